# Optimizing an MI355X kernel written in HIP

```python
import math
import jax
import jax.numpy as jnp
from jax import lax
import numpy as np

D_MODEL = 2048
BATCH = 2
SEQ = 8192
DEPTH = 1

GRID_W = 64
CTX_LEN = 256
EPS = 1e-6

D_MIX = D_MODEL
M_HEADS = 4
M_DV = D_MIX // (2 * M_HEADS)
M_DQK = M_DV // 2
M_V = M_HEADS * M_DV
M_QK = M_HEADS * M_DQK
M_GATES = 2 * 2 * M_HEADS
GATE_SOFTCAP = 15.0
G_HEADS = 8
G_DK = D_MIX // (2 * G_HEADS)
G_W = G_HEADS * G_DK
CONV_K = 5

CHUNK = 64

IN_SPLITS = (M_QK, M_QK, M_V, M_V, M_GATES, 3 * G_W, G_W, 2 * G_HEADS, 2 * G_HEADS)
D_IN = 2 * M_QK + 2 * M_V + M_GATES + 4 * G_W + 4 * G_HEADS

N_GROUPS = 4
EXPERTS_PER_GROUP = 8
N_EXPERTS = N_GROUPS * EXPERTS_PER_GROUP
TOP_K = 2
D_EXPERT = 3 * D_MODEL // 8
MOE_BLOCK = 128

kernel_name = 'hymba_mlstm_gdn_hmoe_prefix_dit'

F32 = jnp.float32


def rmsnorm(x, g):
    xf = x.astype(F32)
    y = xf * lax.rsqrt(jnp.mean(xf * xf, axis=-1, keepdims=True) + EPS)
    return (y * g.astype(F32)).astype(x.dtype)


def modulate(h, shift, scale):
    return h * (1.0 + scale) + shift


def split_cols(z):
    parts, off = [], 0
    for w in IN_SPLITS:
        parts.append(z[..., off:off + w])
        off += w
    return parts


def to_heads(t, n_heads):
    b, n, _ = t.shape
    return t.reshape(b, n, n_heads, -1).transpose(0, 2, 1, 3)


def from_heads_norm(h, g):
    b, nh, n, d = h.shape
    h = rmsnorm(h.transpose(0, 2, 1, 3), g.reshape(nh, d))
    return h.reshape(b, n, nh * d)


def to_chunks(t):
    return t.reshape(t.shape[:2] + (t.shape[2] // CHUNK, CHUNK) + t.shape[3:])


def from_chunks(t):
    return t.reshape(t.shape[:2] + (t.shape[2] * t.shape[3],) + t.shape[4:])


def along(t, d):
    return t if d == 0 else jnp.flip(t, axis=2)


def dwconv_lines(u, w):
    pad = CONV_K // 2
    return lax.conv_general_dilated(u, w[:, None, :].astype(u.dtype), (1,), [(pad, pad)],
                                    dimension_numbers=('NWC', 'WIO', 'NWC'),
                                    feature_group_count=u.shape[-1])


def mlstm_chunk_states(k, v, li, lf, state0):
    b = jnp.cumsum(lf, axis=-1)
    b_last = b[..., -1]
    a = b_last[..., None] - b + li
    a_max = jnp.max(a, axis=-1)

    def step(carry, xs):
        c_st, n_st, m_st = carry
        k_c, v_c, bl, a_c, am = xs
        m_new = jnp.maximum(bl + m_st, am)
        decay = jnp.exp(bl + m_st - m_new)
        w = jnp.exp(a_c - m_new[..., None])
        c_new = decay[..., None, None] * c_st + jnp.einsum('bhlv,bhlk->bhvk', v_c * w[..., None], k_c)
        n_new = decay[..., None] * n_st + jnp.einsum('bhl,bhlk->bhk', w, k_c)
        return (c_new, n_new, m_new), (c_st, n_st, m_st)

    xs = tuple(jnp.moveaxis(t, 2, 0) for t in (k, v, b_last, a, a_max))
    final, starts = lax.scan(step, state0, xs)
    starts = tuple(jnp.moveaxis(t, 0, 2) for t in starts)
    return final, starts, b


def mlstm_chunk_outputs(q, k, v, li, b, starts):
    c0, n0, m0 = starts
    lower = jnp.tril(jnp.ones((CHUNK, CHUNK), dtype=bool))
    dmat = jnp.where(lower, b[..., :, None] - b[..., None, :] + li[..., None, :], -jnp.inf)
    inter = b + m0[..., None]
    m = jnp.maximum(jnp.max(dmat, axis=-1), inter)
    s = jnp.einsum('bhcld,bhcsd->bhcls', q, k) * jnp.exp(dmat - m[..., None])
    e = jnp.exp(inter - m)
    num = jnp.einsum('bhcls,bhcsv->bhclv', s, v) + e[..., None] * jnp.einsum('bhcld,bhcvd->bhclv', q, c0)
    den = jnp.sum(s, axis=-1) + e * jnp.einsum('bhcld,bhcd->bhcl', q, n0)
    return num / jnp.maximum(jnp.abs(den), jnp.exp(-m))[..., None]


def mlstm_run(q, k, v, li, lf, state0, with_out):
    kc, vc, lic = to_chunks(k), to_chunks(v), to_chunks(li)
    final, starts, b = mlstm_chunk_states(kc, vc, lic, to_chunks(lf), state0)
    if not with_out:
        return None, final
    return from_chunks(mlstm_chunk_outputs(to_chunks(q), kc, vc, lic, b, starts)), final


def mlstm_prep(q, k, v, gates, b_gate):
    bsz, n, _ = q.shape
    q = to_heads(q, M_HEADS).astype(F32) * (M_DQK ** -0.5)
    k = to_heads(k, M_HEADS).astype(F32)
    v = to_heads(v, M_HEADS).astype(F32)
    pre = gates.astype(F32).reshape(bsz, n, 2, 2, M_HEADS) + b_gate.astype(F32)
    pre = GATE_SOFTCAP * jnp.tanh(pre / GATE_SOFTCAP)
    pre = jnp.moveaxis(pre, 1, -1)
    return q, k, v, pre[:, :, 0], jax.nn.log_sigmoid(pre[:, :, 1])


def mlstm_group(zc, zl, b_gate, g_head, with_ctx):
    qc, kc, vc, lic, lfc = mlstm_prep(zc[0], zc[1], zc[2], zc[4], b_gate)
    ql, kl, vl, lil, lfl = mlstm_prep(zl[0], zl[1], zl[2], zl[4], b_gate)
    bsz = ql.shape[0]
    hl, hc = 0.0, 0.0
    for d in range(2):
        s0 = (jnp.zeros((bsz, M_HEADS, M_DV, M_DQK), F32), jnp.zeros((bsz, M_HEADS, M_DQK), F32),
              jnp.zeros((bsz, M_HEADS), F32))
        out_c, fin_c = mlstm_run(along(qc, d), along(kc, d), along(vc, d), along(lic[:, d], d),
                                 along(lfc[:, d], d), s0, with_ctx)
        out_l, _ = mlstm_run(along(ql, d), along(kl, d), along(vl, d), along(lil[:, d], d),
                             along(lfl[:, d], d), fin_c, True)
        hl = hl + along(out_l, d)
        if with_ctx:
            hc = hc + along(out_c, d)
    yl = from_heads_norm(hl, g_head) * jax.nn.sigmoid(zl[3].astype(F32))
    yc = from_heads_norm(hc, g_head) * jax.nn.sigmoid(zc[3].astype(F32)) if with_ctx else None
    return yl, yc


def l2norm(t):
    return t * lax.rsqrt(jnp.sum(t * t, axis=-1, keepdims=True) + EPS)


def gdn_chunk_prep(k, v, beta, g):
    gcum = jnp.cumsum(g, axis=-1)
    strict = jnp.tril(jnp.ones((CHUNK, CHUNK), dtype=bool), -1)
    diff = jnp.where(strict, gcum[..., :, None] - gcum[..., None, :], -jnp.inf)
    a_mat = beta[..., :, None] * jnp.einsum('bhcid,bhcjd->bhcij', k, k) * jnp.exp(diff)
    t_mat = a_mat + jnp.eye(CHUNK, dtype=F32)
    rhs = jnp.concatenate([v * beta[..., None], k * (beta * jnp.exp(gcum))[..., None]], axis=-1)
    sol = lax.linalg.triangular_solve(t_mat, rhs, left_side=True, lower=True, unit_diagonal=True)
    dv = v.shape[-1]
    return gcum, sol[..., :dv], sol[..., dv:]


def gdn_chunk_states(k, u, w, gcum, s0):
    g_last = gcum[..., -1]
    kd = k * jnp.exp(g_last[..., None] - gcum)[..., None]

    def step(s_st, xs):
        kd_c, u_c, w_c, gl = xs
        v_new = u_c - jnp.einsum('bhlk,bhkv->bhlv', w_c, s_st)
        s_new = s_st * jnp.exp(gl)[..., None, None] + jnp.einsum('bhlk,bhlv->bhkv', kd_c, v_new)
        return s_new, (s_st, v_new)

    xs = tuple(jnp.moveaxis(t, 2, 0) for t in (kd, u, w, g_last))
    final, (starts, vnew) = lax.scan(step, s0, xs)
    return final, jnp.moveaxis(starts, 0, 2), jnp.moveaxis(vnew, 0, 2)


def gdn_chunk_outputs(q, k, gcum, starts, vnew):
    lower = jnp.tril(jnp.ones((CHUNK, CHUNK), dtype=bool))
    diff = jnp.where(lower, gcum[..., :, None] - gcum[..., None, :], -jnp.inf)
    attn = jnp.einsum('bhcid,bhcjd->bhcij', q, k) * jnp.exp(diff)
    inter = jnp.einsum('bhclk,bhckv->bhclv', q * jnp.exp(gcum)[..., None], starts)
    return inter + jnp.einsum('bhcij,bhcjv->bhciv', attn, vnew)


def gdn_run(q, k, v, beta, g, s0, with_out):
    kc = to_chunks(k)
    gcum, u, w = gdn_chunk_prep(kc, to_chunks(v), to_chunks(beta), to_chunks(g))
    final, starts, vnew = gdn_chunk_states(kc, u, w, gcum, s0)
    if not with_out:
        return None, final
    return from_chunks(gdn_chunk_outputs(to_chunks(q), kc, gcum, starts, vnew)), final


def gdn_prep(qkv, a, b, a_log, dt_bias):
    bsz, n, _ = qkv.shape
    qkv = jax.nn.silu(qkv.astype(F32))
    q = l2norm(to_heads(qkv[..., :G_W], G_HEADS)) * (G_DK ** -0.5)
    k = l2norm(to_heads(qkv[..., G_W:2 * G_W], G_HEADS))
    v = to_heads(qkv[..., 2 * G_W:], G_HEADS)
    a = a.astype(F32).reshape(bsz, n, 2, G_HEADS)
    g = -jnp.exp(a_log.astype(F32)) * jax.nn.softplus(a + dt_bias.astype(F32))
    beta = jax.nn.sigmoid(b.astype(F32).reshape(bsz, n, 2, G_HEADS))
    return q, k, v, jnp.moveaxis(beta, 1, -1), jnp.moveaxis(g, 1, -1)


def gdn_group(zc, zl, a_log, dt_bias, w_conv, g_head, with_ctx):
    bsz, n, cq = zl[0].shape
    rows = n // GRID_W
    qkv_l = dwconv_lines(zl[0].reshape(bsz * rows, GRID_W, cq), w_conv).reshape(bsz, n, cq)
    qkv_c = dwconv_lines(zc[0], w_conv)
    qc, kc, vc, bc, gdc = gdn_prep(qkv_c, zc[2], zc[3], a_log, dt_bias)
    ql, kl, vl, bl, gdl = gdn_prep(qkv_l, zl[2], zl[3], a_log, dt_bias)
    ol, oc = 0.0, 0.0
    for d in range(2):
        s0 = jnp.zeros((bsz, G_HEADS, G_DK, G_DK), F32)
        out_c, fin_c = gdn_run(along(qc, d), along(kc, d), along(vc, d), along(bc[:, d], d),
                               along(gdc[:, d], d), s0, with_ctx)
        out_l, _ = gdn_run(along(ql, d), along(kl, d), along(vl, d), along(bl[:, d], d),
                           along(gdl[:, d], d), fin_c, True)
        ol = ol + along(out_l, d)
        if with_ctx:
            oc = oc + along(out_c, d)
    yl = from_heads_norm(ol, g_head) * jax.nn.silu(zl[1].astype(F32))
    yc = from_heads_norm(oc, g_head) * jax.nn.silu(zc[1].astype(F32)) if with_ctx else None
    return yl, yc


def token_mixing(hc, hl, w_in, b_gate_m, a_log, dt_bias, w_conv, g_head_m, g_head_d, w_out, with_ctx):
    zc = split_cols(hc @ w_in)
    zl = split_cols(hl @ w_in)
    yml, ymc = mlstm_group(zc[:5], zl[:5], b_gate_m, g_head_m, with_ctx)
    ydl, ydc = gdn_group(zc[5:], zl[5:], a_log, dt_bias, w_conv, g_head_d, with_ctx)
    odt = hl.dtype
    yl = jnp.concatenate([yml, ydl], axis=-1).astype(odt) @ w_out
    yc = (jnp.concatenate([ymc, ydc], axis=-1).astype(odt) @ w_out) if with_ctx else None
    return yl, yc


def hier_moe(h, w_grp, b_grp, w_rtr, b_rtr, w1, w3, w2):
    n_tok, d = h.shape
    grp_prob = jax.nn.softmax((h @ w_grp).astype(F32) + b_grp.astype(F32), axis=-1)
    p_grp, grp = lax.top_k(grp_prob, 1)
    exp_logits = ((h @ w_rtr).astype(F32) + b_rtr.astype(F32)).reshape(n_tok, N_GROUPS, EXPERTS_PER_GROUP)
    in_grp = exp_logits[jnp.arange(n_tok), grp[:, 0]]
    top_p, top_e = lax.top_k(jax.nn.softmax(in_grp, axis=-1), TOP_K)
    wts = p_grp * top_p / jnp.sum(top_p, axis=-1, keepdims=True)
    eid = grp * EXPERTS_PER_GROUP + top_e

    n_asg = n_tok * TOP_K
    e_flat = eid.reshape(n_asg)
    tok_flat = jnp.repeat(jnp.arange(n_tok, dtype=jnp.int32), TOP_K)
    w_flat = wts.reshape(n_asg)
    order = jnp.argsort(e_flat)
    e_s, tok_s, w_s = e_flat[order], tok_flat[order], w_flat[order]
    counts = jnp.bincount(e_flat, length=N_EXPERTS)
    start = jnp.cumsum(counts) - counts
    padded = (counts + MOE_BLOCK - 1) // MOE_BLOCK * MOE_BLOCK
    pend = jnp.cumsum(padded)
    dest = pend[e_s] - padded[e_s] + jnp.arange(n_asg) - start[e_s]
    n_blk = -(-n_asg // MOE_BLOCK) + N_EXPERTS
    n_rows = n_blk * MOE_BLOCK
    row_tok = jnp.full((n_rows,), n_tok, jnp.int32).at[dest].set(tok_s)
    row_w = jnp.zeros((n_rows,), F32).at[dest].set(w_s)
    blk_e = jnp.minimum(jnp.searchsorted(pend, jnp.arange(n_blk) * MOE_BLOCK, side='right'), N_EXPERTS - 1)
    h_pad = jnp.concatenate([h, jnp.zeros((1, d), h.dtype)], axis=0)
    xb = h_pad[row_tok].reshape(n_blk, MOE_BLOCK, d)

    def expert_block(args):
        xblk, e = args
        return (jax.nn.silu(xblk @ w1[e]) * (xblk @ w3[e])) @ w2[e]

    yb = lax.map(expert_block, (xb, blk_e)).reshape(n_rows, d)
    out = jnp.zeros((n_tok + 1, d), F32).at[row_tok].add(yb.astype(F32) * row_w[:, None])
    return out[:n_tok].astype(h.dtype)


def setup_inputs(seed: int = 0) -> dict:
    key = jax.random.key(seed)
    ks = jax.random.split(key, 32)

    def nrm(k, shape, scale):
        return jax.random.normal(k, shape, F32) * scale

    b_i = nrm(ks[9], (DEPTH, 2, 1, M_HEADS), 0.1)
    b_f = jnp.linspace(3.0, 6.0, M_HEADS, dtype=F32).reshape(1, 1, 1, M_HEADS) + nrm(ks[10], (DEPTH, 2, 1, M_HEADS), 0.1)
    a_decay = jax.random.uniform(ks[11], (DEPTH, 2, G_HEADS), F32, minval=1.0, maxval=16.0)
    dt = jnp.exp(jax.random.uniform(ks[12], (DEPTH, 2, G_HEADS), F32,
                                    minval=math.log(1e-3), maxval=math.log(1e-1)))
    return {
        'x': nrm(ks[0], (BATCH, SEQ, D_MODEL), 1.0),
        'c': nrm(ks[1], (BATCH, D_MODEL), 1.0),
        'ctx': nrm(ks[2], (BATCH, CTX_LEN, D_MODEL), 1.0),
        'c_ctx': nrm(ks[3], (D_MODEL,), 1.0),
        'w_ada': nrm(ks[4], (DEPTH, D_MODEL, 6 * D_MODEL), 0.01),
        'b_ada': nrm(ks[5], (DEPTH, 6 * D_MODEL), 0.02),
        'g_norm1': 1.0 + nrm(ks[6], (DEPTH, D_MODEL), 0.02),
        'g_norm2': 1.0 + nrm(ks[7], (DEPTH, D_MODEL), 0.02),
        'w_in': nrm(ks[8], (DEPTH, D_MODEL, D_IN), D_MODEL ** -0.5),
        'b_gate_m': jnp.concatenate([b_i, b_f], axis=2),
        'a_log': jnp.log(a_decay),
        'dt_bias': dt + jnp.log(-jnp.expm1(-dt)),
        'w_conv': nrm(ks[13], (DEPTH, CONV_K, 3 * G_W), CONV_K ** -0.5),
        'g_head_m': 1.0 + nrm(ks[14], (DEPTH, M_V), 0.02),
        'g_head_d': 1.0 + nrm(ks[15], (DEPTH, G_W), 0.02),
        'w_out': nrm(ks[16], (DEPTH, D_MIX, D_MODEL), D_MIX ** -0.5),
        'w_grp': nrm(ks[17], (DEPTH, D_MODEL, N_GROUPS), D_MODEL ** -0.5),
        'b_grp': nrm(ks[18], (DEPTH, N_GROUPS), 0.01),
        'w_rtr': nrm(ks[19], (DEPTH, D_MODEL, N_EXPERTS), D_MODEL ** -0.5),
        'b_rtr': nrm(ks[20], (DEPTH, N_EXPERTS), 0.01),
        'w1': nrm(ks[21], (DEPTH, N_EXPERTS, D_MODEL, D_EXPERT), D_MODEL ** -0.5),
        'w3': nrm(ks[22], (DEPTH, N_EXPERTS, D_MODEL, D_EXPERT), D_MODEL ** -0.5),
        'w2': nrm(ks[23], (DEPTH, N_EXPERTS, D_EXPERT, D_MODEL), D_EXPERT ** -0.5),
        'g_final': 1.0 + nrm(ks[24], (D_MODEL,), 0.02),
    }


def reference(x, c, ctx, c_ctx, w_ada, b_ada, g_norm1, g_norm2, w_in, b_gate_m, a_log, dt_bias,
              w_conv, g_head_m, g_head_d, w_out, w_grp, b_grp, w_rtr, b_rtr, w1, w3, w2, g_final):
    cx = ctx
    for l in range(DEPTH):
        last = l == DEPTH - 1
        ada = (jax.nn.silu(c) @ w_ada[l] + b_ada[l])[:, None, :]
        ada_c = (jax.nn.silu(c_ctx) @ w_ada[l] + b_ada[l])[None, None, :]
        sh1, sc1, gt1, sh2, sc2, gt2 = jnp.split(ada, 6, axis=-1)
        csh1, csc1, cgt1, csh2, csc2, cgt2 = jnp.split(ada_c, 6, axis=-1)

        hl = modulate(rmsnorm(x, g_norm1[l]), sh1, sc1)
        hc = modulate(rmsnorm(cx, g_norm1[l]), csh1, csc1)
        yl, yc = token_mixing(hc, hl, w_in[l], b_gate_m[l], a_log[l], dt_bias[l], w_conv[l],
                              g_head_m[l], g_head_d[l], w_out[l], not last)
        x = x + gt1 * yl
        hl2 = modulate(rmsnorm(x, g_norm2[l]), sh2, sc2)
        bsz, n, d = x.shape
        if last:
            x = x + gt2 * hier_moe(hl2.reshape(bsz * n, d), w_grp[l], b_grp[l], w_rtr[l], b_rtr[l],
                                   w1[l], w3[l], w2[l]).reshape(bsz, n, d)
        else:
            cx = cx + cgt1 * yc
            hc2 = modulate(rmsnorm(cx, g_norm2[l]), csh2, csc2)
            n_c = cx.shape[1]
            both = jnp.concatenate([hc2, hl2], axis=1)
            f = hier_moe(both.reshape(-1, d), w_grp[l], b_grp[l], w_rtr[l], b_rtr[l],
                         w1[l], w3[l], w2[l]).reshape(bsz, n_c + n, d)
            cx = cx + cgt2 * f[:, :n_c]
            x = x + gt2 * f[:, n_c:]
    return rmsnorm(x, g_final)
```

```cpp
#include <hip/hip_runtime.h>
#include <hip/hip_cooperative_groups.h>
#include <cstdio>
#include <cstdint>
namespace cg = cooperative_groups;

constexpr int DM = 2048, NB = 2, SEQ = 8192, CTXL = 256;
constexpr int ML = NB * SEQ;
constexpr int MC = NB * CTXL;
constexpr int MT = ML + MC;
constexpr int DIN = 7216, NZ = 7424, ZLD = 7168, GFLD = 64;
constexpr int NE = 32, DE = 768;
constexpr float EPSF = 1e-6f;
constexpr int ZC_MQ = 0, ZC_MK = 512, ZC_MV = 1024, ZC_MO = 2048, ZC_GQKV = 3072, ZC_GO = 6144;

constexpr size_t MiB = 1u << 20;
constexpr size_t WS_CTL = 0, CTL_ZERO_BYTES = 1 * MiB;
constexpr size_t WS_ADA = 1 * MiB;
constexpr size_t WS_GF = 2 * MiB;
constexpr size_t WS_MLG = 7 * MiB;
constexpr size_t WS_GDG = 9 * MiB;
constexpr size_t WS_TOK = 12 * MiB;
constexpr size_t WS_WIN = 13 * MiB;
constexpr size_t WS_WOUT = 42 * MiB;
constexpr size_t WS_W13 = 50 * MiB;
constexpr size_t WS_W2 = 242 * MiB;
constexpr size_t WS_HL = 338 * MiB;
constexpr size_t WS_Y = WS_HL;
constexpr size_t WS_Z = 404 * MiB;
constexpr size_t WS_GQ = 635 * MiB, WS_GK = 668 * MiB, WS_GV = 701 * MiB;
constexpr size_t WS_MO = 734 * MiB, WS_GO = 798 * MiB;
constexpr size_t WS_HL2 = 404 * MiB;
constexpr size_t WS_XB = 468 * MiB;
constexpr size_t WS_H = 628 * MiB;
constexpr size_t WS_YE = 688 * MiB;
constexpr size_t WS_END = 862 * MiB;
static_assert(WS_Z + (size_t)MT * ZLD * 2 <= WS_GQ && WS_GV + (size_t)MT * 1024 * 2 <= WS_MO && WS_GO + (size_t)2 * ML * 1024 * 2 <= WS_END, "ws map A");
static_assert(WS_HL2 + (size_t)ML * 2048 * 2 <= WS_XB && WS_XB + (size_t)40960 * 4096 <= WS_H && WS_H + (size_t)40960 * 1536 <= WS_YE && WS_YE + (size_t)40960 * 4096 <= WS_END, "ws map B");
static_assert(WS_WIN + (size_t)NZ * 2048 * 2 <= WS_WOUT && WS_W13 + (size_t)32 * 1536 * 2048 * 2 <= WS_W2 && WS_W2 + (size_t)32 * 2048 * 768 * 2 <= WS_HL && WS_HL + (size_t)MT * 2048 * 2 <= WS_Z, "ws map W");
constexpr int CW_TMO = 0, CW_CNT = 1024, CW_BAR = 4096;

constexpr int SCR_BYTES = 139264;
constexpr int TBL_OFF = SCR_BYTES;
constexpr int LDS_BYTES = 155648;
constexpr int NWAVES = 8, NTHREADS = 512;

namespace pg8 {
#define PG8_LAS __attribute__((address_space(3)))
typedef unsigned short bf16_t;
typedef short bf16x8 __attribute__((ext_vector_type(8)));
typedef float f32x4 __attribute__((ext_vector_type(4)));
typedef unsigned u32x4 __attribute__((ext_vector_type(4)));
constexpr int BM = 256, BK = 64, HALF = 128, HTB = HALF * BK * 2  , STAGE_BYTES = 8 * HTB, NXCD = 8, WGM = 8;

__host__ __device__ __forceinline__ int lds_byte(int r, int c) { const int st = (r >> 4) * 2 + (c >> 5), rr = r & 15, cc = c & 31, ob = rr * 64 + cc * 2; return st * 1024 + (ob ^ (((ob >> 9) & 1) << 5)); }
__host__ __device__ __forceinline__ void stage_rc(int b, int& R, int& C) { const int st = b / 1024, sb = b % 1024, swz = sb ^ (((sb >> 9) & 1) << 5); R = (st >> 1) * 16 + swz / 64; C = (st & 1) * 32 + (swz % 64) / 2; }
__host__ __device__ __forceinline__ int perm32(int rho) { const int n = rho >> 4, i = rho & 15; return 8 * (i >> 2) + 4 * n + (i & 3); }

struct Unit { int pm, pn; };

struct DenseSched {
    const char* A; const char* Bt; size_t tstep; int nM, nN, nwg, G, c;
    __device__ __forceinline__ void init(const void* A_, const void* Bt_, int M, int N, int K, int G_, int c_) { A = (const char*)A_; Bt = (const char*)Bt_; tstep = (size_t)BM * K * 2; nM = M / BM; nN = N / BM; nwg = nM * nN; G = G_; c = c_; }
    __device__ __forceinline__ bool next(int i, Unit& u) const {
        const long L = (long)i * G + c; if (L >= nwg) return false;
        int wgid = (int)L; { const int q = nwg / NXCD, r = nwg % NXCD, xcd = wgid % NXCD, off = wgid / NXCD; wgid = (xcd < r ? xcd * (q + 1) : r * (q + 1) + (xcd - r) * q) + off; }
        const int nig = WGM * nN, gid = wgid / nig, fm = gid * WGM, gsz = (nM - fm) < WGM ? (nM - fm) : WGM;
        u.pm = fm + ((wgid % nig) % gsz); u.pn = (wgid % nig) / gsz; return true;
    }
    __device__ __forceinline__ const char* a_base(const Unit& u) const { return A + (size_t)u.pm * tstep; }
    __device__ __forceinline__ const char* b_base(const Unit& u) const { return Bt + (size_t)u.pn * tstep; }
    __device__ __forceinline__ void a_ready(const Unit&) const {}
    __device__ __forceinline__ void done(const Unit&) const {}
};
struct MoeSched {
    const char* A; const char* Bt; size_t a_tstep, b_estep, b_tstep; int nN, nunits, G, c; const PG8_LAS int* blk2e;
    __device__ __forceinline__ bool next(int i, Unit& u) const { const long L = (long)i * G + c; if (L >= nunits) return false; u.pm = (int)L / nN; u.pn = (int)L % nN; return true; }
    __device__ __forceinline__ const char* a_base(const Unit& u) const { return A + (size_t)u.pm * a_tstep; }
    __device__ __forceinline__ const char* b_base(const Unit& u) const { return Bt + (size_t)blk2e[u.pm] * b_estep + (size_t)u.pn * b_tstep; }
    __device__ __forceinline__ void a_ready(const Unit&) const {}
    __device__ __forceinline__ void done(const Unit&) const {}
};

__device__ __forceinline__ unsigned cvt_pk_bf16(float lo, float hi) { unsigned r; asm volatile("v_cvt_pk_bf16_f32 %0, %1, %2" : "=v"(r) : "v"(lo), "v"(hi)); return r; }
__device__ __forceinline__ u32x4 pack8(const f32x4 v0, const f32x4 v1) { u32x4 w; w.x = cvt_pk_bf16(v0[0], v0[1]); w.y = cvt_pk_bf16(v0[2], v0[3]); w.z = cvt_pk_bf16(v1[0], v1[1]); w.w = cvt_pk_bf16(v1[2], v1[3]); return w; }

struct EpiZ {
    static constexpr bool PERM = true, AFTER_DRAIN = false;
    bf16_t* Z; float* GF;
    __device__ __forceinline__ void operator()(const f32x4 (&acc)[2][2][4][2], const Unit& u, int wr, int wc, int fr, int fq) const {
        const int row0 = u.pm * BM + wr * 64 + fr;
        if (u.pn < 28) {
            const int col0 = u.pn * BM + wc * 32 + 8 * fq;
#pragma unroll
            for (int ai = 0; ai < 2; ++ai)
#pragma unroll
                for (int m = 0; m < 4; ++m) { bf16_t* rowp = Z + (size_t)(row0 + ai * HALF + m * 16) * 7168 + col0;
#pragma unroll
                    for (int bj = 0; bj < 2; ++bj) *(u32x4*)(rowp + bj * HALF) = pack8(acc[ai][bj][m][0], acc[ai][bj][m][1]); }
        } else if (wc < 2) {
            const int col0 = wc * 32 + 8 * fq;
#pragma unroll
            for (int ai = 0; ai < 2; ++ai)
#pragma unroll
                for (int m = 0; m < 4; ++m) { float* rowp = GF + (size_t)(row0 + ai * HALF + m * 16) * 64 + col0;
                    *(f32x4*)(rowp) = acc[ai][0][m][0]; *(f32x4*)(rowp + 4) = acc[ai][0][m][1]; }
        }
    }
};
struct EpiX1 {
    static constexpr bool PERM = true, AFTER_DRAIN = false;
    const float* x; float* out; const float* ada;
    __device__ __forceinline__ void operator()(const f32x4 (&acc)[2][2][4][2], const Unit& u, int wr, int wc, int fr, int fq) const {
        const int row0 = u.pm * BM + wr * 64 + fr, col0 = u.pn * BM + wc * 32 + 8 * fq;
        const float* gt = ada + (size_t)((u.pm * BM) / 8192) * 12288 + 4096 + col0;
        f32x4 g[2][2];
#pragma unroll
        for (int bj = 0; bj < 2; ++bj)
#pragma unroll
            for (int n = 0; n < 2; ++n) g[bj][n] = *(const f32x4*)(gt + bj * HALF + 4 * n);
#pragma unroll
        for (int ai = 0; ai < 2; ++ai)
#pragma unroll
            for (int m = 0; m < 4; ++m) { const size_t off = (size_t)(row0 + ai * HALF + m * 16) * 2048 + col0;
#pragma unroll
                for (int bj = 0; bj < 2; ++bj)
#pragma unroll
                    for (int n = 0; n < 2; ++n) { const f32x4 xv = *(const f32x4*)(x + off + bj * HALF + 4 * n); *(f32x4*)(out + off + bj * HALF + 4 * n) = xv + g[bj][n] * acc[ai][bj][m][n]; } }
    }
};
struct EpiSwiglu {
    static constexpr bool PERM = true, AFTER_DRAIN = false;
    bf16_t* H;
    __device__ __forceinline__ void operator()(const f32x4 (&acc)[2][2][4][2], const Unit& u, int wr, int wc, int fr, int fq) const {
        const int row0 = u.pm * BM + wr * 64 + fr, col0 = u.pn * HALF + wc * 32 + 8 * fq;
#pragma unroll
        for (int ai = 0; ai < 2; ++ai)
#pragma unroll
            for (int m = 0; m < 4; ++m) { f32x4 h[2];
#pragma unroll
                for (int n = 0; n < 2; ++n)
#pragma unroll
                    for (int r = 0; r < 4; ++r) { const float a = acc[ai][0][m][n][r]; h[n][r] = a / (1.f + __expf(-a)) * acc[ai][1][m][n][r]; }
                *(u32x4*)(H + (size_t)(row0 + ai * HALF + m * 16) * 768 + col0) = pack8(h[0], h[1]); }
    }
};
struct EpiBf {
    static constexpr bool PERM = true, AFTER_DRAIN = false;
    bf16_t* O; int ldc;
    __device__ __forceinline__ void operator()(const f32x4 (&acc)[2][2][4][2], const Unit& u, int wr, int wc, int fr, int fq) const {
        const int row0 = u.pm * BM + wr * 64 + fr, col0 = u.pn * BM + wc * 32 + 8 * fq;
#pragma unroll
        for (int ai = 0; ai < 2; ++ai)
#pragma unroll
            for (int m = 0; m < 4; ++m) { bf16_t* rowp = O + (size_t)(row0 + ai * HALF + m * 16) * ldc + col0;
#pragma unroll
                for (int bj = 0; bj < 2; ++bj) *(u32x4*)(rowp + bj * HALF) = pack8(acc[ai][bj][m][0], acc[ai][bj][m][1]); }
    }
};

template <class Epi, class Sched, bool ALIGN_EPI = false, bool SP2 = false>
__device__ __forceinline__ void gemm_phase(PG8_LAS unsigned char* lds, const int K, const Sched& S, const Epi& E) {
    const int tid = threadIdx.x, wid = __builtin_amdgcn_readfirstlane(tid >> 6), lane = tid & 63, wr = wid >> 2, wc = wid & 3, fr = lane & 15, fq = lane >> 4;
    const int nt = K / BK;
    unsigned voffA[2], voffB[2];
#pragma unroll
    for (int i = 0; i < 2; ++i) { int R, C; stage_rc(tid * 16 + i * 8192, R, C); const int Rb = Epi::PERM ? ((R & ~31) + perm32(R & 31)) : R;
        voffA[i] = (unsigned)(R * K + C) * 2u; voffB[i] = (unsigned)(Rb * K + C) * 2u; }
    const size_t kstep = (size_t)(BK * 2);
    const size_t hstep = (size_t)HALF * K * 2;
    const unsigned ldsw = (unsigned)wid * 1024u;
    const int aoff = lds_byte(wr * 64 + fr, fq * 8), boff = lds_byte(wc * 32 + fr, fq * 8);
#define PG8_SA(b, h) (((b) * 2 + (h)) * HTB)
#define PG8_SB(b, h) ((4 + (b) * 2 + (h)) * HTB)
#define PG8_STAGE(bufoff, gbase, voff) do { _Pragma("unroll") for (int _i = 0; _i < 2; ++_i) \
        __builtin_amdgcn_global_load_lds((const unsigned*)((const char*)(gbase) + (voff)[_i]), (PG8_LAS unsigned*)(lds + (bufoff) + ldsw + _i * 8192), 16, 0, 0); } while (0)
#define PG8_LDA(dst, b, h) do { _Pragma("unroll") for (int m = 0; m < 4; ++m) _Pragma("unroll") for (int k = 0; k < 2; ++k) dst[m][k] = *(const PG8_LAS bf16x8*)(lds + PG8_SA(b, h) + aoff + m * 2048 + k * 1024); } while (0)
#define PG8_LDB(dst, b, h) do { _Pragma("unroll") for (int n = 0; n < 2; ++n) _Pragma("unroll") for (int k = 0; k < 2; ++k) dst[n][k] = *(const PG8_LAS bf16x8*)(lds + PG8_SB(b, h) + boff + n * 2048 + k * 1024); } while (0)
#define PG8_MMA(ai, bj, At, Bt) do { __builtin_amdgcn_s_setprio(1); _Pragma("unroll") for (int m = 0; m < 4; ++m) _Pragma("unroll") for (int n = 0; n < 2; ++n) _Pragma("unroll") for (int k = 0; k < 2; ++k) \
        acc[ai][bj][m][n] = __builtin_amdgcn_mfma_f32_16x16x32_bf16(Bt[n][k], At[m][k], acc[ai][bj][m][n], 0, 0, 0); __builtin_amdgcn_s_setprio(0); } while (0)
#define PG8_WAIT_V(n) asm volatile("s_waitcnt vmcnt(" #n ")" ::: "memory")
#define PG8_WAIT_L(n) asm volatile("s_waitcnt lgkmcnt(" #n ")" ::: "memory")
#define PG8_BAR __builtin_amdgcn_s_barrier()
#define PG8_SCHED __builtin_amdgcn_sched_barrier(0)
    Unit cur, nxt; int ui = 0;
    if (!S.next(0, cur)) return;
    f32x4 acc[2][2][4][2];
#pragma unroll
    for (int a = 0; a < 2; ++a)
#pragma unroll
        for (int b = 0; b < 2; ++b)
#pragma unroll
            for (int m = 0; m < 4; ++m)
#pragma unroll
                for (int n = 0; n < 2; ++n) acc[a][b][m][n] = (f32x4){0.f, 0.f, 0.f, 0.f};
    bf16x8 At[4][2], B0[2][2], B1[2][2];
    const char* cA = S.a_base(cur); const char* cB = S.b_base(cur);
    S.a_ready(cur);
    if constexpr (SP2) {
        PG8_STAGE(PG8_SB(0, 0), cB, voffB); PG8_STAGE(PG8_SB(0, 1), cB + hstep, voffB); PG8_STAGE(PG8_SA(0, 0), cA, voffA); PG8_STAGE(PG8_SA(0, 1), cA + hstep, voffA);
        if (wr == 1) PG8_BAR;
        PG8_WAIT_V(2); PG8_BAR;
        PG8_STAGE(PG8_SB(1, 0), cB + kstep, voffB); PG8_STAGE(PG8_SA(1, 0), cA + kstep, voffA); PG8_STAGE(PG8_SB(1, 1), cB + hstep + kstep, voffB);
        PG8_WAIT_V(6); PG8_BAR;
    } else {
        PG8_STAGE(PG8_SB(0, 0), cB, voffB); PG8_STAGE(PG8_SA(0, 0), cA, voffA); PG8_STAGE(PG8_SB(0, 1), cB + hstep, voffB); PG8_STAGE(PG8_SA(0, 1), cA + hstep, voffA);
        if (wr == 1) PG8_BAR;
        PG8_WAIT_V(4); PG8_BAR;
        PG8_STAGE(PG8_SB(1, 0), cB + kstep, voffB); PG8_STAGE(PG8_SA(1, 0), cA + kstep, voffA); PG8_STAGE(PG8_SB(1, 1), cB + hstep + kstep, voffB);
        PG8_WAIT_V(6); PG8_BAR;
    }
    for (;;) {
        const bool has_next = S.next(ui + 1, nxt);
        const char* nA = has_next ? S.a_base(nxt) : cA; const char* nB = has_next ? S.b_base(nxt) : cB;
        for (int t = 0; t < nt; t += 2) {
            const bool last = (t == nt - 2);
            const char* a1 = cA + (size_t)(t + 1) * kstep;
            const char* a2 = last ? nA : cA + (size_t)(t + 2) * kstep; const char* b2 = last ? nB : cB + (size_t)(t + 2) * kstep;
            const char* a3 = a2 + kstep; const char* b3 = b2 + kstep;
            if (last && has_next) S.a_ready(nxt);
            if constexpr (SP2) {
            PG8_LDB(B0, 0, 0); PG8_LDB(B1, 0, 1); PG8_SCHED; PG8_LDA(At, 0, 0); PG8_STAGE(PG8_SA(1, 1), a1 + hstep, voffA);
            PG8_WAIT_V(8); PG8_WAIT_L(0); PG8_BAR; PG8_MMA(0, 0, At, B0); PG8_MMA(0, 1, At, B1); PG8_BAR; PG8_SCHED;
            PG8_LDA(At, 0, 1); PG8_STAGE(PG8_SB(0, 0), b2, voffB); PG8_STAGE(PG8_SB(0, 1), b2 + hstep, voffB); PG8_STAGE(PG8_SA(0, 0), a2, voffA);
            PG8_WAIT_V(8); PG8_WAIT_L(0); PG8_BAR; PG8_MMA(1, 0, At, B0); PG8_MMA(1, 1, At, B1); PG8_BAR; PG8_SCHED;
            PG8_LDB(B0, 1, 0); PG8_LDB(B1, 1, 1); PG8_SCHED; PG8_LDA(At, 1, 0); PG8_STAGE(PG8_SA(0, 1), a2 + hstep, voffA);
            PG8_WAIT_V(8); PG8_WAIT_L(0); PG8_BAR; PG8_MMA(0, 0, At, B0); PG8_MMA(0, 1, At, B1); PG8_BAR; PG8_SCHED;
            PG8_LDA(At, 1, 1); PG8_STAGE(PG8_SB(1, 0), b3, voffB); PG8_STAGE(PG8_SB(1, 1), b3 + hstep, voffB); PG8_STAGE(PG8_SA(1, 0), a3, voffA);
            PG8_WAIT_V(8); PG8_WAIT_L(0); PG8_BAR; PG8_MMA(1, 0, At, B0); PG8_MMA(1, 1, At, B1); PG8_BAR; PG8_SCHED;
            } else {
            PG8_LDB(B0, 0, 0); PG8_SCHED; PG8_LDA(At, 0, 0); PG8_STAGE(PG8_SA(1, 1), a1 + hstep, voffA);
            PG8_WAIT_L(8); PG8_BAR; PG8_WAIT_L(0); PG8_MMA(0, 0, At, B0); PG8_BAR; PG8_SCHED;
            PG8_LDB(B1, 0, 1); PG8_STAGE(PG8_SB(0, 0), b2, voffB);
            PG8_BAR; PG8_WAIT_L(0); PG8_MMA(0, 1, At, B1); PG8_BAR;
            PG8_LDA(At, 0, 1); PG8_STAGE(PG8_SA(0, 0), a2, voffA);
            PG8_BAR; PG8_WAIT_L(0); PG8_MMA(1, 0, At, B0); PG8_BAR; PG8_SCHED;
            PG8_STAGE(PG8_SB(0, 1), b2 + hstep, voffB);
            PG8_WAIT_V(6); PG8_BAR; PG8_MMA(1, 1, At, B1); PG8_BAR;
            PG8_LDB(B0, 1, 0); PG8_SCHED; PG8_LDA(At, 1, 0); PG8_STAGE(PG8_SA(0, 1), a2 + hstep, voffA);
            PG8_WAIT_L(8); PG8_BAR; PG8_WAIT_L(0); PG8_MMA(0, 0, At, B0); PG8_BAR; PG8_SCHED;
            PG8_LDB(B1, 1, 1); PG8_STAGE(PG8_SB(1, 0), b3, voffB);
            PG8_BAR; PG8_WAIT_L(0); PG8_MMA(0, 1, At, B1); PG8_BAR;
            PG8_LDA(At, 1, 1); PG8_STAGE(PG8_SA(1, 0), a3, voffA);
            PG8_BAR; PG8_WAIT_L(0); PG8_MMA(1, 0, At, B0); PG8_BAR; PG8_SCHED;
            PG8_STAGE(PG8_SB(1, 1), b3 + hstep, voffB);
            PG8_WAIT_V(6); PG8_BAR; PG8_MMA(1, 1, At, B1); PG8_BAR;
            }
        }
        if constexpr (ALIGN_EPI) { if (wr == 0) PG8_BAR; }
        if constexpr (!Epi::AFTER_DRAIN) { E(acc, cur, wr, wc, fr, fq); S.done(cur); }
        if (!has_next) break;
#pragma unroll
        for (int a = 0; a < 2; ++a)
#pragma unroll
            for (int b = 0; b < 2; ++b)
#pragma unroll
                for (int m = 0; m < 4; ++m)
#pragma unroll
                    for (int n = 0; n < 2; ++n) acc[a][b][m][n] = (f32x4){0.f, 0.f, 0.f, 0.f};
        cur = nxt; cA = nA; cB = nB; ++ui;
        if constexpr (ALIGN_EPI) { if (wr == 1) PG8_BAR; }
    }
    PG8_WAIT_V(0);
    if constexpr (!ALIGN_EPI) { if (wr == 0) PG8_BAR; }
    PG8_BAR;
    if constexpr (Epi::AFTER_DRAIN) { E.fused(acc, cur, wr, wc, fr, fq, lds, wid, lane); S.done(cur); }
#undef PG8_SA
#undef PG8_SB
#undef PG8_STAGE
#undef PG8_LDA
#undef PG8_LDB
#undef PG8_MMA
#undef PG8_WAIT_V
#undef PG8_WAIT_L
#undef PG8_BAR
#undef PG8_SCHED
}
}
#define GAS __attribute__((address_space(1)))
#define LAS __attribute__((address_space(3)))
typedef unsigned short bf16;
typedef unsigned v4u __attribute__((ext_vector_type(4)));
typedef float f32x4 __attribute__((ext_vector_type(4)));
typedef short bf16x8 __attribute__((ext_vector_type(8)));
typedef GAS unsigned gu32;
typedef GAS unsigned long long gu64;
#define RLX_AGENT __ATOMIC_RELAXED, __HIP_MEMORY_SCOPE_AGENT
#define LDS_WAIT() asm volatile("s_waitcnt lgkmcnt(0)" ::: "memory")
#define VM_WAIT() asm volatile("s_waitcnt vmcnt(0)" ::: "memory")
__device__ __forceinline__ unsigned long long rt() { return __builtin_amdgcn_s_memrealtime(); }
__device__ __forceinline__ unsigned f2bf(float f) { unsigned u = __builtin_bit_cast(unsigned, f); return (u + 0x7fffu + ((u >> 16) & 1u)) >> 16; }
__device__ __forceinline__ unsigned pk2(float lo, float hi) { return f2bf(lo) | (f2bf(hi) << 16); }

#define XB_TMO      128
#define XB_XCNT(j)  (256  + 64 * (j))
#define XB_XSUB(j)  (1280 + 64 * (j))
#define XB_XGEN(j)  (2304 + 64 * (j))
#define XB_TOP      3328
#define XB_TOPGEN   3392
#define XCD_BAR_WORDS 3456
#define XB_SPIN_CAP (1u << 18)

__device__ __forceinline__ unsigned xb_ld(unsigned* p)              { return __hip_atomic_load(p, __ATOMIC_RELAXED, __HIP_MEMORY_SCOPE_AGENT); }
__device__ __forceinline__ unsigned xb_add(unsigned* p, unsigned v) { return __hip_atomic_fetch_add(p, v, __ATOMIC_RELAXED, __HIP_MEMORY_SCOPE_AGENT); }
__device__ __forceinline__ unsigned xb_xcc_id() { return (unsigned)__builtin_amdgcn_s_getreg((3 << 11) | 20) & 0xFu; }
#define XB_SPIN(cond, bar) do { unsigned _sp = 0; while (cond) { __builtin_amdgcn_s_sleep(1); \
    if ((++_sp & 255u) == 0u) { if (xb_ld(&(bar)[XB_TMO])) break; if (_sp > XB_SPIN_CAP) { atomicAdd(&(bar)[XB_TMO], 1u); break; } } } } while (0)

struct XcdBarrier {
    unsigned* bar; unsigned x;
    volatile LAS unsigned* st;
};

__device__ __forceinline__ XcdBarrier xcd_barrier_post(unsigned* bar, volatile LAS unsigned* st) {
    XcdBarrier b; b.bar = bar; b.x = xb_xcc_id(); b.st = st;
    if (threadIdx.x == 0) (void)xb_add(&bar[XB_XCNT(b.x)], 1u);
    return b;
}
__device__ __forceinline__ void xcd_barrier_complete(unsigned* bar, unsigned x, unsigned& nloc, unsigned& nx) {
    const unsigned G = gridDim.x * gridDim.y * gridDim.z;
    unsigned sum, cnt, mine, sp = 0u;
    for (;;) {
        sum = 0u; cnt = 0u; mine = 0u;
#pragma unroll
        for (unsigned j = 0; j < 16; ++j) { const unsigned c = xb_ld(&bar[XB_XCNT(j)]); sum += c; cnt += (c > 0u) ? 1u : 0u; mine = (j == x) ? c : mine; }
        if (sum == G) break;
        __builtin_amdgcn_s_sleep(1);
        if ((++sp & 255u) == 0u) { if (xb_ld(&bar[XB_TMO])) break; if (sp > XB_SPIN_CAP) { atomicAdd(&bar[XB_TMO], 1u); break; } }
    }
    nloc = mine > 0u ? mine : 1u; nx = cnt > 0u ? cnt : 1u;
}

__device__ __forceinline__ void xcd_barrier(const XcdBarrier& b) {
    asm volatile("s_waitcnt vmcnt(0)" ::: "memory");
    __syncthreads();
    if (threadIdx.x == 0) {
        unsigned* bar = b.bar;
        __builtin_amdgcn_s_waitcnt(0);
        unsigned nloc = b.st[0], nx = b.st[1];
        if (nloc == 0u) { xcd_barrier_complete(bar, b.x, nloc, nx); b.st[0] = nloc; b.st[1] = nx; }
        const unsigned old = xb_add(&bar[XB_XSUB(b.x)], 1u);
        const unsigned gen = old / nloc;
        if (old + 1u == (gen + 1u) * nloc) {
            __builtin_amdgcn_fence(__ATOMIC_RELEASE, "agent");
            asm volatile("s_waitcnt vmcnt(0)" ::: "memory");
            const unsigned og = xb_add(&bar[XB_TOP], 1u);
            const unsigned tg = og / nx;
            if (og + 1u == (tg + 1u) * nx) xb_add(&bar[XB_TOPGEN], 1u);
            else XB_SPIN(xb_ld(&bar[XB_TOPGEN]) == tg, bar);
            __builtin_amdgcn_fence(__ATOMIC_ACQUIRE, "agent");
            xb_add(&bar[XB_XGEN(b.x)], 1u);
            asm volatile("s_waitcnt vmcnt(0)" ::: "memory");
        } else {
            XB_SPIN(xb_ld(&bar[XB_XGEN(b.x)]) == gen, bar);
            __builtin_amdgcn_fence(__ATOMIC_ACQUIRE, "agent");
            asm volatile("s_waitcnt vmcnt(0)" ::: "memory");
        }
    }
    __syncthreads();
}
typedef float f32x2 __attribute__((ext_vector_type(2)));
typedef unsigned u32x2 __attribute__((ext_vector_type(2)));
__device__ __forceinline__ float wave_sum(float v) {
#pragma unroll
    for (int o = 1; o < 64; o <<= 1) v += __shfl_xor(v, o);
    return v;
}
__device__ __forceinline__ float bf_lo(unsigned u) { return __builtin_bit_cast(float, u << 16); }
__device__ __forceinline__ float bf_hi(unsigned u) { return __builtin_bit_cast(float, u & 0xffff0000u); }
__device__ __forceinline__ float sigmoidf_(float v) { return 1.f / (1.f + expf(-v)); }
__device__ __forceinline__ float siluf_(float v) { return v / (1.f + expf(-v)); }
__device__ __forceinline__ float softplusf_(float v) { return fmaxf(v, 0.f) + log1pf(expf(-fabsf(v))); }

__device__ __forceinline__ void ph_ada(const float* c, const float* c_ctx, const float* w_ada, const float* b_ada, float* ADA, LAS float* sf, int tid, int lane, int wave) {
    if ((int)blockIdx.x >= 192) return;
    for (int i = tid; i < 3 * 2048; i += NTHREADS) { const float v = (i < 4096) ? c[i] : c_ctx[i - 4096]; sf[i] = siluf_(v); }
    __syncthreads();
    for (int task = blockIdx.x; task < 192; task += gridDim.x) {
        const int col = task * 64 + lane;
        float a0 = 0.f, a1 = 0.f, a2 = 0.f;
        const float* wp = w_ada + (size_t)(wave * 256) * 12288 + col;
#pragma unroll 8
        for (int k = 0; k < 256; ++k) { const float w = wp[(size_t)k * 12288]; const int kk = wave * 256 + k; a0 += sf[kk] * w; a1 += sf[2048 + kk] * w; a2 += sf[4096 + kk] * w; }
        LAS float* red = sf + 6144;
        red[(wave * 3 + 0) * 64 + lane] = a0; red[(wave * 3 + 1) * 64 + lane] = a1; red[(wave * 3 + 2) * 64 + lane] = a2;
        __syncthreads();
        if (tid < 192) { const int r = tid >> 6, l = tid & 63; float s = 0.f;
#pragma unroll
            for (int w = 0; w < 8; ++w) s += red[(w * 3 + r) * 64 + l];
            ADA[r * 12288 + task * 64 + l] = s + b_ada[task * 64 + l]; }
        __syncthreads();
    }
}
__device__ __forceinline__ int rowmap(int n, int mode, int s128, int off) {
    if (mode == 0) return (n >> 7) * s128 + (n & 127) + off;
    if (n < 3072) return n;
    if (n < 3088) return 7168 + (n - 3072);
    if (n < 7184) return n - 16;
    return n;
}
__device__ __forceinline__ void transpose_item(const float* W, int K, int N, bf16* WT, int mode, int s128, int off, LAS float* scr, int item, int lane) {
    const int nblk = (N + 31) >> 5, kb = item / nblk, nb = item - kb * nblk, k0 = 64 * kb, n0 = 32 * nb;
    const int nn = n0 + (lane & 31); const bool ok = nn < N;
#pragma unroll 8
    for (int i = 0; i < 32; ++i) { const int kk = 2 * i + (lane >> 5); scr[kk * 33 + (lane & 31)] = ok ? W[(size_t)(k0 + kk) * N + nn] : 0.f; }
    LDS_WAIT(); asm volatile("" ::: "memory");
    const int cc = lane & 7;
#pragma unroll
    for (int j = 0; j < 4; ++j) { const int n = (lane >> 3) + 8 * j;
        if (n0 + n < N) { const LAS float* s = scr + (8 * cc) * 33 + n;
            v4u o; o.x = pk2(s[0 * 33], s[1 * 33]); o.y = pk2(s[2 * 33], s[3 * 33]); o.z = pk2(s[4 * 33], s[5 * 33]); o.w = pk2(s[6 * 33], s[7 * 33]);
            *(GAS v4u*)(WT + (size_t)rowmap(n0 + n, mode, s128, off) * K + k0 + 8 * cc) = o; } }
    LDS_WAIT(); asm volatile("" ::: "memory");
}
__device__ __forceinline__ void ph_transposes(const float* w_in, const float* w_out, const float* w1, const float* w3, const float* w2, unsigned char* ws, LAS unsigned char* lds, int gw, int NGW, int wave, int lane) {
    LAS float* scr = (LAS float*)(lds + wave * 16384);
    constexpr int I_IN = 32 * 226, I_OUT = 32 * 64, I_E = 32 * 24, I_E2 = 12 * 64;
    constexpr int NITEMS = I_IN + I_OUT + 32 * (2 * I_E + I_E2);
    bf16* WinT = (bf16*)(ws + WS_WIN); bf16* WoutT = (bf16*)(ws + WS_WOUT); bf16* W13T = (bf16*)(ws + WS_W13); bf16* W2T = (bf16*)(ws + WS_W2);
    for (int it = gw; it < NITEMS; it += NGW) {
        int r = it;
        if (r < I_IN) { transpose_item(w_in, 2048, DIN, WinT, 1, 0, 0, scr, r, lane); continue; } r -= I_IN;
        if (r < I_OUT) { transpose_item(w_out, 2048, 2048, WoutT, 0, 128, 0, scr, r, lane); continue; } r -= I_OUT;
        const int e = r / (2 * I_E + I_E2); r -= e * (2 * I_E + I_E2);
        if (r < I_E) { transpose_item(w1 + (size_t)e * 2048 * 768, 2048, 768, W13T + (size_t)e * 1536 * 2048, 0, 256, 0, scr, r, lane); continue; } r -= I_E;
        if (r < I_E) { transpose_item(w3 + (size_t)e * 2048 * 768, 2048, 768, W13T + (size_t)e * 1536 * 2048, 0, 256, 128, scr, r, lane); continue; } r -= I_E;
        transpose_item(w2 + (size_t)e * 768 * 2048, 768, 2048, W2T + (size_t)e * 2048 * 768, 0, 128, 0, scr, r, lane);
    }
}

__device__ __forceinline__ void ph_norm1(const float* x, const float* ctx, const float* g1, const float* ADA, bf16* HL, int gw, int NGW, int lane) {
    for (int row = gw; row < MT; row += NGW) {
        const float* src = row < ML ? x + (size_t)row * DM : ctx + (size_t)(row - ML) * DM;
        const float* sh = ADA + (size_t)(row < ML ? row / SEQ : 2) * 12288; const float* sc = sh + 2048;
        f32x4 v[8]; float s = 0.f;
#pragma unroll
        for (int j = 0; j < 8; ++j) { v[j] = ((const f32x4*)src)[lane + 64 * j]; s += (v[j].x * v[j].x + v[j].y * v[j].y) + (v[j].z * v[j].z + v[j].w * v[j].w); }
        const float rstd = 1.f / sqrtf(wave_sum(s) * (1.f / DM) + EPSF);
        unsigned long long* o8 = (unsigned long long*)(HL + (size_t)row * DM) + lane;
#pragma unroll
        for (int j = 0; j < 8; ++j) { const int col = 4 * (lane + 64 * j);
            const f32x4 g = *(const f32x4*)(g1 + col), a = *(const f32x4*)(sc + col), b = *(const f32x4*)(sh + col);
            const f32x4 o = (v[j] * rstd) * g * (a + 1.f) + b;
            o8[64 * j] = (unsigned long long)pk2(o.x, o.y) | ((unsigned long long)pk2(o.z, o.w) << 32); }
    }
}

__device__ __forceinline__ void ph_prep(const bf16* Z, const float* GF, const float* w_conv, const float* b_gate, const float* a_log, const float* dt_bias,
                                        bf16* GQ, bf16* GK, bf16* GV, float* MLG, float* GDG, int tid, int lane, int wave) {
    for (int ci = blockIdx.x; ci < 264; ci += gridDim.x) {
        int rowbase, tlo, thi, t0;
        if (ci < 256) { rowbase = (ci >> 7) * SEQ + (ci & 127) * 64; tlo = 0; thi = 64; t0 = 0; }
        else { const int cc = ci - 256; rowbase = ML + (cc >> 2) * CTXL; tlo = 0; thi = 256; t0 = (cc & 3) * 64; }
        for (int gi = wave; gi < 24; gi += 8) {
            const int type = gi >> 3, head = gi & 7, ch = type * 1024 + head * 128 + 2 * lane;
            float w0[5], w1[5];
#pragma unroll
            for (int j = 0; j < 5; ++j) { w0[j] = w_conv[j * 3072 + ch]; w1[j] = w_conv[j * 3072 + ch + 1]; }
            bf16* dst = (type == 0 ? GQ : (type == 1 ? GK : GV)) + head * 128 + 2 * lane;
            const float qs = type == 0 ? 0.08838834764831845f : 1.f;
#pragma unroll 1
            for (int sub = 0; sub < 4; ++sub) {
                unsigned zr[20];
#pragma unroll
                for (int i = 0; i < 20; ++i) { const int t = t0 + sub * 16 + i - 2; zr[i] = (t >= tlo && t < thi) ? *(const unsigned*)(Z + (size_t)(rowbase + t) * ZLD + ZC_GQKV + ch) : 0u; }
#pragma unroll
                for (int i = 0; i < 16; ++i) {
                    float o0 = 0.f, o1 = 0.f;
#pragma unroll
                    for (int j = 0; j < 5; ++j) { o0 += w0[j] * bf_lo(zr[i + j]); o1 += w1[j] * bf_hi(zr[i + j]); }
                    o0 = siluf_(o0); o1 = siluf_(o1);
                    if (type < 2) { const float ss = wave_sum(o0 * o0 + o1 * o1); const float sc = qs / sqrtf(ss + EPSF); o0 *= sc; o1 *= sc; }
                    *(unsigned*)(dst + (size_t)(rowbase + t0 + sub * 16 + i) * 1024) = pk2(o0, o1);
                }
            }
        }
    }
    const int gt = blockIdx.x * NTHREADS + tid, NGT = gridDim.x * NTHREADS;
    for (int e = gt; e < MT * 48; e += NGT) {
        const int row = e / 48, idx = e - row * 48; const float v = GF[(size_t)row * GFLD + idx];
        if (idx < 16) { float p = v + b_gate[idx]; p = 15.f * tanhf(p * (1.f / 15.f)); const int type = (idx >> 2) & 1;
            MLG[(size_t)row * 16 + idx] = type == 0 ? p : -softplusf_(-p); }
        else if (idx < 32) { const int j = idx - 16; GDG[(size_t)row * 32 + j] = -expf(a_log[j]) * softplusf_(v + dt_bias[j]); }
        else { const int j = idx - 32; GDG[(size_t)row * 32 + 16 + j] = sigmoidf_(v); }
    }
}
__device__ __forceinline__ void stage64x128(const bf16* src, size_t ld, int row0, LAS float* dst, float scale, int tid) {
    const int r = tid >> 3, s = tid & 7;
    const v4u a = *(const v4u*)(src + (size_t)(row0 + r) * ld + 16 * s), b = *(const v4u*)(src + (size_t)(row0 + r) * ld + 16 * s + 8);
    LAS f32x4* d = (LAS f32x4*)(dst + r * 128 + 16 * s);
    d[0] = (f32x4){bf_lo(a.x), bf_hi(a.x), bf_lo(a.y), bf_hi(a.y)} * scale; d[1] = (f32x4){bf_lo(a.z), bf_hi(a.z), bf_lo(a.w), bf_hi(a.w)} * scale;
    d[2] = (f32x4){bf_lo(b.x), bf_hi(b.x), bf_lo(b.y), bf_hi(b.y)} * scale; d[3] = (f32x4){bf_lo(b.z), bf_hi(b.z), bf_lo(b.w), bf_hi(b.w)} * scale;
}
__device__ __forceinline__ float red16(float v) { v += __shfl_xor(v, 1); v += __shfl_xor(v, 2); v += __shfl_xor(v, 4); v += __shfl_xor(v, 8); return v; }

__device__ __forceinline__ void mlstm_seq_job(int job, const bf16* Z, const float* MLG, bf16* MO, LAS float* sf, int tid) {
    const int seq = job >> 3, v0 = (job & 7) * 32, b = seq >> 3, h = (seq >> 1) & 3, d = seq & 1;
    const int vi = tid >> 4, kq = tid & 15;
    LAS float* qs = sf; LAS float* ks = sf + 8192; LAS float* vs = sf + 16384; LAS float* fi = sf + 16384 + 2048;
    float C[8], n[8];
#pragma unroll
    for (int j = 0; j < 8; ++j) { C[j] = 0.f; n[j] = 0.f; }
    for (int seg = 0; seg < 2; ++seg) {
        const int T = seg ? SEQ : CTXL, rowbase = seg ? b * SEQ : ML + b * CTXL, nch = T >> 6;
        for (int cidx = 0; cidx < nch; ++cidx) {
            const int c = d == 0 ? cidx : nch - 1 - cidx, row0 = rowbase + c * 64;
            __syncthreads();
            stage64x128(Z + ZC_MQ + h * 128, ZLD, row0, qs, 0.08838834764831845f, tid);
            stage64x128(Z + ZC_MK + h * 128, ZLD, row0, ks, 1.f, tid);
            if (tid < 256) { const int r = tid >> 2, s = tid & 3; const v4u a = *(const v4u*)(Z + (size_t)(row0 + r) * ZLD + ZC_MV + h * 256 + v0 + 8 * s);
                LAS f32x4* dd = (LAS f32x4*)(vs + r * 32 + 8 * s); dd[0] = (f32x4){bf_lo(a.x), bf_hi(a.x), bf_lo(a.y), bf_hi(a.y)}; dd[1] = (f32x4){bf_lo(a.z), bf_hi(a.z), bf_lo(a.w), bf_hi(a.w)}; }
            if (tid < 64) { fi[tid * 2] = expf(MLG[(size_t)(row0 + tid) * 16 + d * 8 + 4 + h]); fi[tid * 2 + 1] = expf(MLG[(size_t)(row0 + tid) * 16 + d * 8 + h]); }
            __syncthreads();
#pragma unroll 1
            for (int s = 0; s < 64; ++s) {
                const int r = d == 0 ? s : 63 - s;
                const f32x4 k0 = *(const LAS f32x4*)(ks + r * 128 + 8 * kq), k1 = *(const LAS f32x4*)(ks + r * 128 + 8 * kq + 4);
                const f32x4 q0 = *(const LAS f32x4*)(qs + r * 128 + 8 * kq), q1 = *(const LAS f32x4*)(qs + r * 128 + 8 * kq + 4);
                const float f = fi[r * 2], ig = fi[r * 2 + 1], iv = ig * vs[r * 32 + vi];
                float pn = 0.f, pd = 0.f;
#pragma unroll
                for (int j = 0; j < 4; ++j) { C[j] = f * C[j] + iv * k0[j]; n[j] = f * n[j] + ig * k0[j]; pn += C[j] * q0[j]; pd += n[j] * q0[j]; }
#pragma unroll
                for (int j = 0; j < 4; ++j) { C[4 + j] = f * C[4 + j] + iv * k1[j]; n[4 + j] = f * n[4 + j] + ig * k1[j]; pn += C[4 + j] * q1[j]; pd += n[4 + j] * q1[j]; }
                pn = red16(pn); pd = red16(pd);
                if (seg == 1 && kq == 0) MO[((size_t)d * ML + row0 + r) * 1024 + h * 256 + v0 + vi] = (bf16)f2bf(pn / fmaxf(fabsf(pd), 1.f));
            }
        }
    }
}
__device__ __forceinline__ void gdn_seq_job(int job, const bf16* GQ, const bf16* GK, const bf16* GV, const float* GDG, bf16* GO, LAS float* sf, int tid) {
    const int seq = job >> 2, c0 = (job & 3) * 32, b = seq >> 4, h = (seq >> 1) & 7, d = seq & 1;
    const int ci = tid >> 4, kq = tid & 15;
    LAS float* qs = sf; LAS float* ks = sf + 8192; LAS float* vs = sf + 16384; LAS float* ab = sf + 16384 + 2048;
    float S[8];
#pragma unroll
    for (int j = 0; j < 8; ++j) S[j] = 0.f;
    for (int seg = 0; seg < 2; ++seg) {
        const int T = seg ? SEQ : CTXL, rowbase = seg ? b * SEQ : ML + b * CTXL, nch = T >> 6;
        for (int cidx = 0; cidx < nch; ++cidx) {
            const int c = d == 0 ? cidx : nch - 1 - cidx, row0 = rowbase + c * 64;
            __syncthreads();
            stage64x128(GQ + h * 128, 1024, row0, qs, 1.f, tid);
            stage64x128(GK + h * 128, 1024, row0, ks, 1.f, tid);
            if (tid < 256) { const int r = tid >> 2, s = tid & 3; const v4u a = *(const v4u*)(GV + (size_t)(row0 + r) * 1024 + h * 128 + c0 + 8 * s);
                LAS f32x4* dd = (LAS f32x4*)(vs + r * 32 + 8 * s); dd[0] = (f32x4){bf_lo(a.x), bf_hi(a.x), bf_lo(a.y), bf_hi(a.y)}; dd[1] = (f32x4){bf_lo(a.z), bf_hi(a.z), bf_lo(a.w), bf_hi(a.w)}; }
            if (tid < 64) { ab[tid * 2] = expf(GDG[(size_t)(row0 + tid) * 32 + d * 8 + h]); ab[tid * 2 + 1] = GDG[(size_t)(row0 + tid) * 32 + 16 + d * 8 + h]; }
            __syncthreads();
#pragma unroll 1
            for (int s = 0; s < 64; ++s) {
                const int r = d == 0 ? s : 63 - s;
                const f32x4 k0 = *(const LAS f32x4*)(ks + r * 128 + 8 * kq), k1 = *(const LAS f32x4*)(ks + r * 128 + 8 * kq + 4);
                const f32x4 q0 = *(const LAS f32x4*)(qs + r * 128 + 8 * kq), q1 = *(const LAS f32x4*)(qs + r * 128 + 8 * kq + 4);
                const float al = ab[r * 2], be = ab[r * 2 + 1], vv = vs[r * 32 + ci];
                float pk = 0.f;
#pragma unroll
                for (int j = 0; j < 4; ++j) { S[j] *= al; S[4 + j] *= al; pk += k0[j] * S[j] + k1[j] * S[4 + j]; }
                pk = red16(pk);
                const float dl = be * (vv - pk);
                float po = 0.f;
#pragma unroll
                for (int j = 0; j < 4; ++j) { S[j] += k0[j] * dl; S[4 + j] += k1[j] * dl; po += q0[j] * S[j] + q1[j] * S[4 + j]; }
                po = red16(po);
                if (seg == 1 && kq == 0) GO[((size_t)d * ML + row0 + r) * 1024 + h * 128 + c0 + ci] = (bf16)f2bf(po);
            }
        }
    }
}
__device__ __forceinline__ void ph_scan_seq(const bf16* Z, const float* MLG, const bf16* GQ, const bf16* GK, const bf16* GV, const float* GDG, bf16* MO, bf16* GO, LAS float* sf, int tid) {
    for (int job = blockIdx.x; job < 256; job += gridDim.x) {
        if (job < 128) mlstm_seq_job(job, Z, MLG, MO, sf, tid); else gdn_seq_job(job - 128, GQ, GK, GV, GDG, GO, sf, tid);
        __syncthreads();
    }
}

__device__ __forceinline__ void unpack16(const bf16* p, float (&v)[16]) {
    const v4u a = *(const v4u*)p, b = *(const v4u*)(p + 8);
    v[0] = bf_lo(a.x); v[1] = bf_hi(a.x); v[2] = bf_lo(a.y); v[3] = bf_hi(a.y); v[4] = bf_lo(a.z); v[5] = bf_hi(a.z); v[6] = bf_lo(a.w); v[7] = bf_hi(a.w);
    v[8] = bf_lo(b.x); v[9] = bf_hi(b.x); v[10] = bf_lo(b.y); v[11] = bf_hi(b.y); v[12] = bf_lo(b.z); v[13] = bf_hi(b.z); v[14] = bf_lo(b.w); v[15] = bf_hi(b.w);
}
__device__ __forceinline__ void pack16(bf16* p, const float (&v)[16]) {
    v4u a, b; a.x = pk2(v[0], v[1]); a.y = pk2(v[2], v[3]); a.z = pk2(v[4], v[5]); a.w = pk2(v[6], v[7]); b.x = pk2(v[8], v[9]); b.y = pk2(v[10], v[11]); b.z = pk2(v[12], v[13]); b.w = pk2(v[14], v[15]);
    *(v4u*)p = a; *(v4u*)(p + 8) = b;
}
__device__ __forceinline__ void ph_combine(const bf16* Z, const bf16* MO, const bf16* GO, const float* g_head_m, const float* g_head_d, bf16* Y, int gw, int NGW, int lane) {
    for (int row = gw; row < ML; row += NGW) {
        float a[16], b2[16], g[16], o[16];
        unpack16(MO + (size_t)row * 1024 + 16 * lane, a); unpack16(MO + ((size_t)ML + row) * 1024 + 16 * lane, b2); unpack16(Z + (size_t)row * ZLD + ZC_MO + 16 * lane, g);
        float ss = 0.f;
#pragma unroll
        for (int j = 0; j < 16; ++j) { a[j] += b2[j]; ss += a[j] * a[j]; }
        ss = red16(ss);
        float r = 1.f / sqrtf(ss * (1.f / 256.f) + EPSF);
#pragma unroll
        for (int j = 0; j < 16; ++j) o[j] = a[j] * r * g_head_m[16 * lane + j] * sigmoidf_(g[j]);
        pack16(Y + (size_t)row * DM + 16 * lane, o);
        unpack16(GO + (size_t)row * 1024 + 16 * lane, a); unpack16(GO + ((size_t)ML + row) * 1024 + 16 * lane, b2); unpack16(Z + (size_t)row * ZLD + ZC_GO + 16 * lane, g);
        ss = 0.f;
#pragma unroll
        for (int j = 0; j < 16; ++j) { a[j] += b2[j]; ss += a[j] * a[j]; }
        ss += __shfl_xor(ss, 1); ss += __shfl_xor(ss, 2); ss += __shfl_xor(ss, 4);
        r = 1.f / sqrtf(ss * (1.f / 128.f) + EPSF);
#pragma unroll
        for (int j = 0; j < 16; ++j) o[j] = a[j] * r * g_head_d[16 * lane + j] * siluf_(g[j]);
        pack16(Y + (size_t)row * DM + 1024 + 16 * lane, o);
    }
}
typedef float f32x4v __attribute__((ext_vector_type(4)));
constexpr int HB_LD = 2052;
__device__ __forceinline__ void ph_norm2_route(const float* X1, const float* g2, const float* ADA, const float* w_grp, const float* b_grp, const float* w_rtr, const float* b_rtr,
                                               bf16* HL2, int* TOK_E, int* TOK_P, float* TOK_W, unsigned* cnt, LAS float* sf, int tid, int lane, int wave) {
    for (int grp16 = blockIdx.x; grp16 < ML / 16; grp16 += gridDim.x) {
#pragma unroll 1
        for (int rr = 0; rr < 2; ++rr) {
            const int r = 2 * wave + rr, row = grp16 * 16 + r;
            const float* src = X1 + (size_t)row * DM; const float* sh = ADA + (size_t)(row / SEQ) * 12288 + 6144; const float* sc = sh + 2048;
            f32x4 v[8]; float s = 0.f;
#pragma unroll
            for (int j = 0; j < 8; ++j) { v[j] = ((const f32x4*)src)[lane + 64 * j]; s += (v[j].x * v[j].x + v[j].y * v[j].y) + (v[j].z * v[j].z + v[j].w * v[j].w); }
            const float rstd = 1.f / sqrtf(wave_sum(s) * (1.f / DM) + EPSF);
            unsigned long long* o8 = (unsigned long long*)(HL2 + (size_t)row * DM) + lane;
#pragma unroll
            for (int j = 0; j < 8; ++j) { const int col = 4 * (lane + 64 * j);
                const f32x4 g = *(const f32x4*)(g2 + col), a = *(const f32x4*)(sc + col), b = *(const f32x4*)(sh + col);
                const f32x4 o = (v[j] * rstd) * g * (a + 1.f) + b;
                o8[64 * j] = (unsigned long long)pk2(o.x, o.y) | ((unsigned long long)pk2(o.z, o.w) << 32);
                *(LAS f32x4*)(sf + r * HB_LD + col) = o; }
        }
        __syncthreads();
        f32x4v acc0 = {0.f, 0.f, 0.f, 0.f}, acc1 = acc0, acc2 = acc0;
        { const int arow = lane & 15, kg = lane >> 4, bc = lane & 15;
#pragma unroll 4
          for (int kk = 0; kk < 64; ++kk) { const int k = 256 * wave + 4 * kk + kg;
              const float a = sf[arow * HB_LD + k];
              const float b0 = w_rtr[k * 32 + bc], b1 = w_rtr[k * 32 + 16 + bc], b2 = bc < 4 ? w_grp[k * 4 + bc] : 0.f;
              acc0 = __builtin_amdgcn_mfma_f32_16x16x4f32(a, b0, acc0, 0, 0, 0);
              acc1 = __builtin_amdgcn_mfma_f32_16x16x4f32(a, b1, acc1, 0, 0, 0);
              acc2 = __builtin_amdgcn_mfma_f32_16x16x4f32(a, b2, acc2, 0, 0, 0); } }
        __syncthreads();
        { LAS float* red = sf; const int col = lane & 15, r4 = 4 * (lane >> 4);
#pragma unroll
          for (int q = 0; q < 4; ++q) { red[((wave * 3 + 0) * 16 + r4 + q) * 16 + col] = acc0[q]; red[((wave * 3 + 1) * 16 + r4 + q) * 16 + col] = acc1[q]; red[((wave * 3 + 2) * 16 + r4 + q) * 16 + col] = acc2[q]; } }
        __syncthreads();
        for (int i = tid; i < 768; i += NTHREADS) { float s = 0.f;
#pragma unroll
            for (int w = 0; w < 8; ++w) s += sf[w * 768 + i];
            sf[8 * 768 + i] = s; }
        __syncthreads();
        if (tid < 16) {
            const int r = tid, row = grp16 * 16 + r; const LAS float* lg = sf + 8 * 768;
            float gl[4];
#pragma unroll
            for (int i = 0; i < 4; ++i) gl[i] = lg[(2 * 16 + r) * 16 + i] + b_grp[i];
            int gbest = 0; float gmax = gl[0];
#pragma unroll
            for (int i = 1; i < 4; ++i) if (gl[i] > gmax) { gmax = gl[i]; gbest = i; }
            float gsum = 0.f;
#pragma unroll
            for (int i = 0; i < 4; ++i) gsum += expf(gl[i] - gmax);
            const float pgrp = 1.f / gsum;
            float l0 = -3.0e38f, l1 = -3.0e38f; int e0 = 0, e1 = 0;
#pragma unroll
            for (int j = 0; j < 8; ++j) { const int idx = gbest * 8 + j; const float l = lg[((idx >> 4) * 16 + r) * 16 + (idx & 15)] + b_rtr[idx];
                if (l > l0) { l1 = l0; e1 = e0; l0 = l; e0 = j; } else if (l > l1) { l1 = l; e1 = j; } }
            const float t = expf(l1 - l0);
            const float w0 = pgrp / (1.f + t), w1 = pgrp * t / (1.f + t);
            const int ea = gbest * 8 + e0, eb = gbest * 8 + e1;
            const int pa = (int)atomicAdd(cnt + ea, 1u), pb = (int)atomicAdd(cnt + eb, 1u);
            TOK_E[row * 2] = ea; TOK_E[row * 2 + 1] = eb; TOK_P[row * 2] = pa; TOK_P[row * 2 + 1] = pb; TOK_W[row * 2] = w0; TOK_W[row * 2 + 1] = w1;
        }
        __syncthreads();
    }
}
__device__ __forceinline__ void build_moe_tables(const unsigned* cnt, LAS int* tb, int tid) {
    __syncthreads();
    if (tid == 0) { int acc = 0;
        for (int e = 0; e < NE; ++e) { const int c = (int)__hip_atomic_load(cnt + e, __ATOMIC_RELAXED, __HIP_MEMORY_SCOPE_AGENT); const int nb = (c + 255) >> 8; tb[e] = acc;
            for (int p = 0; p < nb; ++p) tb[64 + acc + p] = e;
            acc += nb; }
        tb[32] = acc; }
    __syncthreads();
}
__device__ __forceinline__ void ph_gather(const bf16* HL2, const int* TOK_E, const int* TOK_P, int* TOK_D, bf16* XB, const LAS int* tb, int gw, int NGW, int lane) {
    for (int tok = gw; tok < ML; tok += NGW) {
        const v4u* src = (const v4u*)(HL2 + (size_t)tok * DM) + lane;
        const v4u a = src[0], b = src[64], c = src[128], d = src[192];
#pragma unroll
        for (int k = 0; k < 2; ++k) { const int e = TOK_E[tok * 2 + k], pos = TOK_P[tok * 2 + k], dest = tb[e] * 256 + pos;
            v4u* dst = (v4u*)(XB + (size_t)dest * DM) + lane; dst[0] = a; dst[64] = b; dst[128] = c; dst[192] = d;
            if (lane == 0) TOK_D[tok * 2 + k] = dest; }
    }
}
__device__ __forceinline__ void ph_final(float* X1out, const bf16* YE, const int* TOK_D, const float* TOK_W, const float* ADA, const float* g_final, int gw, int NGW, int lane) {
    for (int tok = gw; tok < ML; tok += NGW) {
        const int d0 = TOK_D[tok * 2], d1 = TOK_D[tok * 2 + 1]; const float w0 = TOK_W[tok * 2], w1 = TOK_W[tok * 2 + 1];
        const float* gt = ADA + (size_t)(tok / SEQ) * 12288 + 10240;
        float* xr = X1out + (size_t)tok * DM;
        const u32x2* y0 = (const u32x2*)(YE + (size_t)d0 * DM) + lane; const u32x2* y1 = (const u32x2*)(YE + (size_t)d1 * DM) + lane;
        f32x4 v[8]; float s = 0.f;
#pragma unroll
        for (int j = 0; j < 8; ++j) { const int col = 4 * (lane + 64 * j);
            const f32x4 xv = ((const f32x4*)xr)[lane + 64 * j], g = *(const f32x4*)(gt + col); const u32x2 a = y0[64 * j], b = y1[64 * j];
            const f32x4 ya = {bf_lo(a.x), bf_hi(a.x), bf_lo(a.y), bf_hi(a.y)}, yb = {bf_lo(b.x), bf_hi(b.x), bf_lo(b.y), bf_hi(b.y)};
            v[j] = xv + g * (ya * w0 + yb * w1);
            s += (v[j].x * v[j].x + v[j].y * v[j].y) + (v[j].z * v[j].z + v[j].w * v[j].w); }
        const float rstd = 1.f / sqrtf(wave_sum(s) * (1.f / DM) + EPSF);
#pragma unroll
        for (int j = 0; j < 8; ++j) { const int col = 4 * (lane + 64 * j); ((f32x4*)xr)[lane + 64 * j] = (v[j] * rstd) * *(const f32x4*)(g_final + col); }
    }
}
constexpr int NPH = 12;
struct Args { const float* in[24]; float* out; unsigned char* ws; int ph_lo, ph_hi; };
__global__ void __launch_bounds__(NTHREADS, 2) fwd_kernel(Args args) {
    extern __shared__ __attribute__((aligned(16))) unsigned char lds_raw[];
    LAS unsigned char* lds = (LAS unsigned char*)lds_raw;
    LAS float* sf = (LAS float*)lds;
    LAS int* tb = (LAS int*)(lds + TBL_OFF + 256);
    const int tid = threadIdx.x, lane = tid & 63, wave = __builtin_amdgcn_readfirstlane(tid >> 6);
    const int G = gridDim.x, bx = blockIdx.x;
    const int vcu = (G % 8 == 0) ? (bx % 8) * (G / 8) + bx / 8 : bx;
    const int gw = vcu * NWAVES + wave, NGW = G * NWAVES;
    cg::grid_group grid = cg::this_grid();
    unsigned char* ws = args.ws;
    const float* x = args.in[0]; const float* cvec = args.in[1]; const float* ctx = args.in[2]; const float* c_ctx = args.in[3];
    const float* w_ada = args.in[4]; const float* b_ada = args.in[5]; const float* g_norm1 = args.in[6]; const float* g_norm2 = args.in[7];
    const float* w_in = args.in[8]; const float* b_gate = args.in[9]; const float* a_log = args.in[10]; const float* dt_bias = args.in[11];
    const float* w_conv = args.in[12]; const float* g_head_m = args.in[13]; const float* g_head_d = args.in[14]; const float* w_out = args.in[15];
    const float* w_grp = args.in[16]; const float* b_grp = args.in[17]; const float* w_rtr = args.in[18]; const float* b_rtr = args.in[19];
    const float* w1 = args.in[20]; const float* w3 = args.in[21]; const float* w2 = args.in[22]; const float* g_final = args.in[23];
    float* out = args.out;
    unsigned* ctl = (unsigned*)(ws + WS_CTL); unsigned* cnt = ctl + CW_CNT;
    float* ADA = (float*)(ws + WS_ADA); float* GF = (float*)(ws + WS_GF); float* MLG = (float*)(ws + WS_MLG); float* GDG = (float*)(ws + WS_GDG);
    int* TOK_E = (int*)(ws + WS_TOK); int* TOK_P = TOK_E + 2 * ML; float* TOK_W = (float*)(TOK_P + 2 * ML); int* TOK_D = (int*)(TOK_W + 2 * ML);
    bf16* WinT = (bf16*)(ws + WS_WIN); bf16* WoutT = (bf16*)(ws + WS_WOUT); bf16* W13T = (bf16*)(ws + WS_W13); bf16* W2T = (bf16*)(ws + WS_W2);
    bf16* HL = (bf16*)(ws + WS_HL); bf16* Y = (bf16*)(ws + WS_Y); bf16* Z = (bf16*)(ws + WS_Z);
    bf16* GQ = (bf16*)(ws + WS_GQ); bf16* GK = (bf16*)(ws + WS_GK); bf16* GV = (bf16*)(ws + WS_GV); bf16* MO = (bf16*)(ws + WS_MO); bf16* GO = (bf16*)(ws + WS_GO);
    bf16* HL2 = (bf16*)(ws + WS_HL2); bf16* XB = (bf16*)(ws + WS_XB); bf16* HB = (bf16*)(ws + WS_H); bf16* YE = (bf16*)(ws + WS_YE);

    const int lo = args.ph_lo, hi = args.ph_hi;
#define IN(k) (lo <= (k) && (k) < hi)
#define SEAM(k) do { if (IN(k) && IN((k) + 1)) grid.sync(); } while (0)

    if (IN(0)) { ph_ada(cvec, c_ctx, w_ada, b_ada, ADA, sf, tid, lane, wave); __syncthreads();
                 ph_transposes(w_in, w_out, w1, w3, w2, ws, lds, gw, NGW, wave, lane); }
    SEAM(0);
    if (IN(1)) ph_norm1(x, ctx, g_norm1, ADA, HL, gw, NGW, lane);
    SEAM(1);
    if (IN(2)) { pg8::DenseSched S; S.init(HL, WinT, MT, NZ, DM, G, bx); pg8::EpiZ E{Z, GF};
                 pg8::gemm_phase<pg8::EpiZ, pg8::DenseSched, true, true>(lds, DM, S, E); }
    SEAM(2);
    if (IN(3)) ph_prep(Z, GF, w_conv, b_gate, a_log, dt_bias, GQ, GK, GV, MLG, GDG, tid, lane, wave);
    SEAM(3);
    if (IN(4)) ph_scan_seq(Z, MLG, GQ, GK, GV, GDG, MO, GO, sf, tid);
    SEAM(4);
    if (IN(5)) ph_combine(Z, MO, GO, g_head_m, g_head_d, Y, gw, NGW, lane);
    SEAM(5);
    if (IN(6)) { pg8::DenseSched S; S.init(Y, WoutT, ML, DM, DM, G, bx); pg8::EpiX1 E{x, out, ADA};
                 pg8::gemm_phase<pg8::EpiX1, pg8::DenseSched, true, true>(lds, DM, S, E); }
    SEAM(6);
    if (IN(7)) ph_norm2_route(out, g_norm2, ADA, w_grp, b_grp, w_rtr, b_rtr, HL2, TOK_E, TOK_P, TOK_W, cnt, sf, tid, lane, wave);
    SEAM(7);
    if (IN(8)) { build_moe_tables(cnt, tb, tid); ph_gather(HL2, TOK_E, TOK_P, TOK_D, XB, tb, gw, NGW, lane); }
    SEAM(8);
    if (IN(9)) { build_moe_tables(cnt, tb, tid);
                 pg8::MoeSched S; S.A = (const char*)XB; S.Bt = (const char*)W13T; S.a_tstep = (size_t)256 * DM * 2; S.b_estep = (size_t)1536 * DM * 2; S.b_tstep = (size_t)256 * DM * 2;
                 S.nN = 6; S.nunits = tb[32] * 6; S.G = G; S.c = bx; S.blk2e = tb + 64;
                 pg8::EpiSwiglu E{HB};
                 pg8::gemm_phase<pg8::EpiSwiglu, pg8::MoeSched, true, true>(lds, DM, S, E); }
    SEAM(9);
    if (IN(10)) { build_moe_tables(cnt, tb, tid);
                  pg8::MoeSched S; S.A = (const char*)HB; S.Bt = (const char*)W2T; S.a_tstep = (size_t)256 * DE * 2; S.b_estep = (size_t)DM * DE * 2; S.b_tstep = (size_t)256 * DE * 2;
                  S.nN = 8; S.nunits = tb[32] * 8; S.G = G; S.c = bx; S.blk2e = tb + 64;
                  pg8::EpiBf E{YE, DM};
                  pg8::gemm_phase<pg8::EpiBf, pg8::MoeSched, true, true>(lds, DE, S, E); }
    SEAM(10);
    if (IN(11)) ph_final(out, YE, TOK_D, TOK_W, ADA, g_final, gw, NGW, lane);
#undef IN
#undef SEAM
}

#ifndef MK_MULTI
#define MK_MULTI 0
#endif
extern "C" void kernel_launch(void* const* d_in, const int* in_sizes, int n_in, void* d_out, int out_size, void* d_ws, size_t ws_size, hipStream_t stream) {
    static int grid = 0;
    if (grid == 0) {
        if (n_in != 24 || in_sizes[0] != ML * DM || out_size != ML * DM || ws_size < WS_END) {
            fprintf(stderr, "kernel_launch: built for 24 inputs, x/out of %d floats, >= %zu bytes of workspace; got n_in %d, in0 %d, out %d, ws %zu; nothing launched\n", ML * DM, (size_t)WS_END, n_in, n_in > 0 ? in_sizes[0] : -1, out_size, ws_size);
            grid = -1; return; }
        int dev = 0, cus = 0, per_cu = 0;
        if (hipGetDevice(&dev) != hipSuccess || hipDeviceGetAttribute(&cus, hipDeviceAttributeMultiprocessorCount, dev) != hipSuccess) { fprintf(stderr, "kernel_launch: device query failed\n"); grid = -1; return; }
        if (hipFuncSetAttribute((const void*)fwd_kernel, hipFuncAttributeMaxDynamicSharedMemorySize, LDS_BYTES) != hipSuccess) { fprintf(stderr, "kernel_launch: hipFuncSetAttribute failed\n"); grid = -1; return; }
        if (hipOccupancyMaxActiveBlocksPerMultiprocessor(&per_cu, (const void*)fwd_kernel, NTHREADS, LDS_BYTES) != hipSuccess || per_cu < 1) { fprintf(stderr, "kernel_launch: occupancy query says %d blocks per CU\n", per_cu); (void)hipGetLastError(); grid = -1; return; }
        grid = cus;
        fprintf(stderr, "kernel_launch: %d CUs, occupancy %d per CU, grid %d\n", cus, per_cu, grid);
    }
    if (grid < 0) return;
    if (hipMemsetAsync((char*)d_ws + WS_CTL, 0, CTL_ZERO_BYTES, stream) != hipSuccess) { fprintf(stderr, "kernel_launch: memset failed\n"); return; }
    Args a{};
    for (int i = 0; i < 24; ++i) a.in[i] = (const float*)d_in[i];
    a.out = (float*)d_out; a.ws = (unsigned char*)d_ws;
#if MK_MULTI
    for (int ph = 0; ph < NPH; ++ph) { a.ph_lo = ph; a.ph_hi = ph + 1; hipLaunchKernelGGL(fwd_kernel, dim3(grid), dim3(NTHREADS), LDS_BYTES, stream, a); }
#else
    a.ph_lo = 0; a.ph_hi = NPH;
    void* params[] = {&a};
    const hipError_t e = hipLaunchCooperativeKernel((const void*)fwd_kernel, dim3(grid), dim3(NTHREADS), params, LDS_BYTES, stream);
    if (e != hipSuccess) fprintf(stderr, "kernel_launch: cooperative launch failed: %s (grid %d)\n", hipGetErrorString(e), grid);
#endif
}
```

```cpp
#include <hip/hip_runtime.h>
#include <hip/hip_cooperative_groups.h>
#include <cstdio>
#include <cstdint>
namespace cg = cooperative_groups;

constexpr int DM = 2048, NB = 2, SEQ = 8192, CTXL = 256;
constexpr int ML = NB * SEQ;
constexpr int MC = NB * CTXL;
constexpr int MT = ML + MC;
constexpr int DIN = 7216, NZ = 7424, ZLD = 7168, GFLD = 64;
constexpr int NE = 32, DE = 768;
constexpr float EPSF = 1e-6f;
constexpr int ZC_MQ = 0, ZC_MK = 512, ZC_MV = 1024, ZC_MO = 2048, ZC_GO = 3072;

constexpr size_t MiB = 1u << 20;
constexpr size_t WS_CTL = 0, CTL_ZERO_BYTES = 1 * MiB;
constexpr size_t WS_ADA = 1 * MiB;
constexpr size_t WS_GF = 2 * MiB;
constexpr size_t WS_MLG = 7 * MiB;
constexpr size_t WS_GDG = 9 * MiB;
constexpr size_t WS_TOK = 12 * MiB;
constexpr size_t WS_WIN = 13 * MiB;
constexpr size_t WS_WOUT = 42 * MiB;
constexpr size_t WS_W13 = 50 * MiB;
constexpr size_t WS_W2 = 242 * MiB;
constexpr size_t WS_Z2 = 50 * MiB;
constexpr size_t WS_HL = 149 * MiB;
constexpr size_t WS_GV = 215 * MiB;
constexpr size_t WS_Z1 = 338 * MiB;
constexpr size_t WS_GQ = 470 * MiB, WS_GK = 503 * MiB;
constexpr size_t WS_Y = 470 * MiB;
constexpr size_t WS_GW = 536 * MiB, WS_GU = 602 * MiB, WS_GA = 668 * MiB, WS_GSC = 701 * MiB;
constexpr size_t WS_MS = 705 * MiB, WS_MSC = 722 * MiB;
constexpr size_t WS_MO = 724 * MiB, WS_GO = 788 * MiB;
constexpr size_t WS_DEN = 12 * MiB + 512 * 1024;
constexpr size_t WS_HL2 = 338 * MiB;
constexpr size_t WS_XB = 402 * MiB;
constexpr size_t WS_H = 562 * MiB;
constexpr size_t WS_YE = 622 * MiB;
constexpr size_t WS_X1B = 788 * MiB;
constexpr size_t WS_END = 852 * MiB;
constexpr int Z1LD = 4096, Z2LD = 3072;
static_assert(WS_Z2 + (size_t)MT * Z2LD * 2 <= WS_HL && WS_HL + (size_t)MT * 2048 * 2 <= WS_GV && WS_GV + (size_t)MT * 1024 * 2 <= WS_Z1, "ws map: pre-scan overlays of the expert region");
static_assert(WS_Z1 + (size_t)MT * Z1LD * 2 <= WS_GQ && WS_GK + (size_t)MT * 1024 * 2 <= WS_GW && WS_GSC + (size_t)2112 * 2 * 192 * 4 <= WS_MS && WS_MS + (size_t)1056 * 2 * 4096 * 2 <= WS_MSC && WS_MSC + (size_t)1056 * 2 * 192 * 4 <= WS_MO && WS_GO + (size_t)2 * ML * 1024 * 2 <= WS_END, "ws map A");
static_assert(WS_GW + (size_t)2112 * 2 * 8192 * 2 <= WS_GU && WS_GU + (size_t)2112 * 2 * 8192 * 2 <= WS_GA && WS_GA + (size_t)2112 * 2 * 4096 * 2 <= WS_GSC, "ws map gdn operands");
static_assert(WS_HL2 + (size_t)ML * 2048 * 2 <= WS_XB && WS_XB + (size_t)40960 * 4096 <= WS_H && WS_H + (size_t)40960 * 1536 <= WS_YE && WS_YE + (size_t)40960 * 4096 <= WS_END, "ws map B");
static_assert(WS_WIN + (size_t)NZ * 2048 * 2 <= WS_WOUT && WS_W13 + (size_t)32 * 1536 * 2048 * 2 <= WS_W2 && WS_W2 + (size_t)32 * 2048 * 768 * 2 <= WS_Z1 && WS_Y + (size_t)ML * 2048 * 2 <= WS_GW, "ws map W");
constexpr int CW_TMO = 0, CW_CNT = 1024, CW_BAR = 4096;

constexpr int SCR_BYTES = 161792;
constexpr int TBL_OFF = SCR_BYTES;
constexpr int LDS_BYTES = 163840;
constexpr int NWAVES = 8, NTHREADS = 512;
#ifndef MLSTM_CHUNKED
#define MLSTM_CHUNKED 1
#endif
#ifndef GDN_CHUNKED
#define GDN_CHUNKED 1
#endif
#ifndef USE_CG_SYNC
#define USE_CG_SYNC 1
#endif
#ifndef TR_BLOCKS
#define TR_BLOCKS 128
#endif
#ifndef SCAN_PROBE_WHICH
#define SCAN_PROBE_WHICH 3
#endif
#ifndef SCAN_PROBE_MODE
#define SCAN_PROBE_MODE 0
#endif
#ifndef REPEAT_MASK
#define REPEAT_MASK 0
#endif
#ifndef E6_ABS
#define E6_ABS 0.02f
#endif
#ifndef E6_REL
#define E6_REL 0.05f
#endif
#ifndef GDN_E5
#define GDN_E5 0
#endif
#ifndef GDN_SCAN_SEQ
#define GDN_SCAN_SEQ 0
#endif

namespace pg8 {
#define PG8_LAS __attribute__((address_space(3)))
typedef unsigned short bf16_t;
typedef short bf16x8 __attribute__((ext_vector_type(8)));
typedef float f32x4 __attribute__((ext_vector_type(4)));
typedef unsigned u32x4 __attribute__((ext_vector_type(4)));
constexpr int BM = 256, BK = 64, HALF = 128, HTB = HALF * BK * 2  , STAGE_BYTES = 8 * HTB, NXCD = 8, WGM = 8;

__host__ __device__ __forceinline__ int lds_byte(int r, int c) { const int st = (r >> 4) * 2 + (c >> 5), rr = r & 15, cc = c & 31, ob = rr * 64 + cc * 2; return st * 1024 + (ob ^ (((ob >> 9) & 1) << 5)); }
__host__ __device__ __forceinline__ void stage_rc(int b, int& R, int& C) { const int st = b / 1024, sb = b % 1024, swz = sb ^ (((sb >> 9) & 1) << 5); R = (st >> 1) * 16 + swz / 64; C = (st & 1) * 32 + (swz % 64) / 2; }
__host__ __device__ __forceinline__ int perm32(int rho) { const int n = rho >> 4, i = rho & 15; return 8 * (i >> 2) + 4 * n + (i & 3); }

struct Unit { int pm, pn; };

struct DenseSched {
    const char* A; const char* Bt; size_t tstep; int nM, nN, nwg, G, c;
    __device__ __forceinline__ void init(const void* A_, const void* Bt_, int M, int N, int K, int G_, int c_) { A = (const char*)A_; Bt = (const char*)Bt_; tstep = (size_t)BM * K * 2; nM = M / BM; nN = N / BM; nwg = nM * nN; G = G_; c = c_; }
    __device__ __forceinline__ bool next(int i, Unit& u) const {
        const long L = (long)i * G + c; if (L >= nwg) return false;
        int wgid = (int)L; { const int q = nwg / NXCD, r = nwg % NXCD, xcd = wgid % NXCD, off = wgid / NXCD; wgid = (xcd < r ? xcd * (q + 1) : r * (q + 1) + (xcd - r) * q) + off; }
        const int nig = WGM * nN, gid = wgid / nig, fm = gid * WGM, gsz = (nM - fm) < WGM ? (nM - fm) : WGM;
        u.pm = fm + ((wgid % nig) % gsz); u.pn = (wgid % nig) / gsz; return true;
    }
    __device__ __forceinline__ const char* a_base(const Unit& u) const { return A + (size_t)u.pm * tstep; }
    __device__ __forceinline__ const char* b_base(const Unit& u) const { return Bt + (size_t)u.pn * tstep; }
    __device__ __forceinline__ void a_ready(const Unit&) const {}
    __device__ __forceinline__ void done(const Unit&) const {}
};
struct MoeSched {
    const char* A; const char* Bt; size_t a_tstep, b_estep, b_tstep; int nN, nunits, G, c; const PG8_LAS int* blk2e;
    __device__ __forceinline__ bool next(int i, Unit& u) const { const long L = (long)i * G + c; if (L >= nunits) return false; u.pm = (int)L / nN; u.pn = (int)L % nN; return true; }
    __device__ __forceinline__ const char* a_base(const Unit& u) const { return A + (size_t)u.pm * a_tstep; }
    __device__ __forceinline__ const char* b_base(const Unit& u) const { return Bt + (size_t)blk2e[u.pm] * b_estep + (size_t)u.pn * b_tstep; }
    __device__ __forceinline__ void a_ready(const Unit&) const {}
    __device__ __forceinline__ void done(const Unit&) const {}
};

typedef float f32x2_cv __attribute__((ext_vector_type(2)));
typedef __bf16 bf16x2_cv __attribute__((ext_vector_type(2)));
__device__ __forceinline__ unsigned cvt_pk_bf16(float lo, float hi) { const f32x2_cv v = {lo, hi}; const bf16x2_cv b = __builtin_convertvector(v, bf16x2_cv); return __builtin_bit_cast(unsigned, b); }
__device__ __forceinline__ u32x4 pack8(const f32x4 v0, const f32x4 v1) { u32x4 w; w.x = cvt_pk_bf16(v0[0], v0[1]); w.y = cvt_pk_bf16(v0[2], v0[3]); w.z = cvt_pk_bf16(v1[0], v1[1]); w.w = cvt_pk_bf16(v1[2], v1[3]); return w; }

struct EpiZ {
    static constexpr bool PERM = true, AFTER_DRAIN = false;
    bf16_t* Z1; bf16_t* Z2; float* GF;
    __device__ __forceinline__ void operator()(const f32x4 (&acc)[2][2][4][2], const Unit& u, int wr, int wc, int fr, int fq) const {
        const int row0 = u.pm * BM + wr * 64 + fr;
        if (u.pn < 28) {
            const bool second = u.pn >= 12 && u.pn < 24;
            bf16_t* base = second ? Z2 : Z1; const int ld = second ? 3072 : 4096;
            const int col0 = (second ? u.pn - 12 : (u.pn < 12 ? u.pn : u.pn - 12)) * BM + wc * 32 + 8 * fq;
#pragma unroll
            for (int ai = 0; ai < 2; ++ai)
#pragma unroll
                for (int m = 0; m < 4; ++m) { bf16_t* rowp = base + (size_t)(row0 + ai * HALF + m * 16) * ld + col0;
#pragma unroll
                    for (int bj = 0; bj < 2; ++bj) *(u32x4*)(rowp + bj * HALF) = pack8(acc[ai][bj][m][0], acc[ai][bj][m][1]); }
        } else if (wc < 2) {
            const int col0 = wc * 32 + 8 * fq;
#pragma unroll
            for (int ai = 0; ai < 2; ++ai)
#pragma unroll
                for (int m = 0; m < 4; ++m) { float* rowp = GF + (size_t)(row0 + ai * HALF + m * 16) * 64 + col0;
                    *(f32x4*)(rowp) = acc[ai][0][m][0]; *(f32x4*)(rowp + 4) = acc[ai][0][m][1]; }
        }
    }
};
struct EpiX1 {
    static constexpr bool PERM = true, AFTER_DRAIN = false;
    const float* x; bf16_t* out; const float* ada;
    __device__ __forceinline__ void operator()(const f32x4 (&acc)[2][2][4][2], const Unit& u, int wr, int wc, int fr, int fq) const {
        const int row0 = u.pm * BM + wr * 64 + fr, col0 = u.pn * BM + wc * 32 + 8 * fq;
        const float* gt = ada + (size_t)((u.pm * BM) / 8192) * 12288 + 4096 + col0;
        f32x4 g[2][2];
#pragma unroll
        for (int bj = 0; bj < 2; ++bj)
#pragma unroll
            for (int n = 0; n < 2; ++n) g[bj][n] = *(const f32x4*)(gt + bj * HALF + 4 * n);
#pragma unroll
        for (int ai = 0; ai < 2; ++ai)
#pragma unroll
            for (int m = 0; m < 4; ++m) { const size_t off = (size_t)(row0 + ai * HALF + m * 16) * 2048 + col0;
#pragma unroll
                for (int bj = 0; bj < 2; ++bj) { const f32x4 x0 = *(const f32x4*)(x + off + bj * HALF), x1 = *(const f32x4*)(x + off + bj * HALF + 4);
                    *(u32x4*)(out + off + bj * HALF) = pack8(x0 + g[bj][0] * acc[ai][bj][m][0], x1 + g[bj][1] * acc[ai][bj][m][1]); } }
    }
};
struct EpiSwiglu {
    static constexpr bool PERM = true, AFTER_DRAIN = false;
    bf16_t* H;
    __device__ __forceinline__ void operator()(const f32x4 (&acc)[2][2][4][2], const Unit& u, int wr, int wc, int fr, int fq) const {
        const int row0 = u.pm * BM + wr * 64 + fr, col0 = u.pn * HALF + wc * 32 + 8 * fq;
#pragma unroll
        for (int ai = 0; ai < 2; ++ai)
#pragma unroll
            for (int m = 0; m < 4; ++m) { f32x4 h[2];
#pragma unroll
                for (int n = 0; n < 2; ++n)
#pragma unroll
                    for (int r = 0; r < 4; ++r) { const float a = acc[ai][0][m][n][r]; h[n][r] = a / (1.f + __expf(-a)) * acc[ai][1][m][n][r]; }
                *(u32x4*)(H + (size_t)(row0 + ai * HALF + m * 16) * 768 + col0) = pack8(h[0], h[1]); }
    }
};
struct EpiBf {
    static constexpr bool PERM = true, AFTER_DRAIN = false;
    bf16_t* O; int ldc;
    __device__ __forceinline__ void operator()(const f32x4 (&acc)[2][2][4][2], const Unit& u, int wr, int wc, int fr, int fq) const {
        const int row0 = u.pm * BM + wr * 64 + fr, col0 = u.pn * BM + wc * 32 + 8 * fq;
#pragma unroll
        for (int ai = 0; ai < 2; ++ai)
#pragma unroll
            for (int m = 0; m < 4; ++m) { bf16_t* rowp = O + (size_t)(row0 + ai * HALF + m * 16) * ldc + col0;
#pragma unroll
                for (int bj = 0; bj < 2; ++bj) *(u32x4*)(rowp + bj * HALF) = pack8(acc[ai][bj][m][0], acc[ai][bj][m][1]); }
    }
};

template <class Epi, class Sched, bool ALIGN_EPI = false, bool SP2 = false>
__device__ __forceinline__ void gemm_phase(PG8_LAS unsigned char* lds, const int K, const Sched& S, const Epi& E) {
    const int tid = threadIdx.x, wid = __builtin_amdgcn_readfirstlane(tid >> 6), lane = tid & 63, wr = wid >> 2, wc = wid & 3, fr = lane & 15, fq = lane >> 4;
    const int nt = K / BK;
    unsigned voffA[2], voffB[2];
#pragma unroll
    for (int i = 0; i < 2; ++i) { int R, C; stage_rc(tid * 16 + i * 8192, R, C); const int Rb = Epi::PERM ? ((R & ~31) + perm32(R & 31)) : R;
        voffA[i] = (unsigned)(R * K + C) * 2u; voffB[i] = (unsigned)(Rb * K + C) * 2u; }
    const size_t kstep = (size_t)(BK * 2);
    const size_t hstep = (size_t)HALF * K * 2;
    const unsigned ldsw = (unsigned)wid * 1024u;
    const int aoff = lds_byte(wr * 64 + fr, fq * 8), boff = lds_byte(wc * 32 + fr, fq * 8);
#define PG8_SA(b, h) (((b) * 2 + (h)) * HTB)
#define PG8_SB(b, h) ((4 + (b) * 2 + (h)) * HTB)
#define PG8_STAGE(bufoff, gbase, voff) do { _Pragma("unroll") for (int _i = 0; _i < 2; ++_i) \
        __builtin_amdgcn_global_load_lds((const unsigned*)((const char*)(gbase) + (voff)[_i]), (PG8_LAS unsigned*)(lds + (bufoff) + ldsw + _i * 8192), 16, 0, 0); } while (0)
#define PG8_LDA(dst, b, h) do { _Pragma("unroll") for (int m = 0; m < 4; ++m) _Pragma("unroll") for (int k = 0; k < 2; ++k) dst[m][k] = *(const PG8_LAS bf16x8*)(lds + PG8_SA(b, h) + aoff + m * 2048 + k * 1024); } while (0)
#define PG8_LDB(dst, b, h) do { _Pragma("unroll") for (int n = 0; n < 2; ++n) _Pragma("unroll") for (int k = 0; k < 2; ++k) dst[n][k] = *(const PG8_LAS bf16x8*)(lds + PG8_SB(b, h) + boff + n * 2048 + k * 1024); } while (0)
#define PG8_MMA(ai, bj, At, Bt) do { __builtin_amdgcn_s_setprio(1); _Pragma("unroll") for (int m = 0; m < 4; ++m) _Pragma("unroll") for (int n = 0; n < 2; ++n) _Pragma("unroll") for (int k = 0; k < 2; ++k) \
        acc[ai][bj][m][n] = __builtin_amdgcn_mfma_f32_16x16x32_bf16(Bt[n][k], At[m][k], acc[ai][bj][m][n], 0, 0, 0); __builtin_amdgcn_s_setprio(0); } while (0)
#define PG8_WAIT_V(n) asm volatile("s_waitcnt vmcnt(" #n ")" ::: "memory")
#define PG8_WAIT_L(n) asm volatile("s_waitcnt lgkmcnt(" #n ")" ::: "memory")
#define PG8_BAR __builtin_amdgcn_s_barrier()
#define PG8_SCHED __builtin_amdgcn_sched_barrier(0)
    Unit cur, nxt; int ui = 0;
    if (!S.next(0, cur)) return;
    f32x4 acc[2][2][4][2];
#pragma unroll
    for (int a = 0; a < 2; ++a)
#pragma unroll
        for (int b = 0; b < 2; ++b)
#pragma unroll
            for (int m = 0; m < 4; ++m)
#pragma unroll
                for (int n = 0; n < 2; ++n) acc[a][b][m][n] = (f32x4){0.f, 0.f, 0.f, 0.f};
    bf16x8 At[4][2], B0[2][2], B1[2][2];
    const char* cA = S.a_base(cur); const char* cB = S.b_base(cur);
    S.a_ready(cur);
    if constexpr (SP2) {
        PG8_STAGE(PG8_SB(0, 0), cB, voffB); PG8_STAGE(PG8_SB(0, 1), cB + hstep, voffB); PG8_STAGE(PG8_SA(0, 0), cA, voffA); PG8_STAGE(PG8_SA(0, 1), cA + hstep, voffA);
        if (wr == 1) PG8_BAR;
        PG8_WAIT_V(2); PG8_BAR;
        PG8_STAGE(PG8_SB(1, 0), cB + kstep, voffB); PG8_STAGE(PG8_SA(1, 0), cA + kstep, voffA); PG8_STAGE(PG8_SB(1, 1), cB + hstep + kstep, voffB);
        PG8_WAIT_V(6); PG8_BAR;
    } else {
        PG8_STAGE(PG8_SB(0, 0), cB, voffB); PG8_STAGE(PG8_SA(0, 0), cA, voffA); PG8_STAGE(PG8_SB(0, 1), cB + hstep, voffB); PG8_STAGE(PG8_SA(0, 1), cA + hstep, voffA);
        if (wr == 1) PG8_BAR;
        PG8_WAIT_V(4); PG8_BAR;
        PG8_STAGE(PG8_SB(1, 0), cB + kstep, voffB); PG8_STAGE(PG8_SA(1, 0), cA + kstep, voffA); PG8_STAGE(PG8_SB(1, 1), cB + hstep + kstep, voffB);
        PG8_WAIT_V(6); PG8_BAR;
    }
    for (;;) {
        const bool has_next = S.next(ui + 1, nxt);
        const char* nA = has_next ? S.a_base(nxt) : cA; const char* nB = has_next ? S.b_base(nxt) : cB;
        for (int t = 0; t < nt; t += 2) {
            const bool last = (t == nt - 2);
            const char* a1 = cA + (size_t)(t + 1) * kstep;
            const char* a2 = last ? nA : cA + (size_t)(t + 2) * kstep; const char* b2 = last ? nB : cB + (size_t)(t + 2) * kstep;
            const char* a3 = a2 + kstep; const char* b3 = b2 + kstep;
            if (last && has_next) S.a_ready(nxt);
            if constexpr (SP2) {
            PG8_LDB(B0, 0, 0); PG8_LDB(B1, 0, 1); PG8_SCHED; PG8_LDA(At, 0, 0); PG8_STAGE(PG8_SA(1, 1), a1 + hstep, voffA);
            PG8_WAIT_V(8); PG8_WAIT_L(0); PG8_BAR; PG8_MMA(0, 0, At, B0); PG8_MMA(0, 1, At, B1); PG8_BAR; PG8_SCHED;
            PG8_LDA(At, 0, 1); PG8_STAGE(PG8_SB(0, 0), b2, voffB); PG8_STAGE(PG8_SB(0, 1), b2 + hstep, voffB); PG8_STAGE(PG8_SA(0, 0), a2, voffA);
            PG8_WAIT_V(8); PG8_WAIT_L(0); PG8_BAR; PG8_MMA(1, 0, At, B0); PG8_MMA(1, 1, At, B1); PG8_BAR; PG8_SCHED;
            PG8_LDB(B0, 1, 0); PG8_LDB(B1, 1, 1); PG8_SCHED; PG8_LDA(At, 1, 0); PG8_STAGE(PG8_SA(0, 1), a2 + hstep, voffA);
            PG8_WAIT_V(8); PG8_WAIT_L(0); PG8_BAR; PG8_MMA(0, 0, At, B0); PG8_MMA(0, 1, At, B1); PG8_BAR; PG8_SCHED;
            PG8_LDA(At, 1, 1); PG8_STAGE(PG8_SB(1, 0), b3, voffB); PG8_STAGE(PG8_SB(1, 1), b3 + hstep, voffB); PG8_STAGE(PG8_SA(1, 0), a3, voffA);
            PG8_WAIT_V(8); PG8_WAIT_L(0); PG8_BAR; PG8_MMA(1, 0, At, B0); PG8_MMA(1, 1, At, B1); PG8_BAR; PG8_SCHED;
            } else {
            PG8_LDB(B0, 0, 0); PG8_SCHED; PG8_LDA(At, 0, 0); PG8_STAGE(PG8_SA(1, 1), a1 + hstep, voffA);
            PG8_WAIT_L(8); PG8_BAR; PG8_WAIT_L(0); PG8_MMA(0, 0, At, B0); PG8_BAR; PG8_SCHED;
            PG8_LDB(B1, 0, 1); PG8_STAGE(PG8_SB(0, 0), b2, voffB);
            PG8_BAR; PG8_WAIT_L(0); PG8_MMA(0, 1, At, B1); PG8_BAR;
            PG8_LDA(At, 0, 1); PG8_STAGE(PG8_SA(0, 0), a2, voffA);
            PG8_BAR; PG8_WAIT_L(0); PG8_MMA(1, 0, At, B0); PG8_BAR; PG8_SCHED;
            PG8_STAGE(PG8_SB(0, 1), b2 + hstep, voffB);
            PG8_WAIT_V(6); PG8_BAR; PG8_MMA(1, 1, At, B1); PG8_BAR;
            PG8_LDB(B0, 1, 0); PG8_SCHED; PG8_LDA(At, 1, 0); PG8_STAGE(PG8_SA(0, 1), a2 + hstep, voffA);
            PG8_WAIT_L(8); PG8_BAR; PG8_WAIT_L(0); PG8_MMA(0, 0, At, B0); PG8_BAR; PG8_SCHED;
            PG8_LDB(B1, 1, 1); PG8_STAGE(PG8_SB(1, 0), b3, voffB);
            PG8_BAR; PG8_WAIT_L(0); PG8_MMA(0, 1, At, B1); PG8_BAR;
            PG8_LDA(At, 1, 1); PG8_STAGE(PG8_SA(1, 0), a3, voffA);
            PG8_BAR; PG8_WAIT_L(0); PG8_MMA(1, 0, At, B0); PG8_BAR; PG8_SCHED;
            PG8_STAGE(PG8_SB(1, 1), b3 + hstep, voffB);
            PG8_WAIT_V(6); PG8_BAR; PG8_MMA(1, 1, At, B1); PG8_BAR;
            }
        }
        if constexpr (ALIGN_EPI) { if (wr == 0) PG8_BAR; }
        if constexpr (!Epi::AFTER_DRAIN) { E(acc, cur, wr, wc, fr, fq); S.done(cur); }
        if (!has_next) break;
#pragma unroll
        for (int a = 0; a < 2; ++a)
#pragma unroll
            for (int b = 0; b < 2; ++b)
#pragma unroll
                for (int m = 0; m < 4; ++m)
#pragma unroll
                    for (int n = 0; n < 2; ++n) acc[a][b][m][n] = (f32x4){0.f, 0.f, 0.f, 0.f};
        cur = nxt; cA = nA; cB = nB; ++ui;
        if constexpr (ALIGN_EPI) { if (wr == 1) PG8_BAR; }
    }
    PG8_WAIT_V(0);
    if constexpr (!ALIGN_EPI) { if (wr == 0) PG8_BAR; }
    PG8_BAR;
    if constexpr (Epi::AFTER_DRAIN) { E.fused(acc, cur, wr, wc, fr, fq, lds, wid, lane); S.done(cur); }
#undef PG8_SA
#undef PG8_SB
#undef PG8_STAGE
#undef PG8_LDA
#undef PG8_LDB
#undef PG8_MMA
#undef PG8_WAIT_V
#undef PG8_WAIT_L
#undef PG8_BAR
#undef PG8_SCHED
}
}
#define GAS __attribute__((address_space(1)))
#define LAS __attribute__((address_space(3)))
typedef unsigned short bf16;
typedef unsigned v4u __attribute__((ext_vector_type(4)));
typedef float f32x4 __attribute__((ext_vector_type(4)));
typedef short bf16x8 __attribute__((ext_vector_type(8)));
typedef GAS unsigned gu32;
typedef GAS unsigned long long gu64;
#define RLX_AGENT __ATOMIC_RELAXED, __HIP_MEMORY_SCOPE_AGENT
#define LDS_WAIT() asm volatile("s_waitcnt lgkmcnt(0)" ::: "memory")
#define VM_WAIT() asm volatile("s_waitcnt vmcnt(0)" ::: "memory")
__device__ __forceinline__ unsigned long long rt() { return __builtin_amdgcn_s_memrealtime(); }
__device__ __forceinline__ unsigned f2bf(float f) { unsigned u = __builtin_bit_cast(unsigned, f); return (u + 0x7fffu + ((u >> 16) & 1u)) >> 16; }
__device__ __forceinline__ unsigned pk2(float lo, float hi) { return f2bf(lo) | (f2bf(hi) << 16); }
typedef unsigned u32x4v_t __attribute__((ext_vector_type(4)));
typedef short v4i16_t __attribute__((ext_vector_type(4)));
__device__ __forceinline__ v4i16_t tr16(const LAS unsigned char* p) { return __builtin_amdgcn_ds_read_tr16_b64_v4i16((LAS v4i16_t*)p); }
__device__ __forceinline__ bf16x8 cat8(v4i16_t lo, v4i16_t hi) { bf16x8 r; r[0] = lo[0]; r[1] = lo[1]; r[2] = lo[2]; r[3] = lo[3]; r[4] = hi[0]; r[5] = hi[1]; r[6] = hi[2]; r[7] = hi[3]; return r; }
__device__ __forceinline__ bf16x8 packacc(const f32x4 a, const f32x4 b) {
    u32x4v_t w; w[0] = pg8::cvt_pk_bf16(a[0], a[1]); w[1] = pg8::cvt_pk_bf16(a[2], a[3]); w[2] = pg8::cvt_pk_bf16(b[0], b[1]); w[3] = pg8::cvt_pk_bf16(b[2], b[3]); return __builtin_bit_cast(bf16x8, w);
}
#define LDS_BARRIER() do { asm volatile("s_waitcnt lgkmcnt(0)" ::: "memory"); __builtin_amdgcn_s_barrier(); asm volatile("" ::: "memory"); } while (0)
#define MFMA16(a, b, c) __builtin_amdgcn_mfma_f32_16x16x32_bf16((a), (b), (c), 0, 0, 0)

#define XB_TMO      128
#define XB_XCNT(j)  (256  + 64 * (j))
#define XB_XSUB(j)  (1280 + 64 * (j))
#define XB_XGEN(j)  (2304 + 64 * (j))
#define XB_TOP      3328
#define XB_TOPGEN   3392
#define XCD_BAR_WORDS 3456
#define XB_SPIN_CAP (1u << 18)

__device__ __forceinline__ unsigned xb_ld(unsigned* p)              { return __hip_atomic_load(p, __ATOMIC_RELAXED, __HIP_MEMORY_SCOPE_AGENT); }
__device__ __forceinline__ unsigned xb_add(unsigned* p, unsigned v) { return __hip_atomic_fetch_add(p, v, __ATOMIC_RELAXED, __HIP_MEMORY_SCOPE_AGENT); }
__device__ __forceinline__ unsigned xb_xcc_id() { return (unsigned)__builtin_amdgcn_s_getreg((3 << 11) | 20) & 0xFu; }
#define XB_SPIN(cond, bar) do { unsigned _sp = 0; while (cond) { __builtin_amdgcn_s_sleep(1); \
    if ((++_sp & 255u) == 0u) { if (xb_ld(&(bar)[XB_TMO])) break; if (_sp > XB_SPIN_CAP) { atomicAdd(&(bar)[XB_TMO], 1u); break; } } } } while (0)

struct XcdBarrier {
    unsigned* bar; unsigned x;
    volatile LAS unsigned* st;
};

__device__ __forceinline__ XcdBarrier xcd_barrier_post(unsigned* bar, volatile LAS unsigned* st) {
    XcdBarrier b; b.bar = bar; b.x = xb_xcc_id(); b.st = st;
    if (threadIdx.x == 0) (void)xb_add(&bar[XB_XCNT(b.x)], 1u);
    return b;
}
__device__ __forceinline__ void xcd_barrier_complete(unsigned* bar, unsigned x, unsigned& nloc, unsigned& nx) {
    const unsigned G = gridDim.x * gridDim.y * gridDim.z;
    unsigned sum, cnt, mine, sp = 0u;
    for (;;) {
        sum = 0u; cnt = 0u; mine = 0u;
#pragma unroll
        for (unsigned j = 0; j < 16; ++j) { const unsigned c = xb_ld(&bar[XB_XCNT(j)]); sum += c; cnt += (c > 0u) ? 1u : 0u; mine = (j == x) ? c : mine; }
        if (sum == G) break;
        __builtin_amdgcn_s_sleep(1);
        if ((++sp & 255u) == 0u) { if (xb_ld(&bar[XB_TMO])) break; if (sp > XB_SPIN_CAP) { atomicAdd(&bar[XB_TMO], 1u); break; } }
    }
    nloc = mine > 0u ? mine : 1u; nx = cnt > 0u ? cnt : 1u;
}

__device__ __forceinline__ void xcd_barrier(const XcdBarrier& b) {
    asm volatile("s_waitcnt vmcnt(0)" ::: "memory");
    __syncthreads();
    if (threadIdx.x == 0) {
        unsigned* bar = b.bar;
        __builtin_amdgcn_s_waitcnt(0);
        unsigned nloc = b.st[0], nx = b.st[1];
        if (nloc == 0u) { xcd_barrier_complete(bar, b.x, nloc, nx); b.st[0] = nloc; b.st[1] = nx; }
        const unsigned old = xb_add(&bar[XB_XSUB(b.x)], 1u);
        const unsigned gen = old / nloc;
        if (old + 1u == (gen + 1u) * nloc) {
            __builtin_amdgcn_fence(__ATOMIC_RELEASE, "agent");
            asm volatile("s_waitcnt vmcnt(0)" ::: "memory");
            const unsigned og = xb_add(&bar[XB_TOP], 1u);
            const unsigned tg = og / nx;
            if (og + 1u == (tg + 1u) * nx) xb_add(&bar[XB_TOPGEN], 1u);
            else XB_SPIN(xb_ld(&bar[XB_TOPGEN]) == tg, bar);
            __builtin_amdgcn_fence(__ATOMIC_ACQUIRE, "agent");
            xb_add(&bar[XB_XGEN(b.x)], 1u);
            asm volatile("s_waitcnt vmcnt(0)" ::: "memory");
        } else {
            XB_SPIN(xb_ld(&bar[XB_XGEN(b.x)]) == gen, bar);
            __builtin_amdgcn_fence(__ATOMIC_ACQUIRE, "agent");
            asm volatile("s_waitcnt vmcnt(0)" ::: "memory");
        }
    }
    __syncthreads();
}
typedef float f32x2 __attribute__((ext_vector_type(2)));
typedef unsigned u32x2 __attribute__((ext_vector_type(2)));
__device__ __forceinline__ float wave_sum(float v) {
#pragma unroll
    for (int o = 1; o < 64; o <<= 1) v += __shfl_xor(v, o);
    return v;
}
__device__ __forceinline__ float bf_lo(unsigned u) { return __builtin_bit_cast(float, u << 16); }
__device__ __forceinline__ float bf_hi(unsigned u) { return __builtin_bit_cast(float, u & 0xffff0000u); }
__device__ __forceinline__ float sigmoidf_(float v) { return 1.f / (1.f + expf(-v)); }
__device__ __forceinline__ float siluf_(float v) { return v / (1.f + expf(-v)); }
__device__ __forceinline__ float softplusf_(float v) { return fmaxf(v, 0.f) + log1pf(expf(-fabsf(v))); }

__device__ __forceinline__ void ph_ada(const float* c, const float* c_ctx, const float* w_ada, const float* b_ada, float* ADA, LAS float* sf, int tid, int lane, int wave) {
    if ((int)blockIdx.x >= 192) return;
    for (int i = tid; i < 3 * 2048; i += NTHREADS) { const float v = (i < 4096) ? c[i] : c_ctx[i - 4096]; sf[i] = siluf_(v); }
    __syncthreads();
    for (int task = blockIdx.x; task < 192; task += gridDim.x) {
        const int r4 = lane >> 4, c4 = lane & 15;
        const float* wp = w_ada + (size_t)(wave * 256 + r4) * 12288 + task * 64 + 4 * c4;
        f32x4 a0 = {0.f, 0.f, 0.f, 0.f}, a1 = a0, a2 = a0;
#pragma unroll 1
        for (int jb = 0; jb < 64; jb += 16) { f32x4 w[16];
#pragma unroll
            for (int j = 0; j < 16; ++j) w[j] = *(const f32x4*)(wp + (size_t)(4 * (jb + j)) * 12288);
#pragma unroll
            for (int j = 0; j < 16; ++j) { const int kk = wave * 256 + 4 * (jb + j) + r4; a0 += w[j] * sf[kk]; a1 += w[j] * sf[2048 + kk]; a2 += w[j] * sf[4096 + kk]; } }
#pragma unroll
        for (int q = 0; q < 4; ++q) { a0[q] += __shfl_xor(a0[q], 16); a0[q] += __shfl_xor(a0[q], 32); a1[q] += __shfl_xor(a1[q], 16); a1[q] += __shfl_xor(a1[q], 32); a2[q] += __shfl_xor(a2[q], 16); a2[q] += __shfl_xor(a2[q], 32); }
        LAS float* red = sf + 6144;
        if (r4 == 0) { *(LAS f32x4*)(red + (wave * 3 + 0) * 64 + 4 * c4) = a0; *(LAS f32x4*)(red + (wave * 3 + 1) * 64 + 4 * c4) = a1; *(LAS f32x4*)(red + (wave * 3 + 2) * 64 + 4 * c4) = a2; }
        __syncthreads();
        if (tid < 192) { const int r = tid >> 6, l = tid & 63; float s = 0.f;
#pragma unroll
            for (int w = 0; w < 8; ++w) s += red[(w * 3 + r) * 64 + l];
            ADA[r * 12288 + task * 64 + l] = s + b_ada[task * 64 + l]; }
        __syncthreads();
    }
}
__device__ __forceinline__ int rowmap(int n, int mode, int s128, int off) {
    if (mode == 0) return (n >> 7) * s128 + (n & 127) + off;
    if (n < 3072) return n;
    if (n < 3088) return 7168 + (n - 3072);
    if (n < 7184) return n - 16;
    return n;
}
__device__ __forceinline__ void transpose_item(const float* W, int K, int N, bf16* WT, int mode, int s128, int off, LAS float* scr, int item, int lane) {
    const int nblk = (N + 31) >> 5, kb = item / nblk, nb = item - kb * nblk, k0 = 64 * kb, n0 = 32 * nb;
    const int nn = n0 + (lane & 31); const bool ok = nn < N;
#pragma unroll 8
    for (int i = 0; i < 32; ++i) { const int kk = 2 * i + (lane >> 5); scr[kk * 33 + (lane & 31)] = ok ? W[(size_t)(k0 + kk) * N + nn] : 0.f; }
    LDS_WAIT(); asm volatile("" ::: "memory");
    const int cc = lane & 7;
#pragma unroll
    for (int j = 0; j < 4; ++j) { const int n = (lane >> 3) + 8 * j;
        if (n0 + n < N) { const LAS float* s = scr + (8 * cc) * 33 + n;
            v4u o; o.x = pk2(s[0 * 33], s[1 * 33]); o.y = pk2(s[2 * 33], s[3 * 33]); o.z = pk2(s[4 * 33], s[5 * 33]); o.w = pk2(s[6 * 33], s[7 * 33]);
            *(GAS v4u*)(WT + (size_t)rowmap(n0 + n, mode, s128, off) * K + k0 + 8 * cc) = o; } }
    LDS_WAIT(); asm volatile("" ::: "memory");
}
struct T64Src { const float* W; bf16* WT; int K, N, mode, s128, off, item; };
__device__ __forceinline__ void tile64_load(const T64Src& S, int lane, f32x4 (&v)[16]) {
    const int nblk = S.N >> 6, kb = S.item / nblk, nb = S.item - kb * nblk;
    const float* src = S.W + (size_t)(64 * kb + (lane >> 4)) * S.N + 64 * nb + 4 * (lane & 15);
#pragma unroll
    for (int j = 0; j < 16; ++j) v[j] = *(const f32x4*)(src + (size_t)(4 * j) * S.N);
}
__device__ __forceinline__ void tile64_finish(const T64Src& S, int lane, const f32x4 (&v)[16], LAS unsigned char* tile) {
    const int nblk = S.N >> 6, kb = S.item / nblk, nb = S.item - kb * nblk, k0 = 64 * kb, n0 = 64 * nb;
#pragma unroll
    for (int j = 0; j < 16; ++j) { u32x2 w; w.x = pg8::cvt_pk_bf16(v[j][0], v[j][1]); w.y = pg8::cvt_pk_bf16(v[j][2], v[j][3]);
        *(LAS u32x2*)(tile + (4 * j + (lane >> 4)) * 144 + (lane & 15) * 8) = w; }
    LDS_WAIT(); asm volatile("" ::: "memory");
    const int g = lane >> 4, li = lane & 15, q4 = li >> 2, p4 = li & 3, gi = g >> 1, gp = g & 1;
    const LAS unsigned char* tp0 = tile + (8 * (4 * gp + p4) + q4) * 144 + (4 * gi) * 2;
#pragma unroll
    for (int ib = 0; ib < 8; ++ib) {
        const bf16x8 o = cat8(tr16(tp0 + 16 * ib), tr16(tp0 + 16 * ib + 4 * 144));
        const int n = n0 + 8 * ib + 4 * gi + (li & 3);
        *(bf16x8*)(S.WT + (size_t)rowmap(n, S.mode, S.s128, S.off) * S.K + k0 + 8 * (4 * gp + (li >> 2))) = o; }
    LDS_WAIT(); asm volatile("" ::: "memory");
}
__device__ __forceinline__ T64Src expert_item(const float* w1, const float* w3, const float* w2, unsigned char* ws, int it) {
    constexpr int I_E = 32 * 12, I_E2 = 12 * 32;
    bf16* W13T = (bf16*)(ws + WS_W13); bf16* W2T = (bf16*)(ws + WS_W2);
    const int e = it / (2 * I_E + I_E2); int r = it - e * (2 * I_E + I_E2);
    T64Src S;
    if (r < I_E) { S.W = w1 + (size_t)e * 2048 * 768; S.WT = W13T + (size_t)e * 1536 * 2048; S.K = 2048; S.N = 768; S.mode = 0; S.s128 = 256; S.off = 0; S.item = r; }
    else if (r < 2 * I_E) { S.W = w3 + (size_t)e * 2048 * 768; S.WT = W13T + (size_t)e * 1536 * 2048; S.K = 2048; S.N = 768; S.mode = 0; S.s128 = 256; S.off = 128; S.item = r - I_E; }
    else { S.W = w2 + (size_t)e * 768 * 2048; S.WT = W2T + (size_t)e * 2048 * 768; S.K = 768; S.N = 2048; S.mode = 0; S.s128 = 128; S.off = 0; S.item = r - 2 * I_E; }
    return S;
}
__device__ __forceinline__ void ph_transposes_experts(const float* w1, const float* w3, const float* w2, unsigned char* ws, LAS unsigned char* lds, int gw, int NGW, int wave, int lane) {
    asm volatile("" : "+v"(lane));
    LAS unsigned char* tile = lds + wave * 9216;
    constexpr int NIT = 32 * (2 * 32 * 12 + 12 * 32);
    f32x4 va[16], vb[16];
    int it = gw;
    if (it >= NIT) return;
    T64Src A = expert_item(w1, w3, w2, ws, it), B = A;
    tile64_load(A, lane, va);
    for (;;) {
        const bool hb = it + NGW < NIT;
        if (hb) { B = expert_item(w1, w3, w2, ws, it + NGW); tile64_load(B, lane, vb); }
        tile64_finish(A, lane, va, tile);
        if (!hb) break;
        it += 2 * NGW;
        const bool ha = it < NIT;
        if (ha) { A = expert_item(w1, w3, w2, ws, it); tile64_load(A, lane, va); }
        tile64_finish(B, lane, vb, tile);
        if (!ha) break;
    }
}

__device__ __forceinline__ T64Src io_item(const float* w_in, const float* w_out, unsigned char* ws, int it) {
    T64Src S; constexpr int I_IN = 32 * 112;
    if (it < I_IN) { S.W = w_in; S.WT = (bf16*)(ws + WS_WIN); S.K = 2048; S.N = DIN; S.mode = 1; S.s128 = 0; S.off = 0; S.item = it; }
    else { S.W = w_out; S.WT = (bf16*)(ws + WS_WOUT); S.K = 2048; S.N = 2048; S.mode = 0; S.s128 = 128; S.off = 0; S.item = it - I_IN; }
    return S;
}
__device__ __forceinline__ void ph_transposes_io(const float* w_in, const float* w_out, unsigned char* ws, LAS unsigned char* lds, int gw, int NGW, int wave, int lane) {
    LAS unsigned char* tile = lds + wave * 9216;
    constexpr int NIT = 32 * 112 + 32 * 32;
    f32x4 va[16], vb[16];
    int it = gw;
    if (it < NIT) {
        T64Src A = io_item(w_in, w_out, ws, it), B = A;
        tile64_load(A, lane, va);
        for (;;) {
            const bool hb = it + NGW < NIT;
            if (hb) { B = io_item(w_in, w_out, ws, it + NGW); tile64_load(B, lane, vb); }
            tile64_finish(A, lane, va, tile);
            if (!hb) break;
            it += 2 * NGW;
            const bool ha = it < NIT;
            if (ha) { A = io_item(w_in, w_out, ws, it); tile64_load(A, lane, va); }
            tile64_finish(B, lane, vb, tile);
            if (!ha) break;
        }
    }
    LAS float* scr = (LAS float*)(lds + 73728 + wave * 8448);
    for (int t = gw; t < 64; t += NGW) transpose_item(w_in, 2048, DIN, (bf16*)(ws + WS_WIN), 1, 0, 0, scr, (t >> 1) * 226 + 224 + (t & 1), lane);
}
__device__ __forceinline__ void ph_norm1(const float* x, const float* ctx, const float* g1, const float* ADA, bf16* HL, int gw, int NGW, int lane) {
    for (int row = gw; row < MT; row += NGW) {
        const float* src = row < ML ? x + (size_t)row * DM : ctx + (size_t)(row - ML) * DM;
        const float* sh = ADA + (size_t)(row < ML ? row / SEQ : 2) * 12288; const float* sc = sh + 2048;
        f32x4 v[8]; float s = 0.f;
#pragma unroll
        for (int j = 0; j < 8; ++j) { v[j] = ((const f32x4*)src)[lane + 64 * j]; s += (v[j].x * v[j].x + v[j].y * v[j].y) + (v[j].z * v[j].z + v[j].w * v[j].w); }
        const float rstd = 1.f / sqrtf(wave_sum(s) * (1.f / DM) + EPSF);
        unsigned long long* o8 = (unsigned long long*)(HL + (size_t)row * DM) + lane;
#pragma unroll
        for (int j = 0; j < 8; ++j) { const int col = 4 * (lane + 64 * j);
            const f32x4 g = *(const f32x4*)(g1 + col), a = *(const f32x4*)(sc + col), b = *(const f32x4*)(sh + col);
            const f32x4 o = (v[j] * rstd) * g * (a + 1.f) + b;
            o8[64 * j] = (unsigned long long)pk2(o.x, o.y) | ((unsigned long long)pk2(o.z, o.w) << 32); }
    }
}

__device__ __forceinline__ float silu_fast(float v) { return v * __builtin_amdgcn_rcpf(1.f + __expf(-v)); }
__device__ __forceinline__ void ph_prep(const bf16* Z, const float* GF, const float* w_conv, const float* b_gate, const float* a_log, const float* dt_bias,
                                        bf16* GQ, bf16* GK, bf16* GV, float* MLG, float* GDG, int tid, int lane, int gw, int NGW) {
    for (int it = gw; it < 264 * 24 * 2; it += NGW) {
        const int ci = it / 48, rem = it - ci * 48, gi = rem >> 1, half = rem & 1;
        int rowbase, tlo, thi, t0;
        if (ci < 256) { rowbase = (ci >> 7) * SEQ + (ci & 127) * 64; tlo = 0; thi = 64; t0 = 0; }
        else { const int cc = ci - 256; rowbase = ML + (cc >> 2) * CTXL; tlo = 0; thi = 256; t0 = (cc & 3) * 64; }
        const int type = gi >> 3, head = gi & 7, ch = type * 1024 + head * 128 + 2 * lane;
        float w0[5], w1[5];
#pragma unroll
        for (int j = 0; j < 5; ++j) { w0[j] = w_conv[j * 3072 + ch]; w1[j] = w_conv[j * 3072 + ch + 1]; }
        bf16* dst = (type == 0 ? GQ : (type == 1 ? GK : GV)) + head * 128 + 2 * lane;
        const float qs = type == 0 ? 0.08838834764831845f : 1.f;
#pragma unroll 1
        for (int sub = 2 * half; sub < 2 * half + 2; ++sub) {
            unsigned zr[20];
#pragma unroll
            for (int i = 0; i < 20; ++i) { const int t = t0 + sub * 16 + i - 2; zr[i] = (t >= tlo && t < thi) ? *(const unsigned*)(Z + (size_t)(rowbase + t) * Z2LD + ch) : 0u; }
            float o0[16], o1[16];
#pragma unroll
            for (int i = 0; i < 16; ++i) { float a0 = 0.f, a1 = 0.f;
#pragma unroll
                for (int j = 0; j < 5; ++j) { a0 += w0[j] * bf_lo(zr[i + j]); a1 += w1[j] * bf_hi(zr[i + j]); }
                o0[i] = silu_fast(a0); o1[i] = silu_fast(a1); }
            if (type < 2) {
#pragma unroll
                for (int i = 0; i < 16; ++i) { const float ss = wave_sum(o0[i] * o0[i] + o1[i] * o1[i]); const float sc = qs * __builtin_amdgcn_rsqf(ss + EPSF); o0[i] *= sc; o1[i] *= sc; } }
#pragma unroll
            for (int i = 0; i < 16; ++i) *(unsigned*)(dst + (size_t)(rowbase + t0 + sub * 16 + i) * 1024) = pk2(o0[i], o1[i]);
        }
    }
    const int gt = blockIdx.x * NTHREADS + (int)threadIdx.x, NGT = gridDim.x * NTHREADS;
    for (int e = gt; e < MT * 48; e += NGT) {
        const int row = e / 48, idx = e - row * 48; const float v = GF[(size_t)row * GFLD + idx];
        if (idx < 16) { float p = v + b_gate[idx]; p = 15.f * tanhf(p * (1.f / 15.f)); const int type = (idx >> 2) & 1;
            MLG[(size_t)row * 16 + idx] = type == 0 ? p : -softplusf_(-p); }
        else if (idx < 32) { const int j = idx - 16; GDG[(size_t)row * 32 + j] = -expf(a_log[j]) * softplusf_(v + dt_bias[j]); }
        else { const int j = idx - 32; GDG[(size_t)row * 32 + 16 + j] = sigmoidf_(v); }
    }
}
constexpr int NCH = 132;
constexpr float QSCALE = 0.08838834764831845f;
__device__ __forceinline__ int chunk_row0(int b, int c) { return c < 4 ? ML + b * CTXL + c * 64 : b * SEQ + (c - 4) * 64; }
__device__ __forceinline__ int chunk_of(int idx, int d) { return d == 0 ? idx : (idx < 4 ? 3 - idx : 135 - idx); }
__device__ __forceinline__ float wave_incl_scan(float v, int lane) {
#pragma unroll
    for (int o = 1; o < 64; o <<= 1) { const float t = __shfl_up(v, o); if (lane >= o) v += t; }
    return v;
}
__device__ __forceinline__ void mlstm_prep_task(int mt, const bf16* Z, const float* GF, const float* b_gate, bf16* MS, float* MSC, LAS float* sf, int tid, int lane, int wave) {
    const int bh = mt / NCH, c = mt - bh * NCH, b = bh >> 2, h = bh & 3, row0 = chunk_row0(b, c);
    LAS float* bq = sf; LAS float* lis = sf + 128;
    __syncthreads();
    if (tid < 128) { const int d = tid >> 6, r = d ? 63 - lane : lane;
        float pf = GF[(size_t)(row0 + r) * GFLD + d * 8 + 4 + h] + b_gate[d * 8 + 4 + h], pi = GF[(size_t)(row0 + r) * GFLD + d * 8 + h] + b_gate[d * 8 + h];
        pf = 15.f * tanhf(pf * (1.f / 15.f)); pi = 15.f * tanhf(pi * (1.f / 15.f));
        const float lfv = -softplusf_(-pf), liv = pi;
        const float bc = wave_incl_scan(lfv, lane), bl = __shfl(bc, 63);
        bq[d * 64 + r] = bc; lis[d * 64 + r] = liv;
        float* sc = MSC + ((size_t)mt * 2 + d) * 192;
        sc[r] = __expf(bl - bc + liv); sc[64 + r] = QSCALE * __expf(bc); if (lane == 0) sc[128] = __expf(bl); }
    __syncthreads();
    const int g = lane >> 4, li = lane & 15, tm = wave >> 1;
    const bf16* Kp = Z + (size_t)(row0 + 16 * tm + li) * Z1LD + ZC_MK + h * 128 + 8 * g;
    bf16x8 ka[4];
#pragma unroll
    for (int ks = 0; ks < 4; ++ks) ka[ks] = *(const bf16x8*)(Kp + 32 * ks);
#pragma unroll
    for (int tt = 0; tt < 2; ++tt) { const int tn = 2 * (wave & 1) + tt;
        const bf16* Qp = Z + (size_t)(row0 + 16 * tn + li) * Z1LD + ZC_MQ + h * 128 + 8 * g;
        f32x4 acc = {0.f, 0.f, 0.f, 0.f};
#pragma unroll
        for (int ks = 0; ks < 4; ++ks) acc = MFMA16(ka[ks], *(const bf16x8*)(Qp + 32 * ks), acc);
        const int r = 16 * tn + li, s0 = 16 * tm + 4 * g;
#pragma unroll
        for (int d = 0; d < 2; ++d) { float o[4]; const float br = bq[d * 64 + r];
#pragma unroll
            for (int q = 0; q < 4; ++q) { const int s = s0 + q; const bool ok = d == 0 ? (s <= r) : (s >= r);
                o[q] = ok ? acc[q] * QSCALE * __expf(br - bq[d * 64 + s] + lis[d * 64 + s]) : 0.f; }
            u32x2 w; w.x = pg8::cvt_pk_bf16(o[0], o[1]); w.y = pg8::cvt_pk_bf16(o[2], o[3]);
            *(u32x2*)(MS + (((size_t)mt * 2 + d) * 64 + r) * 64 + s0) = w; }
    }
}
constexpr int MQ_OFF = 0, MK_OFF = 17408, MV_OFF = 34816, MSS_OFF = 44032, ME_OFF = 53248, MSTAGE = 54272;
struct MlCtx { const bf16* Z; const bf16* MS; const float* MSC; bf16* MOR; float* DEN; int b, h, d, bh, v0, slice; };
template <int wv> __device__ __forceinline__ void ml_issue(const MlCtx& X, int idx, int lane, v4u (&buf)[16], f32x4& ev) {
    const int cn = chunk_of(idx, X.d), mt = X.bh * NCH + cn, row0 = chunk_row0(X.b, cn);
    const float* sc = X.MSC + ((size_t)mt * 2 + X.d) * 192;
    const char* zrow = (const char*)(X.Z + (size_t)row0 * Z1LD);
    const unsigned o16 = (unsigned)(lane >> 4) * (Z1LD * 2) + (unsigned)(lane & 15) * 16, o8r = (unsigned)(lane >> 3) * (Z1LD * 2) + (unsigned)(lane & 7) * 16, ol = (unsigned)lane * 16;
    const char* bQ = zrow + (ZC_MQ + X.h * 128) * 2; const char* bK = zrow + (ZC_MK + X.h * 128) * 2; const char* bV = zrow + (ZC_MV + X.h * 256 + X.v0) * 2; const char* bS = (const char*)(X.MS + ((size_t)mt * 2 + X.d) * 4096);
#pragma unroll
    for (int i = 0; i < 16; ++i) { const int pb = 64 * (wv + 3 * i);
        const char* base = pb < 1024 ? bQ + (size_t)(pb >> 4) * (Z1LD * 2) : (pb < 2048 ? bK + (size_t)((pb - 1024) >> 4) * (Z1LD * 2) : (pb < 2560 ? bV + (size_t)((pb - 2048) >> 3) * (Z1LD * 2) : bS + (size_t)(pb - 2560) * 16));
        buf[i] = *(const v4u*)(base + (pb < 2048 ? o16 : (pb < 2560 ? o8r : ol))); }
    ev = (f32x4){sc[lane], sc[64 + lane], sc[128], 0.f};
}
template <int wv> __device__ __forceinline__ void ml_store(LAS unsigned char* st, int lane, const v4u (&buf)[16], const f32x4 ev) {
    const unsigned l16 = (unsigned)(lane >> 4) * 272 + (unsigned)(lane & 15) * 16, l8 = (unsigned)(lane >> 3) * 144 + (unsigned)(lane & 7) * 16;
#pragma unroll
    for (int i = 0; i < 16; ++i) { const int pb = 64 * (wv + 3 * i);
        const unsigned uo = pb < 1024 ? (unsigned)(MQ_OFF + (pb >> 4) * 272) : (pb < 2048 ? (unsigned)(MK_OFF + ((pb - 1024) >> 4) * 272) : (pb < 2560 ? (unsigned)(MV_OFF + ((pb - 2048) >> 3) * 144) : (unsigned)(MSS_OFF + ((pb - 2560) >> 3) * 144)));
        *(LAS v4u*)(st + uo + (pb < 2048 ? l16 : l8)) = buf[i]; }
    if (wv == 0) { LAS float* e = (LAS float*)(st + ME_OFF); e[lane] = ev[1]; e[128 + lane] = ev[0]; if (lane == 0) e[64] = ev[2]; }
}
template <int MODE> __device__ __forceinline__ void ml_compute(const MlCtx& X, int idx, const LAS unsigned char* st, int lane, int wave, f32x4 (&CT)[8], bf16x8 (&Cb)[4]) {
    const int g = lane >> 4, li = lane & 15, q4 = li >> 2, p4 = li & 3;
    const int c = chunk_of(idx, X.d), row0 = chunk_row0(X.b, c), d = X.d, h = X.h;
    const LAS float* ep = (const LAS float*)(st + ME_OFF);
    bf16x8 Vf[2], Vw[2];
#pragma unroll
    for (int s2 = 0; s2 < 2; ++s2) {
        const f32x4 ea0 = *(const LAS f32x4*)(ep + 128 + 32 * s2 + 8 * g), ea1 = *(const LAS f32x4*)(ep + 128 + 32 * s2 + 8 * g + 4);
        if (wave < 4) { const LAS unsigned char* vp = st + MV_OFF + (32 * s2 + 8 * g + q4) * 144 + (16 * wave + 4 * p4) * 2;
            const v4i16_t lo = tr16(vp), hi = tr16(vp + 4 * 144); Vf[s2] = cat8(lo, hi);
            const f32x4 a = {bf_lo((unsigned)(unsigned short)lo[0]), bf_lo((unsigned)(unsigned short)lo[1]), bf_lo((unsigned)(unsigned short)lo[2]), bf_lo((unsigned)(unsigned short)lo[3])};
            const f32x4 b2 = {bf_lo((unsigned)(unsigned short)hi[0]), bf_lo((unsigned)(unsigned short)hi[1]), bf_lo((unsigned)(unsigned short)hi[2]), bf_lo((unsigned)(unsigned short)hi[3])};
            Vw[s2] = packacc(a * ea0, b2 * ea1);
        } else { const short one = li == 0 ? (short)0x3f80 : (short)0; Vf[s2] = (bf16x8){one, one, one, one, one, one, one, one};
            const f32x4 z = {0.f, 0.f, 0.f, 0.f}; Vw[s2] = li == 0 ? packacc(ea0, ea1) : packacc(z, z); }
    }
    __builtin_amdgcn_sched_barrier(0);
    if (c >= 4) {
        f32x4 num[4], e4[4]; bf16x8 qf[4][4], sfr[4][2];
#pragma unroll
        for (int t = 0; t < 4; ++t) { const LAS unsigned char* qp = st + MQ_OFF + (16 * t + li) * 272 + (4 * g) * 2;
#pragma unroll
            for (int ks = 0; ks < 4; ++ks) qf[t][ks] = cat8(*(const LAS v4i16_t*)(qp + 64 * ks), *(const LAS v4i16_t*)(qp + 64 * ks + 32));
            const LAS unsigned char* sp = st + MSS_OFF + (16 * t + li) * 144 + (8 * g) * 2;
            sfr[t][0] = *(const LAS bf16x8*)(sp); sfr[t][1] = *(const LAS bf16x8*)(sp + 64);
            e4[t] = *(const LAS f32x4*)(ep + 16 * t + 4 * g); num[t] = (f32x4){0.f, 0.f, 0.f, 0.f}; }
        __builtin_amdgcn_sched_barrier(0);
#pragma unroll
        for (int ks = 0; ks < 4; ++ks)
#pragma unroll
            for (int t = 0; t < 4; ++t) num[t] = MFMA16(qf[t][ks], Cb[ks], num[t]);
#pragma unroll
        for (int t = 0; t < 4; ++t) num[t] = num[t] * e4[t];
#pragma unroll
        for (int s2 = 0; s2 < 2; ++s2)
#pragma unroll
            for (int t = 0; t < 4; ++t) num[t] = MFMA16(sfr[t][s2], Vf[s2], num[t]);
        if (!(MODE & 4)) { asm volatile("" :: "v"(num[0]), "v"(num[1]), "v"(num[2]), "v"(num[3])); } else if (wave < 4) {
#pragma unroll
            for (int t = 0; t < 4; ++t)
#pragma unroll
                for (int q = 0; q < 4; ++q) *(LAS unsigned short*)((LAS unsigned char*)st + MV_OFF + (16 * t + 4 * g + q) * 144 + (16 * wave + li) * 2) = (unsigned short)f2bf(num[t][q]);
        } else if (X.slice == 0 && li == 0) {
#pragma unroll
            for (int t = 0; t < 4; ++t)
#pragma unroll
                for (int q = 0; q < 4; ++q) X.DEN[((size_t)d * ML + row0 + 16 * t + 4 * g + q) * 4 + h] = num[t][q];
        }
    }
    __builtin_amdgcn_sched_barrier(0);
    { const float dec = ep[64]; bf16x8 kf[8][2];
#pragma unroll
      for (int tk = 0; tk < 8; ++tk)
#pragma unroll
          for (int s2 = 0; s2 < 2; ++s2) { const LAS unsigned char* kp = st + MK_OFF + (32 * s2 + 8 * g + q4) * 272 + (16 * tk + 4 * p4) * 2; kf[tk][s2] = cat8(tr16(kp), tr16(kp + 4 * 272)); }
      __builtin_amdgcn_sched_barrier(0);
#pragma unroll
      for (int tk = 0; tk < 8; ++tk) CT[tk] = CT[tk] * dec;
#pragma unroll
      for (int s2 = 0; s2 < 2; ++s2)
#pragma unroll
          for (int tk = 0; tk < 8; ++tk) CT[tk] = MFMA16(kf[tk][s2], Vw[s2], CT[tk]);
    }
#pragma unroll
    for (int ks = 0; ks < 4; ++ks) Cb[ks] = packacc(CT[2 * ks], CT[2 * ks + 1]);
}
template <int WV> __device__ __forceinline__ void ml_flush(const MlCtx& X, int idx, const LAS unsigned char* st, int lane) {
    if (idx < 0 || idx >= NCH) return;
    const int c = chunk_of(idx, X.d); if (c < 4) return;
    const int row0 = chunk_row0(X.b, c);
#pragma unroll
    for (int i = 0; i < 16; ++i) { const int pb = 64 * (WV + 3 * i);
        if (pb >= 2048 && pb < 2560) { const int r = ((pb - 2048) >> 3) + (lane >> 3);
            const v4u o = *(const LAS v4u*)(st + MV_OFF + r * 144 + (lane & 7) * 16);
            *(v4u*)(X.MOR + ((size_t)X.d * ML + row0 + r) * 1024 + X.h * 256 + X.v0 + 8 * (lane & 7)) = o; } }
}
template <int MODE, int WV> __device__ __forceinline__ void ml_loader_loop(const MlCtx& X, LAS unsigned char* st0, LAS unsigned char* st1, int lane) {
    __builtin_amdgcn_s_setprio(3);
    v4u bufA[16], bufB[16]; f32x4 evA = {0.f, 0.f, 0.f, 0.f}, evB = evA;
    if (MODE & 1) { ml_issue<WV>(X, 0, lane, bufA, evA); ml_issue<WV>(X, 1, lane, bufB, evB); }
    for (int idx = -1; idx < NCH; idx += 2) {
        if (!(MODE & 1)) { LDS_BARRIER(); LDS_BARRIER(); continue; }
        if (MODE & 4) ml_flush<WV>(X, idx - 1, st0, lane);
        if (idx + 1 < NCH) ml_store<WV>(st0, lane, bufA, evA); if (idx + 3 < NCH) ml_issue<WV>(X, idx + 3, lane, bufA, evA);
        LDS_BARRIER();
        if (MODE & 4) ml_flush<WV>(X, idx, st1, lane);
        if (idx + 2 < NCH) ml_store<WV>(st1, lane, bufB, evB); if (idx + 4 < NCH) ml_issue<WV>(X, idx + 4, lane, bufB, evB);
        LDS_BARRIER();
    }
}
template <int MODE> __device__ __forceinline__ void mlstm_chunk_job(int job, const bf16* Z, const bf16* MS, const float* MSC, bf16* MOR, float* DEN, LAS unsigned char* lds, int tid, int lane, int wave) {
    const int seq = job & 15, slice = job >> 4;
    MlCtx X; X.Z = Z; X.MS = MS; X.MSC = MSC; X.MOR = MOR; X.DEN = DEN; X.b = seq >> 3; X.h = (seq >> 1) & 3; X.d = seq & 1; X.bh = X.b * 4 + X.h; X.v0 = slice * 64; X.slice = slice;
    LAS unsigned char* st0 = lds; LAS unsigned char* st1 = lds + MSTAGE;
    __syncthreads();
    if (wave >= 5) {
        if (wave == 5) ml_loader_loop<MODE, 0>(X, st0, st1, lane); else if (wave == 6) ml_loader_loop<MODE, 1>(X, st0, st1, lane); else ml_loader_loop<MODE, 2>(X, st0, st1, lane);
    } else {
        f32x4 CT[8]; bf16x8 Cb[4];
#pragma unroll
        for (int t = 0; t < 8; ++t) CT[t] = (f32x4){0.f, 0.f, 0.f, 0.f};
#pragma unroll
        for (int t = 0; t < 4; ++t) Cb[t] = (bf16x8){0, 0, 0, 0, 0, 0, 0, 0};
        LDS_BARRIER();
#pragma unroll 1
        for (int idx = 0; idx < NCH; ++idx) {
            if (MODE & 2) ml_compute<MODE>(X, idx, (idx & 1) ? st1 : st0, lane, wave, CT, Cb);
            LDS_BARRIER();
        }
        LDS_BARRIER();
    }
}
typedef float f32x16 __attribute__((ext_vector_type(16)));
constexpr int GP_Q = 0, GP_K = 17408, GP_V = 34816, GP_A = 52224, GP_M = 87040, GP_X = 95488, GP_S = 132352, AP = 68, AMD = 64 * AP;
__device__ __forceinline__ void gdn_prep_task(int gt, const bf16* Z2, const float* GF, const float* w_conv, const float* a_log, const float* dt_bias, bf16* GQ, bf16* GK, bf16* GW, bf16* GU, bf16* GA, float* GSC,
                                              LAS unsigned char* lds, int tid, int lane, int wave) {
    const int bh = gt / NCH, c = gt - bh * NCH, b = bh >> 3, h = bh & 7, row0 = chunk_row0(b, c);
    const int g = lane >> 4, li = lane & 15, q4 = li >> 2, p4 = li & 3;
    LAS float* Amat = (LAS float*)(lds + GP_A); LAS float* Mtmp = (LAS float*)(lds + GP_M);
    LAS float* gc = (LAS float*)(lds + GP_S); LAS float* be = gc + 128;
    __syncthreads();
    { const int rowbase = c < 4 ? ML + b * CTXL : row0, t0 = c < 4 ? c * 64 : 0, thi = c < 4 ? CTXL : 64;
      float w0[3][5], w1[3][5]; unsigned zr[3][12];
#pragma unroll
      for (int ty = 0; ty < 3; ++ty) { const int ch = ty * 1024 + h * 128 + 2 * lane;
#pragma unroll
          for (int j = 0; j < 5; ++j) { w0[ty][j] = w_conv[j * 3072 + ch]; w1[ty][j] = w_conv[j * 3072 + ch + 1]; }
#pragma unroll
          for (int i = 0; i < 12; ++i) { const int t = t0 + 8 * wave + i - 2; zr[ty][i] = (t >= 0 && t < thi) ? *(const unsigned*)(Z2 + (size_t)(rowbase + t) * Z2LD + ch) : 0u; } }
#pragma unroll
      for (int ty = 0; ty < 3; ++ty) {
#pragma unroll
          for (int i = 0; i < 8; ++i) { float o0 = 0.f, o1 = 0.f;
#pragma unroll
              for (int j = 0; j < 5; ++j) { o0 += w0[ty][j] * bf_lo(zr[ty][i + j]); o1 += w1[ty][j] * bf_hi(zr[ty][i + j]); }
              o0 = silu_fast(o0); o1 = silu_fast(o1);
              if (ty < 2) { const float ss = wave_sum(o0 * o0 + o1 * o1); const float sc = (ty == 0 ? 0.08838834764831845f : 1.f) * __builtin_amdgcn_rsqf(ss + EPSF); o0 *= sc; o1 *= sc; }
              const unsigned pk = pk2(o0, o1); const int r = 8 * wave + i;
              *(LAS unsigned*)(lds + ty * 17408 + r * 272 + lane * 4) = pk;
              if (ty == 0) *(unsigned*)(GQ + (size_t)(row0 + r) * 1024 + h * 128 + 32 * (lane >> 4) + 8 * ((lane & 7) >> 1) + 4 * ((lane >> 3) & 1) + 2 * (lane & 1)) = pk;
              else if (ty == 1) *(unsigned*)(GK + (size_t)(row0 + r) * 1024 + h * 128 + 2 * lane) = pk; } } }
    if (tid < 128) { const int d = tid >> 6, r = d ? 63 - lane : lane;
        const float gv = -expf(a_log[d * 8 + h]) * softplusf_(GF[(size_t)(row0 + r) * GFLD + 16 + d * 8 + h] + dt_bias[d * 8 + h]), bv = sigmoidf_(GF[(size_t)(row0 + r) * GFLD + 32 + d * 8 + h]);
        const float gcs = wave_incl_scan(gv, lane), gl = __shfl(gcs, 63);
        gc[d * 64 + r] = gcs; be[d * 64 + r] = bv;
        float* sc = GSC + ((size_t)gt * 2 + d) * 192; sc[r] = __expf(gcs); sc[64 + r] = __expf(gl - gcs); if (lane == 0) sc[128] = __expf(gl); }
    LDS_BARRIER();
    { const int tn = wave & 3, i = 16 * tn + li;
      bf16x8 kB[4], qB[4]; u32x2 wa[2][2];
#pragma unroll
      for (int ks = 0; ks < 4; ++ks) { kB[ks] = *(const LAS bf16x8*)(lds + GP_K + i * 272 + (32 * ks + 8 * g) * 2); qB[ks] = *(const LAS bf16x8*)(lds + GP_Q + i * 272 + (32 * ks + 8 * g) * 2); }
#pragma unroll
      for (int tt = 0; tt < 2; ++tt) { const int tm = 2 * (wave >> 2) + tt;
          f32x4 aKK = {0.f, 0.f, 0.f, 0.f}, aQK = aKK;
#pragma unroll
          for (int ks = 0; ks < 4; ++ks) { const bf16x8 kA = *(const LAS bf16x8*)(lds + GP_K + (16 * tm + li) * 272 + (32 * ks + 8 * g) * 2);
              aKK = MFMA16(kA, kB[ks], aKK); aQK = MFMA16(kA, qB[ks], aQK); }
          const int j0 = 16 * tm + 4 * g;
#pragma unroll
          for (int d = 0; d < 2; ++d) { const float gci = gc[d * 64 + i], bi = be[d * 64 + i]; const int pi = d ? 63 - i : i; float at[4];
#pragma unroll
              for (int q = 0; q < 4; ++q) { const int j = j0 + q, pj = d ? 63 - j : j; const bool strict = pj < pi, incl = pj <= pi;
                  const float e = incl ? __expf(gci - gc[d * 64 + j]) : 0.f;
                  Amat[d * AMD + pi * AP + pj] = strict ? bi * aKK[q] * e : 0.f;
                  at[q] = aQK[q] * e; }
              wa[d][tt].x = pg8::cvt_pk_bf16(at[0], at[1]); wa[d][tt].y = pg8::cvt_pk_bf16(at[2], at[3]); }
      }
#pragma unroll
      for (int d = 0; d < 2; ++d) { v4u w; w.x = wa[d][0].x; w.y = wa[d][0].y; w.z = wa[d][1].x; w.w = wa[d][1].y;
          *(v4u*)(GA + (((size_t)gt * 2 + d) * 64 + i) * 64 + 32 * (wave >> 2) + 8 * g) = w; } }
    LDS_BARRIER();
    if (wave < 4) { const int d = wave >> 1, blk = wave & 1, cc = lane & 31; LAS float* Ab = Amat + d * AMD + (32 * blk) * AP + 32 * blk;
        float X[32];
#pragma unroll
        for (int p = 0; p < 32; ++p) { f32x4 a4[8];
#pragma unroll
            for (int q = 0; q < (p + 3) / 4; ++q) a4[q] = *(const LAS f32x4*)(Ab + p * AP + 4 * q);
            float s0 = (p == cc) ? 1.f : 0.f, s1 = 0.f;
#pragma unroll
            for (int pp = 0; pp < p; ++pp) { if (pp & 1) s1 -= a4[pp >> 2][pp & 3] * X[pp]; else s0 -= a4[pp >> 2][pp & 3] * X[pp]; }
            X[p] = s0 + s1; }
        if (lane < 32) {
#pragma unroll
            for (int p = 0; p < 32; ++p) Ab[p * AP + cc] = X[p]; }
    }
    LDS_BARRIER();
    if (wave < 2) { const int d = wave, r32 = lane & 31, kk = lane >> 5; LAS float* Ad = Amat + d * AMD; LAS float* Md = Mtmp + d * 1056;
        f32x16 acc;
#pragma unroll
        for (int q = 0; q < 16; ++q) acc[q] = 0.f;
#pragma unroll
        for (int ks = 0; ks < 16; ++ks) acc = __builtin_amdgcn_mfma_f32_32x32x2f32(Ad[(32 + r32) * AP + 2 * ks + kk], Ad[(2 * ks + kk) * AP + r32], acc, 0, 0, 0);
#pragma unroll
        for (int q = 0; q < 16; ++q) Md[((q & 3) + 8 * (q >> 2) + 4 * kk) * 33 + r32] = acc[q];
#pragma unroll
        for (int q = 0; q < 16; ++q) acc[q] = 0.f;
#pragma unroll
        for (int ks = 0; ks < 16; ++ks) acc = __builtin_amdgcn_mfma_f32_32x32x2f32(Ad[(32 + r32) * AP + 32 + 2 * ks + kk], Md[(2 * ks + kk) * 33 + r32], acc, 0, 0, 0);
#pragma unroll
        for (int q = 0; q < 16; ++q) Ad[(32 + (q & 3) + 8 * (q >> 2) + 4 * kk) * AP + r32] = -acc[q];
    }
    LDS_BARRIER();
    { const int d = tid >> 8, i = (tid >> 2) & 63, jq = tid & 3, pi = d ? 63 - i : i; float xu[16], xw[16];
#pragma unroll
      for (int q = 0; q < 16; ++q) { const int j = 16 * jq + q, pj = d ? 63 - j : j; const float xv = Amat[d * AMD + pi * AP + pj] * be[d * 64 + j]; xu[q] = xv; xw[q] = xv * __expf(gc[d * 64 + j]); }
      LAS unsigned char* xo = lds + GP_X + (d * 2) * 9216 + i * 144 + jq * 32;
      v4u o; o.x = pk2(xu[0], xu[1]); o.y = pk2(xu[2], xu[3]); o.z = pk2(xu[4], xu[5]); o.w = pk2(xu[6], xu[7]); *(LAS v4u*)xo = o;
      o.x = pk2(xu[8], xu[9]); o.y = pk2(xu[10], xu[11]); o.z = pk2(xu[12], xu[13]); o.w = pk2(xu[14], xu[15]); *(LAS v4u*)(xo + 16) = o;
      o.x = pk2(xw[0], xw[1]); o.y = pk2(xw[2], xw[3]); o.z = pk2(xw[4], xw[5]); o.w = pk2(xw[6], xw[7]); *(LAS v4u*)(xo + 9216) = o;
      o.x = pk2(xw[8], xw[9]); o.y = pk2(xw[10], xw[11]); o.z = pk2(xw[12], xw[13]); o.w = pk2(xw[14], xw[15]); *(LAS v4u*)(xo + 9216 + 16) = o; }
    LDS_BARRIER();
    { const int d = wave >> 2, ti = wave & 3;
      const LAS unsigned char* xr = lds + GP_X + (d * 2) * 9216 + (16 * ti + li) * 144 + (8 * g) * 2;
      const bf16x8 xa0 = *(const LAS bf16x8*)xr, xa1 = *(const LAS bf16x8*)(xr + 64), xw0 = *(const LAS bf16x8*)(xr + 9216), xw1 = *(const LAS bf16x8*)(xr + 9216 + 64);
#pragma unroll 1
      for (int ts = 0; ts < 4; ++ts) { u32x2 ww[2];
#pragma unroll
        for (int hi = 0; hi < 2; ++hi) { const int tv = 2 * ts + hi;
          const LAS unsigned char* vp = lds + GP_V + (8 * g + q4) * 272 + (16 * tv + 4 * p4) * 2;
          f32x4 acc = {0.f, 0.f, 0.f, 0.f};
          acc = MFMA16(xa0, cat8(tr16(vp), tr16(vp + 4 * 272)), acc);
          acc = MFMA16(xa1, cat8(tr16(vp + 32 * 272), tr16(vp + 36 * 272)), acc);
          u32x2 w; w.x = pg8::cvt_pk_bf16(acc[0], acc[1]); w.y = pg8::cvt_pk_bf16(acc[2], acc[3]);
          *(u32x2*)(GU + (((size_t)gt * 2 + d) * 128 + 16 * tv + li) * 64 + 16 * ti + 4 * g) = w;
          const LAS unsigned char* kp = lds + GP_K + (8 * g + q4) * 272 + (16 * tv + 4 * p4) * 2;
          f32x4 acw = {0.f, 0.f, 0.f, 0.f};
          acw = MFMA16(cat8(tr16(kp), tr16(kp + 4 * 272)), xw0, acw);
          acw = MFMA16(cat8(tr16(kp + 32 * 272), tr16(kp + 36 * 272)), xw1, acw);
          ww[hi].x = pg8::cvt_pk_bf16(-acw[0], -acw[1]); ww[hi].y = pg8::cvt_pk_bf16(-acw[2], -acw[3]); }
        v4u w4; w4.x = ww[0].x; w4.y = ww[0].y; w4.z = ww[1].x; w4.w = ww[1].y;
        *(v4u*)(GW + (((size_t)gt * 2 + d) * 64 + 16 * ti + li) * 128 + 32 * ts + 8 * g) = w4;
      } }
}
constexpr int KP = 288, APITCH = 160, GS_W = 0, GS_Q = 18432, GS_K = 36864, GS_A = 55296, GS_U = 65536, GS_E = 74752, GSTAGE = 75280;
struct GdCtx { const bf16* GQ; const bf16* GK; const bf16* GW; const bf16* GU; const bf16* GA; const float* GSC; bf16* GO; int b, h, d, bh, c0; };
template <int wv> __device__ __forceinline__ void gd_issue(const GdCtx& X, int idx, int lane, v4u (&buf)[16], float& ev) {
    const int cn = chunk_of(idx, X.d), gt = X.bh * NCH + cn, row0 = chunk_row0(X.b, cn);
    const size_t td = (size_t)gt * 2 + X.d;
    const unsigned o16 = (unsigned)(lane >> 4) * 2048 + (unsigned)(lane & 15) * 16, ol = (unsigned)lane * 16;
    const char* bW = (const char*)(X.GW + td * 8192); const char* bQ = (const char*)(X.GQ + (size_t)row0 * 1024 + X.h * 128); const char* bK = (const char*)(X.GK + (size_t)row0 * 1024 + X.h * 128);
    const char* bA = (const char*)(X.GA + td * 4096); const char* bU = (const char*)(X.GU + (td * 128 + X.c0) * 64);
#pragma unroll
    for (int i = 0; i < 16; ++i) { const int pb = 64 * (wv < 3 ? (i < 14 ? wv + 4 * i : 3 + 8 * wv + 4 * (i - 14)) : (i < 8 ? 27 + 4 * i : 48 + i));
        const bool rowk = pb >= 1024 && pb < 3072;
        const char* base = pb < 1024 ? bW + (size_t)pb * 16 : (pb < 2048 ? bQ + (size_t)((pb - 1024) >> 4) * 2048 : (pb < 3072 ? bK + (size_t)((pb - 2048) >> 4) * 2048 : (pb < 3584 ? bA + (size_t)(pb - 3072) * 16 : bU + (size_t)(pb - 3584) * 16)));
        buf[i] = *(const v4u*)(base + (rowk ? o16 : ol)); }
    ev = X.GSC[td * 192 + (wv < 2 ? 64 * wv + lane : 128)];
}
template <int wv> __device__ __forceinline__ void gd_store(LAS unsigned char* st, int lane, const v4u (&buf)[16], float ev) {
    const unsigned l16 = (unsigned)(lane >> 4) * KP + (unsigned)(lane & 15) * 16, l8a = (unsigned)(lane >> 3) * APITCH + (unsigned)(lane & 7) * 16, l8 = (unsigned)(lane >> 3) * 144 + (unsigned)(lane & 7) * 16;
#pragma unroll
    for (int i = 0; i < 16; ++i) { const int pb = 64 * (wv < 3 ? (i < 14 ? wv + 4 * i : 3 + 8 * wv + 4 * (i - 14)) : (i < 8 ? 27 + 4 * i : 48 + i));
        const unsigned uo = pb < 3072 ? (unsigned)((pb >> 10) * 18432 + ((pb & 1023) >> 4) * KP) : (pb < 3584 ? (unsigned)(GS_A + ((pb - 3072) >> 3) * APITCH) : (unsigned)(GS_U + ((pb - 3584) >> 3) * 144));
        *(LAS v4u*)(st + uo + (pb < 3072 ? l16 : (pb < 3584 ? l8a : l8))) = buf[i]; }
    if (wv < 2) ((LAS float*)(st + GS_E))[64 * wv + lane] = ev; else if (wv == 2 && lane == 0) ((LAS float*)(st + GS_E))[128] = ev;
}
#define SCHED_FENCE() __builtin_amdgcn_sched_barrier(0)
#define LD16(p) (*(const LAS bf16x8*)(p))
template <int G> __device__ __forceinline__ void gd_ld(const LAS unsigned char* st, int g, int li, int q4, int p4, bf16x8 (&F)[4]) {
    if constexpr (G < 8) { constexpr int t = G >> 1, hf = G & 1;
        const LAS unsigned char* wp = st + GS_W + (16 * t + li) * KP + 16 * g + 128 * hf; const LAS unsigned char* qp = wp + (GS_Q - GS_W);
        F[0] = LD16(wp); F[1] = LD16(qp); F[2] = LD16(wp + 64); F[3] = LD16(qp + 64);
    } else if constexpr (G < 10) { constexpr int t0 = 2 * (G - 8);
        const LAS unsigned char* ap = st + GS_A + (16 * t0 + li) * APITCH + 16 * g;
        F[0] = LD16(ap); F[1] = LD16(ap + 16 * APITCH); F[2] = LD16(ap + 64); F[3] = LD16(ap + 16 * APITCH + 64);
    } else { constexpr int tk0 = 2 * (G - 10);
        const LAS unsigned char* kp = st + GS_K + (4 * g + q4) * KP + (16 * tk0 + 4 * p4) * 2;
        F[0] = cat8(tr16(kp), tr16(kp + 16 * KP)); F[1] = cat8(tr16(kp + 32), tr16(kp + 32 + 16 * KP)); F[2] = cat8(tr16(kp + 32 * KP), tr16(kp + 48 * KP)); F[3] = cat8(tr16(kp + 32 + 32 * KP), tr16(kp + 32 + 48 * KP));
    }
}
template <int MODE> __device__ __forceinline__ void gd_compute(const GdCtx& X, int idx, const LAS unsigned char* st, int lane, int wave, f32x4 (&S)[8], bf16x8 (&Sb)[4]) {
    const int g = lane >> 4, li = lane & 15, q4 = li >> 2, p4 = li & 3;
    const int c = chunk_of(idx, X.d);
    const LAS float* eg = (const LAS float*)(st + GS_E);
    bf16x8 F0[4], F1[4], F2[4];
    f32x4 vn[4], o1[4], o2[4], ed4[4], e4[4]; u32x2 uu[4]; bf16x8 vb0, vb1, vs0, vs1; float dec;
#define GD_WQ(G, F) { constexpr int t_ = (G) >> 1, hf_ = (G) & 1; \
        if (hf_ == 0) { vn[t_] = (f32x4){bf_lo(uu[t_].x), bf_hi(uu[t_].x), bf_lo(uu[t_].y), bf_hi(uu[t_].y)}; o1[t_] = (f32x4){0.f, 0.f, 0.f, 0.f}; } \
        vn[t_] = MFMA16(F[0], Sb[2 * hf_], vn[t_]); o1[t_] = MFMA16(F[1], Sb[2 * hf_], o1[t_]); vn[t_] = MFMA16(F[2], Sb[2 * hf_ + 1], vn[t_]); o1[t_] = MFMA16(F[3], Sb[2 * hf_ + 1], o1[t_]); }
#define GD_AT(G, F) { constexpr int t_ = 2 * ((G) - 8); o2[t_] = (f32x4){0.f, 0.f, 0.f, 0.f}; o2[t_ + 1] = o2[t_]; \
        o2[t_] = MFMA16(F[0], vb0, o2[t_]); o2[t_ + 1] = MFMA16(F[1], vb0, o2[t_ + 1]); o2[t_] = MFMA16(F[2], vb1, o2[t_]); o2[t_ + 1] = MFMA16(F[3], vb1, o2[t_ + 1]); }
#define GD_KT(G, F) { constexpr int k_ = 2 * ((G) - 10); S[k_] = S[k_] * dec; S[k_ + 1] = S[k_ + 1] * dec; \
        S[k_] = MFMA16(F[0], vs0, S[k_]); S[k_ + 1] = MFMA16(F[1], vs0, S[k_ + 1]); S[k_] = MFMA16(F[2], vs1, S[k_]); S[k_ + 1] = MFMA16(F[3], vs1, S[k_ + 1]); }
#pragma unroll
    for (int t = 0; t < 4; ++t) uu[t] = *(const LAS u32x2*)(st + GS_U + (16 * wave + li) * 144 + (16 * t + 4 * g) * 2);
    gd_ld<0>(st, g, li, q4, p4, F0); gd_ld<1>(st, g, li, q4, p4, F1);
    SCHED_FENCE();
    gd_ld<2>(st, g, li, q4, p4, F2); SCHED_FENCE(); GD_WQ(0, F0); SCHED_FENCE();
    gd_ld<3>(st, g, li, q4, p4, F0); SCHED_FENCE(); GD_WQ(1, F1); SCHED_FENCE();
    gd_ld<4>(st, g, li, q4, p4, F1); SCHED_FENCE(); GD_WQ(2, F2); SCHED_FENCE();
    gd_ld<5>(st, g, li, q4, p4, F2); SCHED_FENCE(); GD_WQ(3, F0); SCHED_FENCE();
    gd_ld<6>(st, g, li, q4, p4, F0); SCHED_FENCE(); GD_WQ(4, F1); SCHED_FENCE();
    gd_ld<7>(st, g, li, q4, p4, F1); SCHED_FENCE(); GD_WQ(5, F2); SCHED_FENCE();
    gd_ld<8>(st, g, li, q4, p4, F2);
#pragma unroll
    for (int t = 0; t < 4; ++t) ed4[t] = *(const LAS f32x4*)(eg + 64 + 16 * t + 4 * g);
    dec = eg[128];
    SCHED_FENCE(); GD_WQ(6, F0); SCHED_FENCE();
    gd_ld<9>(st, g, li, q4, p4, F0); SCHED_FENCE(); GD_WQ(7, F1); SCHED_FENCE();
    vb0 = packacc(vn[0], vn[1]); vb1 = packacc(vn[2], vn[3]);
    gd_ld<10>(st, g, li, q4, p4, F1);
#pragma unroll
    for (int t = 0; t < 4; ++t) e4[t] = *(const LAS f32x4*)(eg + 16 * t + 4 * g);
    SCHED_FENCE(); GD_AT(8, F2);
#pragma unroll
    for (int t = 0; t < 4; ++t) vn[t] = vn[t] * ed4[t];
    vs0 = packacc(vn[0], vn[1]); vs1 = packacc(vn[2], vn[3]);
    SCHED_FENCE();
    gd_ld<11>(st, g, li, q4, p4, F2); SCHED_FENCE(); GD_AT(9, F0); SCHED_FENCE();
    gd_ld<12>(st, g, li, q4, p4, F0); SCHED_FENCE(); GD_KT(10, F1);
    if (!(MODE & 4)) { asm volatile("" :: "v"(o1[0]), "v"(o1[1]), "v"(o1[2]), "v"(o1[3]), "v"(o2[0]), "v"(o2[1]), "v"(o2[2]), "v"(o2[3]), "v"(e4[0]), "v"(e4[1]), "v"(e4[2]), "v"(e4[3])); } else if (c >= 4) {
#pragma unroll
        for (int t = 0; t < 4; ++t) { const f32x4 o = o1[t] * e4[t] + o2[t];
            u32x2 w; w.x = pg8::cvt_pk_bf16(o[0], o[1]); w.y = pg8::cvt_pk_bf16(o[2], o[3]);
            *(LAS u32x2*)((LAS unsigned char*)st + GS_U + (16 * wave + li) * 144 + (16 * t + 4 * g) * 2) = w; } }
    SCHED_FENCE();
    gd_ld<13>(st, g, li, q4, p4, F1); SCHED_FENCE(); GD_KT(11, F2); SCHED_FENCE();
    GD_KT(12, F0); SCHED_FENCE();
    GD_KT(13, F1);
#pragma unroll
    for (int ks = 0; ks < 4; ++ks) Sb[ks] = packacc(S[2 * ks], S[2 * ks + 1]);
#undef GD_WQ
#undef GD_AT
#undef GD_KT
}
template <int WV> __device__ __forceinline__ void gd_flush(const GdCtx& X, int idx, const LAS unsigned char* st, int lane) {
    if (WV != 3) return;
    if (idx < 0 || idx >= NCH) return;
    const int c = chunk_of(idx, X.d); if (c < 4) return;
    const int row0 = chunk_row0(X.b, c), g = lane >> 4, li = lane & 15, q4 = li >> 2, p4 = li & 3, gi = g >> 1, gp = g & 1;
    const LAS unsigned char* tp0 = st + GS_U + (8 * (4 * gp + p4) + q4) * 144 + (4 * gi) * 2;
    bf16* dst0 = X.GO + ((size_t)X.d * ML + row0 + 4 * gi + (li & 3)) * 1024 + X.h * 128 + X.c0 + 8 * (4 * gp + (li >> 2));
#pragma unroll 1
    for (int ib = 0; ib < 8; ++ib) {
        const bf16x8 o = cat8(tr16(tp0 + 16 * ib), tr16(tp0 + 16 * ib + 4 * 144));
        *(bf16x8*)(dst0 + (size_t)(8 * ib) * 1024) = o; }
}
template <int MODE, int WV> __device__ __forceinline__ void gd_loader_loop(const GdCtx& X, LAS unsigned char* st0, LAS unsigned char* st1, int lane) {
    __builtin_amdgcn_s_setprio(3);
    v4u bufA[16], bufB[16]; float evA = 0.f, evB = 0.f;
    if (MODE & 1) { gd_issue<WV>(X, 0, lane, bufA, evA); gd_issue<WV>(X, 1, lane, bufB, evB); }
    for (int idx = -1; idx < NCH; idx += 2) {
        if (!(MODE & 1)) { LDS_BARRIER(); LDS_BARRIER(); continue; }
        if (MODE & 4) gd_flush<WV>(X, idx - 1, st0, lane);
        if (idx + 1 < NCH) gd_store<WV>(st0, lane, bufA, evA); if (idx + 3 < NCH) gd_issue<WV>(X, idx + 3, lane, bufA, evA);
        LDS_BARRIER();
        if (MODE & 4) gd_flush<WV>(X, idx, st1, lane);
        if (idx + 2 < NCH) gd_store<WV>(st1, lane, bufB, evB); if (idx + 4 < NCH) gd_issue<WV>(X, idx + 4, lane, bufB, evB);
        LDS_BARRIER();
    }
}
template <int MODE> __device__ __forceinline__ void gdn_chunk_job(int job, const bf16* GQ, const bf16* GK, const bf16* GW, const bf16* GU, const bf16* GA, const float* GSC, bf16* GO,
                                              LAS unsigned char* lds, int tid, int lane, int wave) {
    const int seq = job & 31;
    GdCtx X; X.GQ = GQ; X.GK = GK; X.GW = GW; X.GU = GU; X.GA = GA; X.GSC = GSC; X.GO = GO; X.b = seq >> 4; X.h = (seq >> 1) & 7; X.d = seq & 1; X.bh = X.b * 8 + X.h; X.c0 = (job >> 5) * 64;
    LAS unsigned char* st0 = lds; LAS unsigned char* st1 = lds + GSTAGE;
    LDS_BARRIER();
    if (wave >= 4) {
        if (wave == 4) gd_loader_loop<MODE, 0>(X, st0, st1, lane); else if (wave == 5) gd_loader_loop<MODE, 1>(X, st0, st1, lane); else if (wave == 6) gd_loader_loop<MODE, 2>(X, st0, st1, lane); else gd_loader_loop<MODE, 3>(X, st0, st1, lane);
    } else {
        f32x4 S[8]; bf16x8 Sb[4];
#pragma unroll
        for (int t = 0; t < 8; ++t) S[t] = (f32x4){0.f, 0.f, 0.f, 0.f};
#pragma unroll
        for (int t = 0; t < 4; ++t) Sb[t] = (bf16x8){0, 0, 0, 0, 0, 0, 0, 0};
        LDS_BARRIER();
#pragma unroll 1
        for (int idx = 0; idx < NCH; ++idx) {
            if (MODE & 2) gd_compute<MODE>(X, idx, (idx & 1) ? st1 : st0, lane, wave, S, Sb);
            LDS_BARRIER();
        }
        LDS_BARRIER();
    }
}
__device__ __forceinline__ void ph_cprep(const bf16* Z1, const bf16* Z2, const float* GF, const float* w_conv, const float* b_gate, const float* a_log, const float* dt_bias, bf16* MS, float* MSC,
                                         bf16* GQ, bf16* GK, bf16* GW, bf16* GU, bf16* GA, float* GSC, LAS unsigned char* lds, int tid, int lane, int wave) {
    for (int gt = blockIdx.x; gt < 16 * NCH; gt += gridDim.x) gdn_prep_task(gt, Z2, GF, w_conv, a_log, dt_bias, GQ, GK, GW, GU, GA, GSC, lds, tid, lane, wave);
    for (int mt = blockIdx.x; mt < 8 * NCH; mt += gridDim.x) mlstm_prep_task(mt, Z1, GF, b_gate, MS, MSC, (LAS float*)lds, tid, lane, wave);
}
__device__ __forceinline__ float red16(float v) { v += __shfl_xor(v, 1); v += __shfl_xor(v, 2); v += __shfl_xor(v, 4); v += __shfl_xor(v, 8); return v; }
__device__ __forceinline__ void ph_scan(const bf16* Z1, const bf16* MS, const float* MSC, const bf16* GQ, const bf16* GK, const bf16* GW, const bf16* GU, const bf16* GA, const float* GSC,
                                        bf16* MO, float* DEN, bf16* GO, const float* w1, const float* w3, const float* w2, unsigned char* ws, LAS unsigned char* lds, int tid, int lane, int wave) {
    for (int job = blockIdx.x; job < 256; job += gridDim.x) {
        if (job < 64) {
            if (SCAN_PROBE_MODE && (SCAN_PROBE_WHICH & 1)) { mlstm_chunk_job<SCAN_PROBE_MODE>(job, Z1, MS, MSC, MO, DEN, lds, tid, lane, wave); __syncthreads(); }
            mlstm_chunk_job<7>(job, Z1, MS, MSC, MO, DEN, lds, tid, lane, wave);
        } else if (job < 128) {
            if (SCAN_PROBE_MODE && (SCAN_PROBE_WHICH & 2)) { gdn_chunk_job<SCAN_PROBE_MODE>(job - 64, GQ, GK, GW, GU, GA, GSC, GO, lds, tid, lane, wave); __syncthreads(); }
            gdn_chunk_job<7>(job - 64, GQ, GK, GW, GU, GA, GSC, GO, lds, tid, lane, wave);
        } else if (job < 128 + TR_BLOCKS) {
            ph_transposes_experts(w1, w3, w2, ws, lds, (job - 128) * NWAVES + wave, TR_BLOCKS * NWAVES, wave, lane);

        }
        __syncthreads();
    }
}

__device__ __forceinline__ void unpack16(const bf16* p, float (&v)[16]) {
    const v4u a = *(const v4u*)p, b = *(const v4u*)(p + 8);
    v[0] = bf_lo(a.x); v[1] = bf_hi(a.x); v[2] = bf_lo(a.y); v[3] = bf_hi(a.y); v[4] = bf_lo(a.z); v[5] = bf_hi(a.z); v[6] = bf_lo(a.w); v[7] = bf_hi(a.w);
    v[8] = bf_lo(b.x); v[9] = bf_hi(b.x); v[10] = bf_lo(b.y); v[11] = bf_hi(b.y); v[12] = bf_lo(b.z); v[13] = bf_hi(b.z); v[14] = bf_lo(b.w); v[15] = bf_hi(b.w);
}
__device__ __forceinline__ void pack16(bf16* p, const float (&v)[16]) {
    v4u a, b; a.x = pk2(v[0], v[1]); a.y = pk2(v[2], v[3]); a.z = pk2(v[4], v[5]); a.w = pk2(v[6], v[7]); b.x = pk2(v[8], v[9]); b.y = pk2(v[10], v[11]); b.z = pk2(v[12], v[13]); b.w = pk2(v[14], v[15]);
    *(v4u*)p = a; *(v4u*)(p + 8) = b;
}
__device__ __forceinline__ void unpack8(const bf16* p, float (&v)[8]) {
    const v4u a = *(const v4u*)p;
    v[0] = bf_lo(a.x); v[1] = bf_hi(a.x); v[2] = bf_lo(a.y); v[3] = bf_hi(a.y); v[4] = bf_lo(a.z); v[5] = bf_hi(a.z); v[6] = bf_lo(a.w); v[7] = bf_hi(a.w);
}
__device__ __forceinline__ void pack8s(bf16* p, const float (&v)[8]) { v4u a; a.x = pk2(v[0], v[1]); a.y = pk2(v[2], v[3]); a.z = pk2(v[4], v[5]); a.w = pk2(v[6], v[7]); *(v4u*)p = a; }
__device__ __forceinline__ void ph_combine(const bf16* Z, const bf16* MO, const float* DEN, const bf16* GO, const float* g_head_m, const float* g_head_d, bf16* Y, int gw, int NGW, int lane) {
    for (int row = gw; row < ML; row += NGW) {
#pragma unroll
        for (int hf = 0; hf < 2; ++hf) { const int c0 = 512 * hf + 8 * lane;
            { float a[8], b2[8], g[8], o[8];
              unpack8(MO + (size_t)row * 1024 + c0, a); unpack8(MO + ((size_t)ML + row) * 1024 + c0, b2); unpack8(Z + (size_t)row * Z1LD + ZC_MO + c0, g);
              const int hd = 2 * hf + (lane >> 5);
              const float i0 = 1.f / fmaxf(fabsf(DEN[(size_t)row * 4 + hd]), 1.f), i1 = 1.f / fmaxf(fabsf(DEN[((size_t)ML + row) * 4 + hd]), 1.f);
              float ss = 0.f;
#pragma unroll
              for (int j = 0; j < 8; ++j) { a[j] = a[j] * i0 + b2[j] * i1; ss += a[j] * a[j]; }
              ss = red16(ss); ss += __shfl_xor(ss, 16);
              const float r = 1.f / sqrtf(ss * (1.f / 256.f) + EPSF);
              const f32x4 w0 = *(const f32x4*)(g_head_m + c0), w1 = *(const f32x4*)(g_head_m + c0 + 4);
#pragma unroll
              for (int j = 0; j < 8; ++j) o[j] = a[j] * r * (j < 4 ? w0[j & 3] : w1[j & 3]) * sigmoidf_(g[j]);
              pack8s(Y + (size_t)row * DM + c0, o); }
            { float a[8], b2[8], g[8], o[8];
              unpack8(GO + (size_t)row * 1024 + c0, a); unpack8(GO + ((size_t)ML + row) * 1024 + c0, b2); unpack8(Z + (size_t)row * Z1LD + ZC_GO + c0, g);
              float ss = 0.f;
#pragma unroll
              for (int j = 0; j < 8; ++j) { a[j] += b2[j]; ss += a[j] * a[j]; }
              ss = red16(ss);
              const float r = 1.f / sqrtf(ss * (1.f / 128.f) + EPSF);
              const f32x4 w0 = *(const f32x4*)(g_head_d + c0), w1 = *(const f32x4*)(g_head_d + c0 + 4);
#pragma unroll
              for (int j = 0; j < 8; ++j) o[j] = a[j] * r * (j < 4 ? w0[j & 3] : w1[j & 3]) * siluf_(g[j]);
              pack8s(Y + (size_t)row * DM + 1024 + c0, o); }
        }
    }
}
typedef float f32x4v __attribute__((ext_vector_type(4)));
constexpr int HB_LD = 2052;
typedef float f32x2_t __attribute__((ext_vector_type(2)));
template <bool DRY> __device__ __forceinline__ void ph_norm2_route(const bf16* X1, const float* g2, const float* ADA, const float* w_grp, const float* b_grp, const float* w_rtr, const float* b_rtr,
                                               bf16* HL2, int* TOK_E, int* TOK_P, float* TOK_W, unsigned* cnt, LAS float* sf, int tid, int lane, int wave) {
    for (int grp16 = blockIdx.x; grp16 < ML / 16; grp16 += gridDim.x) {
#pragma unroll 1
        for (int rr = 0; rr < 2; ++rr) {
            const int r = 2 * wave + rr, row = grp16 * 16 + r;
            const u32x2* src = (const u32x2*)(X1 + (size_t)row * DM); const float* sh = ADA + (size_t)(row / SEQ) * 12288 + 6144; const float* sc = sh + 2048;
            f32x4 v[8]; float s = 0.f;
#pragma unroll
            for (int j = 0; j < 8; ++j) { const u32x2 w = src[lane + 64 * j]; v[j] = (f32x4){bf_lo(w.x), bf_hi(w.x), bf_lo(w.y), bf_hi(w.y)}; s += (v[j].x * v[j].x + v[j].y * v[j].y) + (v[j].z * v[j].z + v[j].w * v[j].w); }
            const float rstd = 1.f / sqrtf(wave_sum(s) * (1.f / DM) + EPSF);
#pragma unroll
            for (int j = 0; j < 8; ++j) { const int col = 4 * (lane + 64 * j);
                const f32x4 g = *(const f32x4*)(g2 + col), a = *(const f32x4*)(sc + col), b = *(const f32x4*)(sh + col);
                const f32x4 o = (v[j] * rstd) * g * (a + 1.f) + b;
                *(LAS f32x4*)(sf + r * HB_LD + col) = o; }
        }
        __syncthreads();
        f32x4v acc0 = {0.f, 0.f, 0.f, 0.f}, acc1 = acc0, acc2 = acc0;
        { const int arow = lane & 15, kg = lane >> 4, bc = lane & 15;
#pragma unroll 1
          for (int kb = 0; kb < 64; kb += 16) {
              float av[16], b0[16], b1[16], b2[16];
#pragma unroll
              for (int u = 0; u < 16; ++u) { const int k = 256 * wave + 4 * (kb + u) + kg;
                  av[u] = sf[arow * HB_LD + k]; const f32x2_t bw = *(const f32x2_t*)(w_rtr + k * 32 + 2 * bc); b0[u] = bw.x; b1[u] = bw.y; b2[u] = bc < 4 ? w_grp[k * 4 + bc] : 0.f; }
              __builtin_amdgcn_sched_barrier(0);
#pragma unroll
              for (int u = 0; u < 16; ++u) {
                  acc0 = __builtin_amdgcn_mfma_f32_16x16x4f32(av[u], b0[u], acc0, 0, 0, 0);
                  acc1 = __builtin_amdgcn_mfma_f32_16x16x4f32(av[u], b1[u], acc1, 0, 0, 0);
                  acc2 = __builtin_amdgcn_mfma_f32_16x16x4f32(av[u], b2[u], acc2, 0, 0, 0); } } }
        __syncthreads();
        { LAS float* red = sf; const int col = lane & 15, r4 = 4 * (lane >> 4);
#pragma unroll
          for (int q = 0; q < 4; ++q) { red[((wave * 3 + 0) * 16 + r4 + q) * 16 + col] = acc0[q]; red[((wave * 3 + 1) * 16 + r4 + q) * 16 + col] = acc1[q]; red[((wave * 3 + 2) * 16 + r4 + q) * 16 + col] = acc2[q]; } }
        __syncthreads();
        for (int i = tid; i < 768; i += NTHREADS) { float s = 0.f;
#pragma unroll
            for (int w = 0; w < 8; ++w) s += sf[w * 768 + i];
            sf[8 * 768 + i] = s; }
        __syncthreads();
        if (tid < 16) {
            const int r = tid, row = grp16 * 16 + r; const LAS float* lg = sf + 8 * 768;
            float gl[4];
#pragma unroll
            for (int i = 0; i < 4; ++i) gl[i] = lg[(2 * 16 + r) * 16 + i] + b_grp[i];
            int gbest = 0; float gmax = gl[0];
#pragma unroll
            for (int i = 1; i < 4; ++i) if (gl[i] > gmax) { gmax = gl[i]; gbest = i; }
            float gsum = 0.f;
#pragma unroll
            for (int i = 0; i < 4; ++i) gsum += expf(gl[i] - gmax);
            const float pgrp = 1.f / gsum;
            float l0 = -3.0e38f, l1 = -3.0e38f; int e0 = 0, e1 = 0;
#pragma unroll
            for (int j = 0; j < 8; ++j) { const int idx = gbest * 8 + j; const float l = lg[((idx & 1) * 16 + r) * 16 + (idx >> 1)] + b_rtr[idx];
                if (l > l0) { l1 = l0; e1 = e0; l0 = l; e0 = j; } else if (l > l1) { l1 = l; e1 = j; } }
            const float t = expf(l1 - l0);
            const float w0 = pgrp / (1.f + t), w1 = pgrp * t / (1.f + t);
            const int ea = gbest * 8 + e0, eb = gbest * 8 + e1;
            if (DRY) { asm volatile("" :: "v"(w0), "v"(w1), "v"(ea), "v"(eb)); } else {
            const int pa = (int)atomicAdd(cnt + 64 * ea, 1u), pb = (int)atomicAdd(cnt + 64 * eb, 1u);
            TOK_E[row * 2] = ea; TOK_E[row * 2 + 1] = eb; TOK_P[row * 2] = pa; TOK_P[row * 2 + 1] = pb; TOK_W[row * 2] = w0; TOK_W[row * 2 + 1] = w1; }
        }
        __syncthreads();
    }
}
__device__ __forceinline__ void build_moe_tables(const unsigned* cnt, LAS int* tb, int tid) {
    __syncthreads();
    if (tid < NE) tb[320 + tid] = (int)__hip_atomic_load(cnt + 64 * tid, __ATOMIC_RELAXED, __HIP_MEMORY_SCOPE_AGENT);
    __syncthreads();
    if (tid == 0) { int acc = 0;
        for (int e = 0; e < NE; ++e) { const int nb = (tb[320 + e] + 255) >> 8; tb[e] = acc;
            for (int p = 0; p < nb; ++p) tb[64 + acc + p] = e;
            acc += nb; }
        tb[32] = acc; }
    __syncthreads();
}
__device__ __forceinline__ void ph_gather(const bf16* X1, const float* g2, const float* ADA, const int* TOK_E, const int* TOK_P, int* TOK_D, bf16* XB, const LAS int* tb, int gw, int NGW, int lane) {
    for (int tok = gw; tok < ML; tok += NGW) {
        const u32x2* src = (const u32x2*)(X1 + (size_t)tok * DM); const float* sh = ADA + (size_t)(tok / SEQ) * 12288 + 6144; const float* sc = sh + 2048;
        f32x4 v[8]; float s = 0.f;
#pragma unroll
        for (int j = 0; j < 8; ++j) { const u32x2 w = src[lane + 64 * j]; v[j] = (f32x4){bf_lo(w.x), bf_hi(w.x), bf_lo(w.y), bf_hi(w.y)}; s += (v[j].x * v[j].x + v[j].y * v[j].y) + (v[j].z * v[j].z + v[j].w * v[j].w); }
        const float rstd = 1.f / sqrtf(wave_sum(s) * (1.f / DM) + EPSF);
        const int e0 = TOK_E[tok * 2], e1 = TOK_E[tok * 2 + 1], d0 = tb[e0] * 256 + TOK_P[tok * 2], d1 = tb[e1] * 256 + TOK_P[tok * 2 + 1];
        unsigned long long* o0 = (unsigned long long*)(XB + (size_t)d0 * DM) + lane; unsigned long long* o1 = (unsigned long long*)(XB + (size_t)d1 * DM) + lane;
#pragma unroll
        for (int j = 0; j < 8; ++j) { const int col = 4 * (lane + 64 * j);
            const f32x4 g = *(const f32x4*)(g2 + col), a = *(const f32x4*)(sc + col), b = *(const f32x4*)(sh + col);
            const f32x4 o = (v[j] * rstd) * g * (a + 1.f) + b;
            const unsigned long long w = (unsigned long long)pk2(o.x, o.y) | ((unsigned long long)pk2(o.z, o.w) << 32);
            o0[64 * j] = w; o1[64 * j] = w; }
        if (lane == 0) { TOK_D[tok * 2] = d0; TOK_D[tok * 2 + 1] = d1; }
    }
}
__device__ __forceinline__ void ph_final(const bf16* X1, float* dst, const bf16* YE, const int* TOK_D, const float* TOK_W, const float* ADA, const float* g_final, int gw, int NGW, int lane) {
    for (int tok = gw; tok < ML; tok += NGW) {
        const int d0 = TOK_D[tok * 2], d1 = TOK_D[tok * 2 + 1]; const float w0 = TOK_W[tok * 2], w1 = TOK_W[tok * 2 + 1];
        const float* gt = ADA + (size_t)(tok / SEQ) * 12288 + 10240;
        const u32x2* xr = (const u32x2*)(X1 + (size_t)tok * DM) + lane;
        const u32x2* y0 = (const u32x2*)(YE + (size_t)d0 * DM) + lane; const u32x2* y1 = (const u32x2*)(YE + (size_t)d1 * DM) + lane;
        f32x4 v[8]; float s = 0.f;
#pragma unroll
        for (int j = 0; j < 8; ++j) { const int col = 4 * (lane + 64 * j);
            const u32x2 xw = xr[64 * j]; const f32x4 xv = {bf_lo(xw.x), bf_hi(xw.x), bf_lo(xw.y), bf_hi(xw.y)}, g = *(const f32x4*)(gt + col); const u32x2 a = y0[64 * j], b = y1[64 * j];
            const f32x4 ya = {bf_lo(a.x), bf_hi(a.x), bf_lo(a.y), bf_hi(a.y)}, yb = {bf_lo(b.x), bf_hi(b.x), bf_lo(b.y), bf_hi(b.y)};
            v[j] = xv + g * (ya * w0 + yb * w1);
            s += (v[j].x * v[j].x + v[j].y * v[j].y) + (v[j].z * v[j].z + v[j].w * v[j].w); }
        const float rstd = 1.f / sqrtf(wave_sum(s) * (1.f / DM) + EPSF);
#pragma unroll
        for (int j = 0; j < 8; ++j) { const int col = 4 * (lane + 64 * j); ((f32x4*)(dst + (size_t)tok * DM))[lane + 64 * j] = (v[j] * rstd) * *(const f32x4*)(g_final + col); }
    }
}
constexpr int NPH = 13;
struct Args { const float* in[24]; float* out; unsigned char* ws; int ph_lo, ph_hi; };
__global__ void __launch_bounds__(NTHREADS, 2) fwd_kernel(Args args) {
    extern __shared__ __attribute__((aligned(16))) unsigned char lds_raw[];
    LAS unsigned char* lds = (LAS unsigned char*)lds_raw;
    LAS float* sf = (LAS float*)lds;
    LAS int* tb = (LAS int*)(lds + TBL_OFF + 256);
    const int tid = threadIdx.x, lane = tid & 63, wave = __builtin_amdgcn_readfirstlane(tid >> 6);
    const int G = gridDim.x, bx = blockIdx.x;
    const int vcu = (G % 8 == 0) ? (bx % 8) * (G / 8) + bx / 8 : bx;
    const int gw = vcu * NWAVES + wave, NGW = G * NWAVES;
    unsigned char* const ws = args.ws;
    unsigned* const ctl = (unsigned*)(ws + WS_CTL);
#define xin ((const float*)args.in[0])
#define cvec ((const float*)args.in[1])
#define ctx ((const float*)args.in[2])
#define c_ctx ((const float*)args.in[3])
#define w_ada ((const float*)args.in[4])
#define b_ada ((const float*)args.in[5])
#define g_norm1 ((const float*)args.in[6])
#define g_norm2 ((const float*)args.in[7])
#define w_in ((const float*)args.in[8])
#define b_gate ((const float*)args.in[9])
#define a_log ((const float*)args.in[10])
#define dt_bias ((const float*)args.in[11])
#define w_conv ((const float*)args.in[12])
#define g_head_m ((const float*)args.in[13])
#define g_head_d ((const float*)args.in[14])
#define w_out ((const float*)args.in[15])
#define w_grp ((const float*)args.in[16])
#define b_grp ((const float*)args.in[17])
#define w_rtr ((const float*)args.in[18])
#define b_rtr ((const float*)args.in[19])
#define w1 ((const float*)args.in[20])
#define w3 ((const float*)args.in[21])
#define w2 ((const float*)args.in[22])
#define g_final ((const float*)args.in[23])
#define out (args.out)
#define cnt (ctl + CW_CNT)
#define ADA ((float*)(ws + WS_ADA))
#define GF ((float*)(ws + WS_GF))
#define MLG ((float*)(ws + WS_MLG))
#define GDG ((float*)(ws + WS_GDG))
#define TOK_E ((int*)(ws + WS_TOK))
#define TOK_P ((int*)(ws + WS_TOK) + 2 * ML)
#define TOK_W ((float*)(ws + WS_TOK) + 4 * ML)
#define TOK_D ((int*)(ws + WS_TOK) + 6 * ML)
#define WinT ((bf16*)(ws + WS_WIN))
#define WoutT ((bf16*)(ws + WS_WOUT))
#define W13T ((bf16*)(ws + WS_W13))
#define W2T ((bf16*)(ws + WS_W2))
#define HL ((bf16*)(ws + WS_HL))
#define Y ((bf16*)(ws + WS_Y))
#define Z1 ((bf16*)(ws + WS_Z1))
#define Z2 ((bf16*)(ws + WS_Z2))
#define GQ ((bf16*)(ws + WS_GQ))
#define GK ((bf16*)(ws + WS_GK))
#define GV ((bf16*)(ws + WS_GV))
#define MO ((bf16*)(ws + WS_MO))
#define GO ((bf16*)(ws + WS_GO))
#define GW ((bf16*)(ws + WS_GW))
#define GU ((bf16*)(ws + WS_GU))
#define GA ((bf16*)(ws + WS_GA))
#define GSC ((float*)(ws + WS_GSC))
#define MS ((bf16*)(ws + WS_MS))
#define MSC ((float*)(ws + WS_MSC))
#define DEN ((float*)(ws + WS_DEN))
#define HL2 ((bf16*)(ws + WS_HL2))
#define XB ((bf16*)(ws + WS_XB))
#define HB ((bf16*)(ws + WS_H))
#define YE ((bf16*)(ws + WS_YE))
#define X1B ((bf16*)(ws + WS_X1B))

    const int lo = args.ph_lo, hi = args.ph_hi;
    volatile LAS unsigned* MISC = (volatile LAS unsigned*)(lds + TBL_OFF);
    if (tid < 64) MISC[tid] = 0u;
    __syncthreads();
    XcdBarrier bar; bar.bar = ctl + CW_BAR; bar.x = 0; bar.st = nullptr;
    if (hi - lo > 1) bar = xcd_barrier_post(ctl + CW_BAR, MISC + 8);
#define IN(k) (lo <= (k) && (k) < hi)
#define SEAM(k) do { if (IN(k) && IN((k) + 1)) { xcd_barrier(bar); \
        if (USE_CG_SYNC && (k) == 0) { cg::this_grid().sync(); if (tid == 0) { __builtin_amdgcn_fence(__ATOMIC_ACQUIRE, "agent"); asm volatile("s_waitcnt vmcnt(0)" ::: "memory"); } __syncthreads(); } } } while (0)

#define RUN(k, ...) do { if (IN(k)) { __VA_ARGS__ if ((REPEAT_MASK >> (k)) & 1) { xcd_barrier(bar); __VA_ARGS__ } } } while (0)
    RUN(0, ph_ada(cvec, c_ctx, w_ada, b_ada, ADA, sf, tid, lane, wave); __syncthreads(); ph_transposes_io(w_in, w_out, ws, lds, gw, NGW, wave, lane););
    SEAM(0);
    RUN(1, ph_norm1(xin, ctx, g_norm1, ADA, HL, gw, NGW, lane););
    SEAM(1);
    RUN(2, { pg8::DenseSched S; S.init(HL, WinT, MT, NZ, DM, G, bx); pg8::EpiZ E{Z1, Z2, GF}; pg8::gemm_phase<pg8::EpiZ, pg8::DenseSched, true, true>(lds, DM, S, E); });
    SEAM(2);
    RUN(4, ph_cprep(Z1, Z2, GF, w_conv, b_gate, a_log, dt_bias, MS, MSC, GQ, GK, GW, GU, GA, GSC, lds, tid, lane, wave););
    SEAM(4);
    RUN(5, ph_scan(Z1, MS, MSC, GQ, GK, GW, GU, GA, GSC, MO, DEN, GO, w1, w3, w2, ws, lds, tid, lane, wave););
    SEAM(5);
    RUN(6, ph_combine(Z1, MO, DEN, GO, g_head_m, g_head_d, Y, gw, NGW, lane););
    SEAM(6);
    RUN(7, { pg8::DenseSched S; S.init(Y, WoutT, ML, DM, DM, G, bx); pg8::EpiX1 E{xin, X1B, ADA}; pg8::gemm_phase<pg8::EpiX1, pg8::DenseSched, true, true>(lds, DM, S, E); });
    SEAM(7);
    if (IN(8)) { if ((REPEAT_MASK >> 8) & 1) { ph_norm2_route<true>(X1B, g_norm2, ADA, w_grp, b_grp, w_rtr, b_rtr, HL2, TOK_E, TOK_P, TOK_W, cnt, sf, tid, lane, wave); xcd_barrier(bar); }
                 ph_norm2_route<false>(X1B, g_norm2, ADA, w_grp, b_grp, w_rtr, b_rtr, HL2, TOK_E, TOK_P, TOK_W, cnt, sf, tid, lane, wave); }
    SEAM(8);
    RUN(9, build_moe_tables(cnt, tb, tid); ph_gather(X1B, g_norm2, ADA, TOK_E, TOK_P, TOK_D, XB, tb, gw, NGW, lane););
    SEAM(9);
    RUN(10, { build_moe_tables(cnt, tb, tid);
                 pg8::MoeSched S; S.A = (const char*)XB; S.Bt = (const char*)W13T; S.a_tstep = (size_t)256 * DM * 2; S.b_estep = (size_t)1536 * DM * 2; S.b_tstep = (size_t)256 * DM * 2;
                 S.nN = 6; S.nunits = tb[32] * 6; S.G = G; S.c = vcu; S.blk2e = tb + 64;
                 pg8::EpiSwiglu E{HB};
                 pg8::gemm_phase<pg8::EpiSwiglu, pg8::MoeSched, true, true>(lds, DM, S, E); });
    SEAM(10);
    RUN(11, { build_moe_tables(cnt, tb, tid);
                  pg8::MoeSched S; S.A = (const char*)HB; S.Bt = (const char*)W2T; S.a_tstep = (size_t)256 * DE * 2; S.b_estep = (size_t)DM * DE * 2; S.b_tstep = (size_t)256 * DE * 2;
                  S.nN = 8; S.nunits = tb[32] * 8; S.G = G; S.c = vcu; S.blk2e = tb + 64;
                  pg8::EpiBf E{YE, DM};
                  pg8::gemm_phase<pg8::EpiBf, pg8::MoeSched, true, true>(lds, DE, S, E); });
    SEAM(11);
    if (IN(12)) { if ((REPEAT_MASK >> 12) & 1) { ph_final(X1B, (float*)(ws + WS_XB), YE, TOK_D, TOK_W, ADA, g_final, gw, NGW, lane); xcd_barrier(bar); }
                  ph_final(X1B, out, YE, TOK_D, TOK_W, ADA, g_final, gw, NGW, lane); }
#undef RUN
#undef IN
#undef SEAM
#undef xin
#undef cvec
#undef ctx
#undef c_ctx
#undef w_ada
#undef b_ada
#undef g_norm1
#undef g_norm2
#undef w_in
#undef b_gate
#undef a_log
#undef dt_bias
#undef w_conv
#undef g_head_m
#undef g_head_d
#undef w_out
#undef w_grp
#undef b_grp
#undef w_rtr
#undef b_rtr
#undef w1
#undef w3
#undef w2
#undef g_final
#undef out
#undef cnt
#undef ADA
#undef GF
#undef MLG
#undef GDG
#undef TOK_E
#undef TOK_P
#undef TOK_W
#undef TOK_D
#undef WinT
#undef WoutT
#undef W13T
#undef W2T
#undef HL
#undef Y
#undef Z1
#undef Z2
#undef GQ
#undef GK
#undef GV
#undef MO
#undef GO
#undef GW
#undef GU
#undef GA
#undef GSC
#undef MS
#undef MSC
#undef DEN
#undef HL2
#undef XB
#undef HB
#undef YE
#undef X1B
}

#ifndef MK_MULTI
#define MK_MULTI 0
#endif
extern "C" void kernel_launch(void* const* d_in, const int* in_sizes, int n_in, void* d_out, int out_size, void* d_ws, size_t ws_size, hipStream_t stream) {
    static int grid = 0;
    if (grid == 0) {
        if (n_in != 24 || in_sizes[0] != ML * DM || out_size != ML * DM || ws_size < WS_END) {
            fprintf(stderr, "kernel_launch: built for 24 inputs, x/out of %d floats, >= %zu bytes of workspace; got n_in %d, in0 %d, out %d, ws %zu; nothing launched\n", ML * DM, (size_t)WS_END, n_in, n_in > 0 ? in_sizes[0] : -1, out_size, ws_size);
            grid = -1; return; }
        int dev = 0, cus = 0, per_cu = 0;
        if (hipGetDevice(&dev) != hipSuccess || hipDeviceGetAttribute(&cus, hipDeviceAttributeMultiprocessorCount, dev) != hipSuccess) { fprintf(stderr, "kernel_launch: device query failed\n"); grid = -1; return; }
        if (hipFuncSetAttribute((const void*)fwd_kernel, hipFuncAttributeMaxDynamicSharedMemorySize, LDS_BYTES) != hipSuccess) { fprintf(stderr, "kernel_launch: hipFuncSetAttribute failed\n"); grid = -1; return; }
        if (hipOccupancyMaxActiveBlocksPerMultiprocessor(&per_cu, (const void*)fwd_kernel, NTHREADS, LDS_BYTES) != hipSuccess || per_cu < 1) { fprintf(stderr, "kernel_launch: occupancy query says %d blocks per CU\n", per_cu); (void)hipGetLastError(); grid = -1; return; }
        grid = cus;
        fprintf(stderr, "kernel_launch: %d CUs, occupancy %d per CU, grid %d\n", cus, per_cu, grid);
    }
    if (grid < 0) return;
    if (hipMemsetAsync((char*)d_ws + WS_CTL, 0, CTL_ZERO_BYTES, stream) != hipSuccess) { fprintf(stderr, "kernel_launch: memset failed\n"); return; }
    Args a{};
    for (int i = 0; i < 24; ++i) a.in[i] = (const float*)d_in[i];
    a.out = (float*)d_out; a.ws = (unsigned char*)d_ws;
#if MK_MULTI
    for (int ph = 0; ph < NPH; ++ph) { a.ph_lo = ph; a.ph_hi = ph + 1; hipLaunchKernelGGL(fwd_kernel, dim3(grid), dim3(NTHREADS), LDS_BYTES, stream, a); }
#else
    a.ph_lo = 0; a.ph_hi = NPH;
    void* params[] = {&a};
    const hipError_t e = hipLaunchCooperativeKernel((const void*)fwd_kernel, dim3(grid), dim3(NTHREADS), params, LDS_BYTES, stream);
    if (e != hipSuccess) fprintf(stderr, "kernel_launch: cooperative launch failed: %s (grid %d)\n", hipGetErrorString(e), grid);
#endif
}
```

```cpp
#include <hip/hip_runtime.h>
#include <hip/hip_cooperative_groups.h>
#include <cstdio>
#include <cstdint>
namespace cg = cooperative_groups;

constexpr int DM = 2048, NB = 2, SEQ = 8192, CTXL = 256;
constexpr int ML = NB * SEQ;
constexpr int MC = NB * CTXL;
constexpr int MT = ML + MC;
constexpr int DIN = 7216, NZ = 7424, ZLD = 7168, GFLD = 64;
constexpr int NE = 32, DE = 768;
constexpr float EPSF = 1e-6f;
constexpr int ZC_MQ = 0, ZC_MK = 512, ZC_MV = 1024, ZC_MO = 2048, ZC_GO = 3072;

constexpr size_t MiB = 1u << 20;
constexpr size_t WS_CTL = 0, CTL_ZERO_BYTES = 1 * MiB;
constexpr size_t WS_ADA = 1 * MiB;
constexpr size_t WS_GF = 2 * MiB;
constexpr size_t WS_MLG = 7 * MiB;
constexpr size_t WS_GDG = 9 * MiB;
constexpr size_t WS_TOK = 12 * MiB;
constexpr size_t WS_WIN = 13 * MiB;
constexpr size_t WS_WOUT = 42 * MiB;
constexpr size_t WS_W13 = 50 * MiB;
constexpr size_t WS_W2 = 242 * MiB;
constexpr size_t WS_Z2 = 50 * MiB;
constexpr size_t WS_HL = 149 * MiB;
constexpr size_t WS_GV = 215 * MiB;
constexpr size_t WS_Z1 = 338 * MiB;
constexpr size_t WS_GQ = 470 * MiB, WS_GK = 503 * MiB;
constexpr size_t WS_Y = 470 * MiB;
constexpr size_t WS_GW = 536 * MiB, WS_GU = 602 * MiB, WS_GA = 668 * MiB, WS_GSC = 701 * MiB;
constexpr size_t WS_MS = 705 * MiB, WS_MSC = 722 * MiB;
constexpr size_t WS_MO = 724 * MiB, WS_GO = 788 * MiB;
constexpr size_t WS_DEN = 12 * MiB + 512 * 1024;
constexpr size_t WS_HL2 = 338 * MiB;
constexpr size_t WS_XB = 402 * MiB;
constexpr size_t WS_H = 562 * MiB;
constexpr size_t WS_YE = 622 * MiB;
constexpr size_t WS_X1B = 788 * MiB;
constexpr size_t WS_END = 852 * MiB;
constexpr int Z1LD = 4096, Z2LD = 3072;
static_assert(WS_Z2 + (size_t)MT * Z2LD * 2 <= WS_HL && WS_HL + (size_t)MT * 2048 * 2 <= WS_GV && WS_GV + (size_t)MT * 1024 * 2 <= WS_Z1, "ws map: pre-scan overlays of the expert region");
static_assert(WS_Z1 + (size_t)MT * Z1LD * 2 <= WS_GQ && WS_GK + (size_t)MT * 1024 * 2 <= WS_GW && WS_GSC + (size_t)2112 * 2 * 192 * 4 <= WS_MS && WS_MS + (size_t)1056 * 2 * 4096 * 2 <= WS_MSC && WS_MSC + (size_t)1056 * 2 * 192 * 4 <= WS_MO && WS_GO + (size_t)2 * ML * 1024 * 2 <= WS_END, "ws map A");
static_assert(WS_GW + (size_t)2112 * 2 * 8192 * 2 <= WS_GU && WS_GU + (size_t)2112 * 2 * 8192 * 2 <= WS_GA && WS_GA + (size_t)2112 * 2 * 4096 * 2 <= WS_GSC, "ws map gdn operands");
static_assert(WS_HL2 + (size_t)ML * 2048 * 2 <= WS_XB && WS_XB + (size_t)40960 * 4096 <= WS_H && WS_H + (size_t)40960 * 1536 <= WS_YE && WS_YE + (size_t)40960 * 4096 <= WS_END, "ws map B");
static_assert(WS_WIN + (size_t)NZ * 2048 * 2 <= WS_WOUT && WS_W13 + (size_t)32 * 1536 * 2048 * 2 <= WS_W2 && WS_W2 + (size_t)32 * 2048 * 768 * 2 <= WS_Z1 && WS_Y + (size_t)ML * 2048 * 2 <= WS_GW, "ws map W");
constexpr int CW_TMO = 0, CW_CNT = 1024, CW_BAR = 4096;

constexpr int SCR_BYTES = 161792;
constexpr int TBL_OFF = SCR_BYTES;
constexpr int LDS_BYTES = 163840;
constexpr int NWAVES = 8, NTHREADS = 512;
#ifndef MLSTM_CHUNKED
#define MLSTM_CHUNKED 1
#endif
#ifndef GDN_CHUNKED
#define GDN_CHUNKED 1
#endif
#ifndef USE_CG_SYNC
#define USE_CG_SYNC 1
#endif
#ifndef TR_BLOCKS
#define TR_BLOCKS 96
#endif
#ifndef SCAN_PROBE_WHICH
#define SCAN_PROBE_WHICH 3
#endif
#ifndef SCAN_PROBE_MODE
#define SCAN_PROBE_MODE 0
#endif
#ifndef REPEAT_MASK
#define REPEAT_MASK 0
#endif
#ifndef E6_ABS
#define E6_ABS 0.02f
#endif
#ifndef E6_REL
#define E6_REL 0.05f
#endif
#ifndef GDN_E5
#define GDN_E5 0
#endif
#ifndef GDN_SCAN_SEQ
#define GDN_SCAN_SEQ 0
#endif

namespace pg8 {
#define PG8_LAS __attribute__((address_space(3)))
typedef unsigned short bf16_t;
typedef short bf16x8 __attribute__((ext_vector_type(8)));
typedef float f32x4 __attribute__((ext_vector_type(4)));
typedef unsigned u32x4 __attribute__((ext_vector_type(4)));
constexpr int BM = 256, BK = 64, HALF = 128, HTB = HALF * BK * 2  , STAGE_BYTES = 8 * HTB, NXCD = 8, WGM = 8;

__host__ __device__ __forceinline__ int lds_byte(int r, int c) { const int st = (r >> 4) * 2 + (c >> 5), rr = r & 15, cc = c & 31, ob = rr * 64 + cc * 2; return st * 1024 + (ob ^ (((ob >> 9) & 1) << 5)); }
__host__ __device__ __forceinline__ void stage_rc(int b, int& R, int& C) { const int st = b / 1024, sb = b % 1024, swz = sb ^ (((sb >> 9) & 1) << 5); R = (st >> 1) * 16 + swz / 64; C = (st & 1) * 32 + (swz % 64) / 2; }
__host__ __device__ __forceinline__ int perm32(int rho) { const int n = rho >> 4, i = rho & 15; return 8 * (i >> 2) + 4 * n + (i & 3); }

struct Unit { int pm, pn; };

struct DenseSched {
    const char* A; const char* Bt; size_t tstep; int nM, nN, nwg, G, c;
    __device__ __forceinline__ void init(const void* A_, const void* Bt_, int M, int N, int K, int G_, int c_) { A = (const char*)A_; Bt = (const char*)Bt_; tstep = (size_t)BM * K * 2; nM = M / BM; nN = N / BM; nwg = nM * nN; G = G_; c = c_; }
    __device__ __forceinline__ bool next(int i, Unit& u) const {
        const long L = (long)i * G + c; if (L >= nwg) return false;
        int wgid = (int)L; { const int q = nwg / NXCD, r = nwg % NXCD, xcd = wgid % NXCD, off = wgid / NXCD; wgid = (xcd < r ? xcd * (q + 1) : r * (q + 1) + (xcd - r) * q) + off; }
        const int nig = WGM * nN, gid = wgid / nig, fm = gid * WGM, gsz = (nM - fm) < WGM ? (nM - fm) : WGM;
        u.pm = fm + ((wgid % nig) % gsz); u.pn = (wgid % nig) / gsz; return true;
    }
    __device__ __forceinline__ const char* a_base(const Unit& u) const { return A + (size_t)u.pm * tstep; }
    __device__ __forceinline__ const char* b_base(const Unit& u) const { return Bt + (size_t)u.pn * tstep; }
    __device__ __forceinline__ void a_ready(const Unit&) const {}
    __device__ __forceinline__ void done(const Unit&) const {}
};
struct MoeSched {
    const char* A; const char* Bt; size_t a_tstep, b_estep, b_tstep; int nN, nunits, G, c; const PG8_LAS int* blk2e;
    __device__ __forceinline__ bool next(int i, Unit& u) const { const long L = (long)i * G + c; if (L >= nunits) return false; u.pm = (int)L / nN; u.pn = (int)L % nN; return true; }
    __device__ __forceinline__ const char* a_base(const Unit& u) const { return A + (size_t)u.pm * a_tstep; }
    __device__ __forceinline__ const char* b_base(const Unit& u) const { return Bt + (size_t)blk2e[u.pm] * b_estep + (size_t)u.pn * b_tstep; }
    __device__ __forceinline__ void a_ready(const Unit&) const {}
    __device__ __forceinline__ void done(const Unit&) const {}
};

typedef float f32x2_cv __attribute__((ext_vector_type(2)));
typedef __bf16 bf16x2_cv __attribute__((ext_vector_type(2)));
__device__ __forceinline__ unsigned cvt_pk_bf16(float lo, float hi) { const f32x2_cv v = {lo, hi}; const bf16x2_cv b = __builtin_convertvector(v, bf16x2_cv); return __builtin_bit_cast(unsigned, b); }
__device__ __forceinline__ u32x4 pack8(const f32x4 v0, const f32x4 v1) { u32x4 w; w.x = cvt_pk_bf16(v0[0], v0[1]); w.y = cvt_pk_bf16(v0[2], v0[3]); w.z = cvt_pk_bf16(v1[0], v1[1]); w.w = cvt_pk_bf16(v1[2], v1[3]); return w; }

struct EpiZ {
    static constexpr bool PERM = true, AFTER_DRAIN = false;
    bf16_t* Z1; bf16_t* Z2; float* GF;
    __device__ __forceinline__ void operator()(const f32x4 (&acc)[2][2][4][2], const Unit& u, int wr, int wc, int fr, int fq) const {
        const int row0 = u.pm * BM + wr * 64 + fr;
        if (u.pn < 28) {
            const bool second = u.pn >= 12 && u.pn < 24;
            bf16_t* base = second ? Z2 : Z1; const int ld = second ? 3072 : 4096;
            const int col0 = (second ? u.pn - 12 : (u.pn < 12 ? u.pn : u.pn - 12)) * BM + wc * 32 + 8 * fq;
#pragma unroll
            for (int ai = 0; ai < 2; ++ai)
#pragma unroll
                for (int m = 0; m < 4; ++m) { bf16_t* rowp = base + (size_t)(row0 + ai * HALF + m * 16) * ld + col0;
#pragma unroll
                    for (int bj = 0; bj < 2; ++bj) *(u32x4*)(rowp + bj * HALF) = pack8(acc[ai][bj][m][0], acc[ai][bj][m][1]); }
        } else if (wc < 2) {
            const int col0 = wc * 32 + 8 * fq;
#pragma unroll
            for (int ai = 0; ai < 2; ++ai)
#pragma unroll
                for (int m = 0; m < 4; ++m) { float* rowp = GF + (size_t)(row0 + ai * HALF + m * 16) * 64 + col0;
                    *(f32x4*)(rowp) = acc[ai][0][m][0]; *(f32x4*)(rowp + 4) = acc[ai][0][m][1]; }
        }
    }
};
struct EpiX1 {
    static constexpr bool PERM = true, AFTER_DRAIN = false;
    const float* x; bf16_t* out; const float* ada;
    __device__ __forceinline__ void operator()(const f32x4 (&acc)[2][2][4][2], const Unit& u, int wr, int wc, int fr, int fq) const {
        const int row0 = u.pm * BM + wr * 64 + fr, col0 = u.pn * BM + wc * 32 + 8 * fq;
        const float* gt = ada + (size_t)((u.pm * BM) / 8192) * 12288 + 4096 + col0;
        f32x4 g[2][2];
#pragma unroll
        for (int bj = 0; bj < 2; ++bj)
#pragma unroll
            for (int n = 0; n < 2; ++n) g[bj][n] = *(const f32x4*)(gt + bj * HALF + 4 * n);
#pragma unroll
        for (int ai = 0; ai < 2; ++ai)
#pragma unroll
            for (int m = 0; m < 4; ++m) { const size_t off = (size_t)(row0 + ai * HALF + m * 16) * 2048 + col0;
#pragma unroll
                for (int bj = 0; bj < 2; ++bj) { const f32x4 x0 = *(const f32x4*)(x + off + bj * HALF), x1 = *(const f32x4*)(x + off + bj * HALF + 4);
                    *(u32x4*)(out + off + bj * HALF) = pack8(x0 + g[bj][0] * acc[ai][bj][m][0], x1 + g[bj][1] * acc[ai][bj][m][1]); } }
    }
};
struct EpiSwiglu {
    static constexpr bool PERM = true, AFTER_DRAIN = false;
    bf16_t* H;
    __device__ __forceinline__ void operator()(const f32x4 (&acc)[2][2][4][2], const Unit& u, int wr, int wc, int fr, int fq) const {
        const int row0 = u.pm * BM + wr * 64 + fr, col0 = u.pn * HALF + wc * 32 + 8 * fq;
#pragma unroll
        for (int ai = 0; ai < 2; ++ai)
#pragma unroll
            for (int m = 0; m < 4; ++m) { f32x4 h[2];
#pragma unroll
                for (int n = 0; n < 2; ++n)
#pragma unroll
                    for (int r = 0; r < 4; ++r) { const float a = acc[ai][0][m][n][r]; h[n][r] = a / (1.f + __expf(-a)) * acc[ai][1][m][n][r]; }
                *(u32x4*)(H + (size_t)(row0 + ai * HALF + m * 16) * 768 + col0) = pack8(h[0], h[1]); }
    }
};
struct EpiBf {
    static constexpr bool PERM = true, AFTER_DRAIN = false;
    bf16_t* O; int ldc;
    __device__ __forceinline__ void operator()(const f32x4 (&acc)[2][2][4][2], const Unit& u, int wr, int wc, int fr, int fq) const {
        const int row0 = u.pm * BM + wr * 64 + fr, col0 = u.pn * BM + wc * 32 + 8 * fq;
#pragma unroll
        for (int ai = 0; ai < 2; ++ai)
#pragma unroll
            for (int m = 0; m < 4; ++m) { bf16_t* rowp = O + (size_t)(row0 + ai * HALF + m * 16) * ldc + col0;
#pragma unroll
                for (int bj = 0; bj < 2; ++bj) *(u32x4*)(rowp + bj * HALF) = pack8(acc[ai][bj][m][0], acc[ai][bj][m][1]); }
    }
};

template <class Epi, class Sched, bool ALIGN_EPI = false, bool SP2 = false>
__device__ __forceinline__ void gemm_phase(PG8_LAS unsigned char* lds, const int K, const Sched& S, const Epi& E) {
    const int tid = threadIdx.x, wid = __builtin_amdgcn_readfirstlane(tid >> 6), lane = tid & 63, wr = wid >> 2, wc = wid & 3, fr = lane & 15, fq = lane >> 4;
    const int nt = K / BK;
    unsigned voffA[2], voffB[2];
#pragma unroll
    for (int i = 0; i < 2; ++i) { int R, C; stage_rc(tid * 16 + i * 8192, R, C); const int Rb = Epi::PERM ? ((R & ~31) + perm32(R & 31)) : R;
        voffA[i] = (unsigned)(R * K + C) * 2u; voffB[i] = (unsigned)(Rb * K + C) * 2u; }
    const size_t kstep = (size_t)(BK * 2);
    const size_t hstep = (size_t)HALF * K * 2;
    const unsigned ldsw = (unsigned)wid * 1024u;
    const int aoff = lds_byte(wr * 64 + fr, fq * 8), boff = lds_byte(wc * 32 + fr, fq * 8);
#define PG8_SA(b, h) (((b) * 2 + (h)) * HTB)
#define PG8_SB(b, h) ((4 + (b) * 2 + (h)) * HTB)
#define PG8_STAGE(bufoff, gbase, voff) do { _Pragma("unroll") for (int _i = 0; _i < 2; ++_i) \
        __builtin_amdgcn_global_load_lds((const unsigned*)((const char*)(gbase) + (voff)[_i]), (PG8_LAS unsigned*)(lds + (bufoff) + ldsw + _i * 8192), 16, 0, 0); } while (0)
#define PG8_LDA(dst, b, h) do { _Pragma("unroll") for (int m = 0; m < 4; ++m) _Pragma("unroll") for (int k = 0; k < 2; ++k) dst[m][k] = *(const PG8_LAS bf16x8*)(lds + PG8_SA(b, h) + aoff + m * 2048 + k * 1024); } while (0)
#define PG8_LDB(dst, b, h) do { _Pragma("unroll") for (int n = 0; n < 2; ++n) _Pragma("unroll") for (int k = 0; k < 2; ++k) dst[n][k] = *(const PG8_LAS bf16x8*)(lds + PG8_SB(b, h) + boff + n * 2048 + k * 1024); } while (0)
#define PG8_MMA(ai, bj, At, Bt) do { __builtin_amdgcn_s_setprio(1); _Pragma("unroll") for (int m = 0; m < 4; ++m) _Pragma("unroll") for (int n = 0; n < 2; ++n) _Pragma("unroll") for (int k = 0; k < 2; ++k) \
        acc[ai][bj][m][n] = __builtin_amdgcn_mfma_f32_16x16x32_bf16(Bt[n][k], At[m][k], acc[ai][bj][m][n], 0, 0, 0); __builtin_amdgcn_s_setprio(0); } while (0)
#define PG8_WAIT_V(n) asm volatile("s_waitcnt vmcnt(" #n ")" ::: "memory")
#define PG8_WAIT_L(n) asm volatile("s_waitcnt lgkmcnt(" #n ")" ::: "memory")
#define PG8_BAR __builtin_amdgcn_s_barrier()
#define PG8_SCHED __builtin_amdgcn_sched_barrier(0)
    Unit cur, nxt; int ui = 0;
    if (!S.next(0, cur)) return;
    f32x4 acc[2][2][4][2];
#pragma unroll
    for (int a = 0; a < 2; ++a)
#pragma unroll
        for (int b = 0; b < 2; ++b)
#pragma unroll
            for (int m = 0; m < 4; ++m)
#pragma unroll
                for (int n = 0; n < 2; ++n) acc[a][b][m][n] = (f32x4){0.f, 0.f, 0.f, 0.f};
    bf16x8 At[4][2], B0[2][2], B1[2][2];
    const char* cA = S.a_base(cur); const char* cB = S.b_base(cur);
    S.a_ready(cur);
    if constexpr (SP2) {
        PG8_STAGE(PG8_SB(0, 0), cB, voffB); PG8_STAGE(PG8_SB(0, 1), cB + hstep, voffB); PG8_STAGE(PG8_SA(0, 0), cA, voffA); PG8_STAGE(PG8_SA(0, 1), cA + hstep, voffA);
        if (wr == 1) PG8_BAR;
        PG8_WAIT_V(2); PG8_BAR;
        PG8_STAGE(PG8_SB(1, 0), cB + kstep, voffB); PG8_STAGE(PG8_SA(1, 0), cA + kstep, voffA); PG8_STAGE(PG8_SB(1, 1), cB + hstep + kstep, voffB);
        PG8_WAIT_V(6); PG8_BAR;
    } else {
        PG8_STAGE(PG8_SB(0, 0), cB, voffB); PG8_STAGE(PG8_SA(0, 0), cA, voffA); PG8_STAGE(PG8_SB(0, 1), cB + hstep, voffB); PG8_STAGE(PG8_SA(0, 1), cA + hstep, voffA);
        if (wr == 1) PG8_BAR;
        PG8_WAIT_V(4); PG8_BAR;
        PG8_STAGE(PG8_SB(1, 0), cB + kstep, voffB); PG8_STAGE(PG8_SA(1, 0), cA + kstep, voffA); PG8_STAGE(PG8_SB(1, 1), cB + hstep + kstep, voffB);
        PG8_WAIT_V(6); PG8_BAR;
    }
    for (;;) {
        const bool has_next = S.next(ui + 1, nxt);
        const char* nA = has_next ? S.a_base(nxt) : cA; const char* nB = has_next ? S.b_base(nxt) : cB;
        for (int t = 0; t < nt; t += 2) {
            const bool last = (t == nt - 2);
            const char* a1 = cA + (size_t)(t + 1) * kstep;
            const char* a2 = last ? nA : cA + (size_t)(t + 2) * kstep; const char* b2 = last ? nB : cB + (size_t)(t + 2) * kstep;
            const char* a3 = a2 + kstep; const char* b3 = b2 + kstep;
            if (last && has_next) S.a_ready(nxt);
            if constexpr (SP2) {
            PG8_LDB(B0, 0, 0); PG8_LDB(B1, 0, 1); PG8_SCHED; PG8_LDA(At, 0, 0); PG8_STAGE(PG8_SA(1, 1), a1 + hstep, voffA);
            PG8_WAIT_V(8); PG8_WAIT_L(0); PG8_BAR; PG8_MMA(0, 0, At, B0); PG8_MMA(0, 1, At, B1); PG8_BAR; PG8_SCHED;
            PG8_LDA(At, 0, 1); PG8_STAGE(PG8_SB(0, 0), b2, voffB); PG8_STAGE(PG8_SB(0, 1), b2 + hstep, voffB); PG8_STAGE(PG8_SA(0, 0), a2, voffA);
            PG8_WAIT_V(8); PG8_WAIT_L(0); PG8_BAR; PG8_MMA(1, 0, At, B0); PG8_MMA(1, 1, At, B1); PG8_BAR; PG8_SCHED;
            PG8_LDB(B0, 1, 0); PG8_LDB(B1, 1, 1); PG8_SCHED; PG8_LDA(At, 1, 0); PG8_STAGE(PG8_SA(0, 1), a2 + hstep, voffA);
            PG8_WAIT_V(8); PG8_WAIT_L(0); PG8_BAR; PG8_MMA(0, 0, At, B0); PG8_MMA(0, 1, At, B1); PG8_BAR; PG8_SCHED;
            PG8_LDA(At, 1, 1); PG8_STAGE(PG8_SB(1, 0), b3, voffB); PG8_STAGE(PG8_SB(1, 1), b3 + hstep, voffB); PG8_STAGE(PG8_SA(1, 0), a3, voffA);
            PG8_WAIT_V(8); PG8_WAIT_L(0); PG8_BAR; PG8_MMA(1, 0, At, B0); PG8_MMA(1, 1, At, B1); PG8_BAR; PG8_SCHED;
            } else {
            PG8_LDB(B0, 0, 0); PG8_SCHED; PG8_LDA(At, 0, 0); PG8_STAGE(PG8_SA(1, 1), a1 + hstep, voffA);
            PG8_WAIT_L(8); PG8_BAR; PG8_WAIT_L(0); PG8_MMA(0, 0, At, B0); PG8_BAR; PG8_SCHED;
            PG8_LDB(B1, 0, 1); PG8_STAGE(PG8_SB(0, 0), b2, voffB);
            PG8_BAR; PG8_WAIT_L(0); PG8_MMA(0, 1, At, B1); PG8_BAR;
            PG8_LDA(At, 0, 1); PG8_STAGE(PG8_SA(0, 0), a2, voffA);
            PG8_BAR; PG8_WAIT_L(0); PG8_MMA(1, 0, At, B0); PG8_BAR; PG8_SCHED;
            PG8_STAGE(PG8_SB(0, 1), b2 + hstep, voffB);
            PG8_WAIT_V(6); PG8_BAR; PG8_MMA(1, 1, At, B1); PG8_BAR;
            PG8_LDB(B0, 1, 0); PG8_SCHED; PG8_LDA(At, 1, 0); PG8_STAGE(PG8_SA(0, 1), a2 + hstep, voffA);
            PG8_WAIT_L(8); PG8_BAR; PG8_WAIT_L(0); PG8_MMA(0, 0, At, B0); PG8_BAR; PG8_SCHED;
            PG8_LDB(B1, 1, 1); PG8_STAGE(PG8_SB(1, 0), b3, voffB);
            PG8_BAR; PG8_WAIT_L(0); PG8_MMA(0, 1, At, B1); PG8_BAR;
            PG8_LDA(At, 1, 1); PG8_STAGE(PG8_SA(1, 0), a3, voffA);
            PG8_BAR; PG8_WAIT_L(0); PG8_MMA(1, 0, At, B0); PG8_BAR; PG8_SCHED;
            PG8_STAGE(PG8_SB(1, 1), b3 + hstep, voffB);
            PG8_WAIT_V(6); PG8_BAR; PG8_MMA(1, 1, At, B1); PG8_BAR;
            }
        }
        if constexpr (ALIGN_EPI) { if (wr == 0) PG8_BAR; }
        if constexpr (!Epi::AFTER_DRAIN) { E(acc, cur, wr, wc, fr, fq); S.done(cur); }
        if (!has_next) break;
#pragma unroll
        for (int a = 0; a < 2; ++a)
#pragma unroll
            for (int b = 0; b < 2; ++b)
#pragma unroll
                for (int m = 0; m < 4; ++m)
#pragma unroll
                    for (int n = 0; n < 2; ++n) acc[a][b][m][n] = (f32x4){0.f, 0.f, 0.f, 0.f};
        cur = nxt; cA = nA; cB = nB; ++ui;
        if constexpr (ALIGN_EPI) { if (wr == 1) PG8_BAR; }
    }
    PG8_WAIT_V(0);
    if constexpr (!ALIGN_EPI) { if (wr == 0) PG8_BAR; }
    PG8_BAR;
    if constexpr (Epi::AFTER_DRAIN) { E.fused(acc, cur, wr, wc, fr, fq, lds, wid, lane); S.done(cur); }
#undef PG8_SA
#undef PG8_SB
#undef PG8_STAGE
#undef PG8_LDA
#undef PG8_LDB
#undef PG8_MMA
#undef PG8_WAIT_V
#undef PG8_WAIT_L
#undef PG8_BAR
#undef PG8_SCHED
}
}
#define GAS __attribute__((address_space(1)))
#define LAS __attribute__((address_space(3)))
typedef unsigned short bf16;
typedef unsigned v4u __attribute__((ext_vector_type(4)));
typedef float f32x4 __attribute__((ext_vector_type(4)));
typedef short bf16x8 __attribute__((ext_vector_type(8)));
typedef GAS unsigned gu32;
typedef GAS unsigned long long gu64;
#define RLX_AGENT __ATOMIC_RELAXED, __HIP_MEMORY_SCOPE_AGENT
#define LDS_WAIT() asm volatile("s_waitcnt lgkmcnt(0)" ::: "memory")
#define VM_WAIT() asm volatile("s_waitcnt vmcnt(0)" ::: "memory")
__device__ __forceinline__ unsigned long long rt() { return __builtin_amdgcn_s_memrealtime(); }
__device__ __forceinline__ unsigned f2bf(float f) { unsigned u = __builtin_bit_cast(unsigned, f); return (u + 0x7fffu + ((u >> 16) & 1u)) >> 16; }
__device__ __forceinline__ unsigned pk2(float lo, float hi) { return f2bf(lo) | (f2bf(hi) << 16); }
typedef unsigned u32x4v_t __attribute__((ext_vector_type(4)));
typedef short v4i16_t __attribute__((ext_vector_type(4)));
__device__ __forceinline__ v4i16_t tr16(const LAS unsigned char* p) { return __builtin_amdgcn_ds_read_tr16_b64_v4i16((LAS v4i16_t*)p); }
__device__ __forceinline__ bf16x8 cat8(v4i16_t lo, v4i16_t hi) { bf16x8 r; r[0] = lo[0]; r[1] = lo[1]; r[2] = lo[2]; r[3] = lo[3]; r[4] = hi[0]; r[5] = hi[1]; r[6] = hi[2]; r[7] = hi[3]; return r; }
__device__ __forceinline__ bf16x8 packacc(const f32x4 a, const f32x4 b) {
    u32x4v_t w; w[0] = pg8::cvt_pk_bf16(a[0], a[1]); w[1] = pg8::cvt_pk_bf16(a[2], a[3]); w[2] = pg8::cvt_pk_bf16(b[0], b[1]); w[3] = pg8::cvt_pk_bf16(b[2], b[3]); return __builtin_bit_cast(bf16x8, w);
}
#define LDS_BARRIER() do { asm volatile("s_waitcnt lgkmcnt(0)" ::: "memory"); __builtin_amdgcn_s_barrier(); asm volatile("" ::: "memory"); } while (0)
#define MFMA16(a, b, c) __builtin_amdgcn_mfma_f32_16x16x32_bf16((a), (b), (c), 0, 0, 0)

#define XB_TMO      128
#define XB_XCNT(j)  (256  + 64 * (j))
#define XB_XSUB(j)  (1280 + 64 * (j))
#define XB_XGEN(j)  (2304 + 64 * (j))
#define XB_TOP      3328
#define XB_TOPGEN   3392
#define XCD_BAR_WORDS 3456
#define XB_SPIN_CAP (1u << 18)

__device__ __forceinline__ unsigned xb_ld(unsigned* p)              { return __hip_atomic_load(p, __ATOMIC_RELAXED, __HIP_MEMORY_SCOPE_AGENT); }
__device__ __forceinline__ unsigned xb_add(unsigned* p, unsigned v) { return __hip_atomic_fetch_add(p, v, __ATOMIC_RELAXED, __HIP_MEMORY_SCOPE_AGENT); }
__device__ __forceinline__ unsigned xb_xcc_id() { return (unsigned)__builtin_amdgcn_s_getreg((3 << 11) | 20) & 0xFu; }
#define XB_SPIN(cond, bar) do { unsigned _sp = 0; while (cond) { __builtin_amdgcn_s_sleep(1); \
    if ((++_sp & 255u) == 0u) { if (xb_ld(&(bar)[XB_TMO])) break; if (_sp > XB_SPIN_CAP) { atomicAdd(&(bar)[XB_TMO], 1u); break; } } } } while (0)

struct XcdBarrier {
    unsigned* bar; unsigned x;
    volatile LAS unsigned* st;
};

__device__ __forceinline__ XcdBarrier xcd_barrier_post(unsigned* bar, volatile LAS unsigned* st) {
    XcdBarrier b; b.bar = bar; b.x = xb_xcc_id(); b.st = st;
    if (threadIdx.x == 0) (void)xb_add(&bar[XB_XCNT(b.x)], 1u);
    return b;
}
__device__ __forceinline__ void xcd_barrier_complete(unsigned* bar, unsigned x, unsigned& nloc, unsigned& nx) {
    const unsigned G = gridDim.x * gridDim.y * gridDim.z;
    unsigned sum, cnt, mine, sp = 0u;
    for (;;) {
        sum = 0u; cnt = 0u; mine = 0u;
#pragma unroll
        for (unsigned j = 0; j < 16; ++j) { const unsigned c = xb_ld(&bar[XB_XCNT(j)]); sum += c; cnt += (c > 0u) ? 1u : 0u; mine = (j == x) ? c : mine; }
        if (sum == G) break;
        __builtin_amdgcn_s_sleep(1);
        if ((++sp & 255u) == 0u) { if (xb_ld(&bar[XB_TMO])) break; if (sp > XB_SPIN_CAP) { atomicAdd(&bar[XB_TMO], 1u); break; } }
    }
    nloc = mine > 0u ? mine : 1u; nx = cnt > 0u ? cnt : 1u;
}

__device__ __forceinline__ void xcd_barrier(const XcdBarrier& b) {
    asm volatile("s_waitcnt vmcnt(0)" ::: "memory");
    __syncthreads();
    if (threadIdx.x == 0) {
        unsigned* bar = b.bar;
        __builtin_amdgcn_s_waitcnt(0);
        unsigned nloc = b.st[0], nx = b.st[1];
        if (nloc == 0u) { xcd_barrier_complete(bar, b.x, nloc, nx); b.st[0] = nloc; b.st[1] = nx; }
        const unsigned old = xb_add(&bar[XB_XSUB(b.x)], 1u);
        const unsigned gen = old / nloc;
        if (old + 1u == (gen + 1u) * nloc) {
            __builtin_amdgcn_fence(__ATOMIC_RELEASE, "agent");
            asm volatile("s_waitcnt vmcnt(0)" ::: "memory");
            const unsigned og = xb_add(&bar[XB_TOP], 1u);
            const unsigned tg = og / nx;
            if (og + 1u == (tg + 1u) * nx) xb_add(&bar[XB_TOPGEN], 1u);
            else XB_SPIN(xb_ld(&bar[XB_TOPGEN]) == tg, bar);
            __builtin_amdgcn_fence(__ATOMIC_ACQUIRE, "agent");
            xb_add(&bar[XB_XGEN(b.x)], 1u);
            asm volatile("s_waitcnt vmcnt(0)" ::: "memory");
        } else {
            XB_SPIN(xb_ld(&bar[XB_XGEN(b.x)]) == gen, bar);
            __builtin_amdgcn_fence(__ATOMIC_ACQUIRE, "agent");
            asm volatile("s_waitcnt vmcnt(0)" ::: "memory");
        }
    }
    __syncthreads();
}
typedef float f32x2 __attribute__((ext_vector_type(2)));
typedef unsigned u32x2 __attribute__((ext_vector_type(2)));
__device__ __forceinline__ float wave_sum(float v) {
#pragma unroll
    for (int o = 1; o < 64; o <<= 1) v += __shfl_xor(v, o);
    return v;
}
__device__ __forceinline__ float bf_lo(unsigned u) { return __builtin_bit_cast(float, u << 16); }
__device__ __forceinline__ float bf_hi(unsigned u) { return __builtin_bit_cast(float, u & 0xffff0000u); }
__device__ __forceinline__ float sigmoidf_(float v) { return 1.f / (1.f + expf(-v)); }
__device__ __forceinline__ float siluf_(float v) { return v / (1.f + expf(-v)); }
__device__ __forceinline__ float softplusf_(float v) { return fmaxf(v, 0.f) + log1pf(expf(-fabsf(v))); }

__device__ __forceinline__ void ph_ada(const float* c, const float* c_ctx, const float* w_ada, const float* b_ada, float* ADA, LAS float* sf, int tid, int lane, int wave) {
    if ((int)blockIdx.x >= 192) return;
    for (int i = tid; i < 3 * 2048; i += NTHREADS) { const float v = (i < 4096) ? c[i] : c_ctx[i - 4096]; sf[i] = siluf_(v); }
    __syncthreads();
    for (int task = blockIdx.x; task < 192; task += gridDim.x) {
        const int r4 = lane >> 4, c4 = lane & 15;
        const float* wp = w_ada + (size_t)(wave * 256 + r4) * 12288 + task * 64 + 4 * c4;
        f32x4 a0 = {0.f, 0.f, 0.f, 0.f}, a1 = a0, a2 = a0;
#pragma unroll 1
        for (int jb = 0; jb < 64; jb += 16) { f32x4 w[16];
#pragma unroll
            for (int j = 0; j < 16; ++j) w[j] = *(const f32x4*)(wp + (size_t)(4 * (jb + j)) * 12288);
#pragma unroll
            for (int j = 0; j < 16; ++j) { const int kk = wave * 256 + 4 * (jb + j) + r4; a0 += w[j] * sf[kk]; a1 += w[j] * sf[2048 + kk]; a2 += w[j] * sf[4096 + kk]; } }
#pragma unroll
        for (int q = 0; q < 4; ++q) { a0[q] += __shfl_xor(a0[q], 16); a0[q] += __shfl_xor(a0[q], 32); a1[q] += __shfl_xor(a1[q], 16); a1[q] += __shfl_xor(a1[q], 32); a2[q] += __shfl_xor(a2[q], 16); a2[q] += __shfl_xor(a2[q], 32); }
        LAS float* red = sf + 6144;
        if (r4 == 0) { *(LAS f32x4*)(red + (wave * 3 + 0) * 64 + 4 * c4) = a0; *(LAS f32x4*)(red + (wave * 3 + 1) * 64 + 4 * c4) = a1; *(LAS f32x4*)(red + (wave * 3 + 2) * 64 + 4 * c4) = a2; }
        __syncthreads();
        if (tid < 192) { const int r = tid >> 6, l = tid & 63; float s = 0.f;
#pragma unroll
            for (int w = 0; w < 8; ++w) s += red[(w * 3 + r) * 64 + l];
            ADA[r * 12288 + task * 64 + l] = s + b_ada[task * 64 + l]; }
        __syncthreads();
    }
}
__device__ __forceinline__ int rowmap(int n, int mode, int s128, int off) {
    if (mode == 0) return (n >> 7) * s128 + (n & 127) + off;
    if (n < 3072) return n;
    if (n < 3088) return 7168 + (n - 3072);
    if (n < 7184) return n - 16;
    return n;
}
__device__ __forceinline__ void transpose_item(const float* W, int K, int N, bf16* WT, int mode, int s128, int off, LAS float* scr, int item, int lane) {
    const int nblk = (N + 31) >> 5, kb = item / nblk, nb = item - kb * nblk, k0 = 64 * kb, n0 = 32 * nb;
    const int nn = n0 + (lane & 31); const bool ok = nn < N;
#pragma unroll 8
    for (int i = 0; i < 32; ++i) { const int kk = 2 * i + (lane >> 5); scr[kk * 33 + (lane & 31)] = ok ? W[(size_t)(k0 + kk) * N + nn] : 0.f; }
    LDS_WAIT(); asm volatile("" ::: "memory");
    const int cc = lane & 7;
#pragma unroll
    for (int j = 0; j < 4; ++j) { const int n = (lane >> 3) + 8 * j;
        if (n0 + n < N) { const LAS float* s = scr + (8 * cc) * 33 + n;
            v4u o; o.x = pk2(s[0 * 33], s[1 * 33]); o.y = pk2(s[2 * 33], s[3 * 33]); o.z = pk2(s[4 * 33], s[5 * 33]); o.w = pk2(s[6 * 33], s[7 * 33]);
            *(GAS v4u*)(WT + (size_t)rowmap(n0 + n, mode, s128, off) * K + k0 + 8 * cc) = o; } }
    LDS_WAIT(); asm volatile("" ::: "memory");
}
struct T64Src { const float* W; bf16* WT; int K, N, mode, s128, off, item; };
__device__ __forceinline__ void tile64_load(const T64Src& S, int lane, f32x4 (&v)[16]) {
    const int nblk = S.N >> 6, kb = S.item / nblk, nb = S.item - kb * nblk;
    const float* src = S.W + (size_t)(64 * kb + (lane >> 4)) * S.N + 64 * nb + 4 * (lane & 15);
#pragma unroll
    for (int j = 0; j < 16; ++j) v[j] = *(const f32x4*)(src + (size_t)(4 * j) * S.N);
}
__device__ __forceinline__ void tile64_finish(const T64Src& S, int lane, const f32x4 (&v)[16], LAS unsigned char* tile) {
    const int nblk = S.N >> 6, kb = S.item / nblk, nb = S.item - kb * nblk, k0 = 64 * kb, n0 = 64 * nb;
#pragma unroll
    for (int j = 0; j < 16; ++j) { u32x2 w; w.x = pg8::cvt_pk_bf16(v[j][0], v[j][1]); w.y = pg8::cvt_pk_bf16(v[j][2], v[j][3]);
        *(LAS u32x2*)(tile + (4 * j + (lane >> 4)) * 144 + (lane & 15) * 8) = w; }
    LDS_WAIT(); asm volatile("" ::: "memory");
    const int g = lane >> 4, li = lane & 15, q4 = li >> 2, p4 = li & 3, gi = g >> 1, gp = g & 1;
    const LAS unsigned char* tp0 = tile + (8 * (4 * gp + p4) + q4) * 144 + (4 * gi) * 2;
#pragma unroll
    for (int ib = 0; ib < 8; ++ib) {
        const bf16x8 o = cat8(tr16(tp0 + 16 * ib), tr16(tp0 + 16 * ib + 4 * 144));
        const int n = n0 + 8 * ib + 4 * gi + (li & 3);
        *(bf16x8*)(S.WT + (size_t)rowmap(n, S.mode, S.s128, S.off) * S.K + k0 + 8 * (4 * gp + (li >> 2))) = o; }
    LDS_WAIT(); asm volatile("" ::: "memory");
}
__device__ __forceinline__ T64Src expert_item(const float* w1, const float* w3, const float* w2, unsigned char* ws, int it) {
    constexpr int I_E = 32 * 12, I_E2 = 12 * 32;
    bf16* W13T = (bf16*)(ws + WS_W13); bf16* W2T = (bf16*)(ws + WS_W2);
    const int e = it / (2 * I_E + I_E2); int r = it - e * (2 * I_E + I_E2);
    T64Src S;
    if (r < I_E) { S.W = w1 + (size_t)e * 2048 * 768; S.WT = W13T + (size_t)e * 1536 * 2048; S.K = 2048; S.N = 768; S.mode = 0; S.s128 = 256; S.off = 0; S.item = r; }
    else if (r < 2 * I_E) { S.W = w3 + (size_t)e * 2048 * 768; S.WT = W13T + (size_t)e * 1536 * 2048; S.K = 2048; S.N = 768; S.mode = 0; S.s128 = 256; S.off = 128; S.item = r - I_E; }
    else { S.W = w2 + (size_t)e * 768 * 2048; S.WT = W2T + (size_t)e * 2048 * 768; S.K = 768; S.N = 2048; S.mode = 0; S.s128 = 128; S.off = 0; S.item = r - 2 * I_E; }
    return S;
}
__device__ __forceinline__ void ph_transposes_experts(const float* w1, const float* w3, const float* w2, unsigned char* ws, LAS unsigned char* lds, int gw, int NGW, int wave, int lane) {
    asm volatile("" : "+v"(lane));
    LAS unsigned char* tile = lds + wave * 9216;
    constexpr int NIT = 32 * (2 * 32 * 12 + 12 * 32);
    f32x4 va[16], vb[16];
    int it = gw;
    if (it >= NIT) return;
    T64Src A = expert_item(w1, w3, w2, ws, it), B = A;
    tile64_load(A, lane, va);
    for (;;) {
        const bool hb = it + NGW < NIT;
        if (hb) { B = expert_item(w1, w3, w2, ws, it + NGW); tile64_load(B, lane, vb); }
        tile64_finish(A, lane, va, tile);
        if (!hb) break;
        it += 2 * NGW;
        const bool ha = it < NIT;
        if (ha) { A = expert_item(w1, w3, w2, ws, it); tile64_load(A, lane, va); }
        tile64_finish(B, lane, vb, tile);
        if (!ha) break;
    }
}

__device__ __forceinline__ T64Src io_item(const float* w_in, const float* w_out, unsigned char* ws, int it) {
    T64Src S; constexpr int I_IN = 32 * 112;
    if (it < I_IN) { S.W = w_in; S.WT = (bf16*)(ws + WS_WIN); S.K = 2048; S.N = DIN; S.mode = 1; S.s128 = 0; S.off = 0; S.item = it; }
    else { S.W = w_out; S.WT = (bf16*)(ws + WS_WOUT); S.K = 2048; S.N = 2048; S.mode = 0; S.s128 = 128; S.off = 0; S.item = it - I_IN; }
    return S;
}
__device__ __forceinline__ void ph_transposes_io(const float* w_in, const float* w_out, unsigned char* ws, LAS unsigned char* lds, int gw, int NGW, int wave, int lane) {
    LAS unsigned char* tile = lds + wave * 9216;
    constexpr int NIT = 32 * 112 + 32 * 32;
    f32x4 va[16], vb[16];
    int it = gw;
    if (it < NIT) {
        T64Src A = io_item(w_in, w_out, ws, it), B = A;
        tile64_load(A, lane, va);
        for (;;) {
            const bool hb = it + NGW < NIT;
            if (hb) { B = io_item(w_in, w_out, ws, it + NGW); tile64_load(B, lane, vb); }
            tile64_finish(A, lane, va, tile);
            if (!hb) break;
            it += 2 * NGW;
            const bool ha = it < NIT;
            if (ha) { A = io_item(w_in, w_out, ws, it); tile64_load(A, lane, va); }
            tile64_finish(B, lane, vb, tile);
            if (!ha) break;
        }
    }
    LAS float* scr = (LAS float*)(lds + 73728 + wave * 8448);
    for (int t = gw; t < 64; t += NGW) transpose_item(w_in, 2048, DIN, (bf16*)(ws + WS_WIN), 1, 0, 0, scr, (t >> 1) * 226 + 224 + (t & 1), lane);
}
__device__ __forceinline__ void ph_norm1(const float* x, const float* ctx, const float* g1, const float* ADA, bf16* HL, int gw, int NGW, int lane) {
    for (int row = gw; row < MT; row += NGW) {
        const float* src = row < ML ? x + (size_t)row * DM : ctx + (size_t)(row - ML) * DM;
        const float* sh = ADA + (size_t)(row < ML ? row / SEQ : 2) * 12288; const float* sc = sh + 2048;
        f32x4 v[8]; float s = 0.f;
#pragma unroll
        for (int j = 0; j < 8; ++j) { v[j] = ((const f32x4*)src)[lane + 64 * j]; s += (v[j].x * v[j].x + v[j].y * v[j].y) + (v[j].z * v[j].z + v[j].w * v[j].w); }
        const float rstd = 1.f / sqrtf(wave_sum(s) * (1.f / DM) + EPSF);
        unsigned long long* o8 = (unsigned long long*)(HL + (size_t)row * DM) + lane;
#pragma unroll
        for (int j = 0; j < 8; ++j) { const int col = 4 * (lane + 64 * j);
            const f32x4 g = *(const f32x4*)(g1 + col), a = *(const f32x4*)(sc + col), b = *(const f32x4*)(sh + col);
            const f32x4 o = (v[j] * rstd) * g * (a + 1.f) + b;
            o8[64 * j] = (unsigned long long)pk2(o.x, o.y) | ((unsigned long long)pk2(o.z, o.w) << 32); }
    }
}

__device__ __forceinline__ float silu_fast(float v) { return v * __builtin_amdgcn_rcpf(1.f + __expf(-v)); }
__device__ __forceinline__ void ph_prep(const bf16* Z, const float* GF, const float* w_conv, const float* b_gate, const float* a_log, const float* dt_bias,
                                        bf16* GQ, bf16* GK, bf16* GV, float* MLG, float* GDG, int tid, int lane, int gw, int NGW) {
    for (int it = gw; it < 264 * 24 * 2; it += NGW) {
        const int ci = it / 48, rem = it - ci * 48, gi = rem >> 1, half = rem & 1;
        int rowbase, tlo, thi, t0;
        if (ci < 256) { rowbase = (ci >> 7) * SEQ + (ci & 127) * 64; tlo = 0; thi = 64; t0 = 0; }
        else { const int cc = ci - 256; rowbase = ML + (cc >> 2) * CTXL; tlo = 0; thi = 256; t0 = (cc & 3) * 64; }
        const int type = gi >> 3, head = gi & 7, ch = type * 1024 + head * 128 + 2 * lane;
        float w0[5], w1[5];
#pragma unroll
        for (int j = 0; j < 5; ++j) { w0[j] = w_conv[j * 3072 + ch]; w1[j] = w_conv[j * 3072 + ch + 1]; }
        bf16* dst = (type == 0 ? GQ : (type == 1 ? GK : GV)) + head * 128 + 2 * lane;
        const float qs = type == 0 ? 0.08838834764831845f : 1.f;
#pragma unroll 1
        for (int sub = 2 * half; sub < 2 * half + 2; ++sub) {
            unsigned zr[20];
#pragma unroll
            for (int i = 0; i < 20; ++i) { const int t = t0 + sub * 16 + i - 2; zr[i] = (t >= tlo && t < thi) ? *(const unsigned*)(Z + (size_t)(rowbase + t) * Z2LD + ch) : 0u; }
            float o0[16], o1[16];
#pragma unroll
            for (int i = 0; i < 16; ++i) { float a0 = 0.f, a1 = 0.f;
#pragma unroll
                for (int j = 0; j < 5; ++j) { a0 += w0[j] * bf_lo(zr[i + j]); a1 += w1[j] * bf_hi(zr[i + j]); }
                o0[i] = silu_fast(a0); o1[i] = silu_fast(a1); }
            if (type < 2) {
#pragma unroll
                for (int i = 0; i < 16; ++i) { const float ss = wave_sum(o0[i] * o0[i] + o1[i] * o1[i]); const float sc = qs * __builtin_amdgcn_rsqf(ss + EPSF); o0[i] *= sc; o1[i] *= sc; } }
#pragma unroll
            for (int i = 0; i < 16; ++i) *(unsigned*)(dst + (size_t)(rowbase + t0 + sub * 16 + i) * 1024) = pk2(o0[i], o1[i]);
        }
    }
    const int gt = blockIdx.x * NTHREADS + (int)threadIdx.x, NGT = gridDim.x * NTHREADS;
    for (int e = gt; e < MT * 48; e += NGT) {
        const int row = e / 48, idx = e - row * 48; const float v = GF[(size_t)row * GFLD + idx];
        if (idx < 16) { float p = v + b_gate[idx]; p = 15.f * tanhf(p * (1.f / 15.f)); const int type = (idx >> 2) & 1;
            MLG[(size_t)row * 16 + idx] = type == 0 ? p : -softplusf_(-p); }
        else if (idx < 32) { const int j = idx - 16; GDG[(size_t)row * 32 + j] = -expf(a_log[j]) * softplusf_(v + dt_bias[j]); }
        else { const int j = idx - 32; GDG[(size_t)row * 32 + 16 + j] = sigmoidf_(v); }
    }
}
constexpr int NCH = 132;
constexpr float QSCALE = 0.08838834764831845f;
__device__ __forceinline__ int chunk_row0(int b, int c) { return c < 4 ? ML + b * CTXL + c * 64 : b * SEQ + (c - 4) * 64; }
__device__ __forceinline__ int chunk_of(int idx, int d) { return d == 0 ? idx : (idx < 4 ? 3 - idx : 135 - idx); }
__device__ __forceinline__ float wave_incl_scan(float v, int lane) {
#pragma unroll
    for (int o = 1; o < 64; o <<= 1) { const float t = __shfl_up(v, o); if (lane >= o) v += t; }
    return v;
}
__device__ __forceinline__ void mlstm_prep_task(int mt, const bf16* Z, const float* GF, const float* b_gate, bf16* MS, float* MSC, LAS float* sf, int tid, int lane, int wave) {
    const int bh = mt / NCH, c = mt - bh * NCH, b = bh >> 2, h = bh & 3, row0 = chunk_row0(b, c);
    LAS float* bq = sf; LAS float* lis = sf + 128;
    __syncthreads();
    if (tid < 128) { const int d = tid >> 6, r = d ? 63 - lane : lane;
        float pf = GF[(size_t)(row0 + r) * GFLD + d * 8 + 4 + h] + b_gate[d * 8 + 4 + h], pi = GF[(size_t)(row0 + r) * GFLD + d * 8 + h] + b_gate[d * 8 + h];
        pf = 15.f * tanhf(pf * (1.f / 15.f)); pi = 15.f * tanhf(pi * (1.f / 15.f));
        const float lfv = -softplusf_(-pf), liv = pi;
        const float bc = wave_incl_scan(lfv, lane), bl = __shfl(bc, 63);
        bq[d * 64 + r] = bc; lis[d * 64 + r] = liv;
        float* sc = MSC + ((size_t)mt * 2 + d) * 192;
        sc[r] = __expf(bl - bc + liv); sc[64 + r] = QSCALE * __expf(bc); if (lane == 0) sc[128] = __expf(bl); }
    __syncthreads();
    const int g = lane >> 4, li = lane & 15, tm = wave >> 1;
    const bf16* Kp = Z + (size_t)(row0 + 16 * tm + li) * Z1LD + ZC_MK + h * 128 + 8 * g;
    bf16x8 ka[4];
#pragma unroll
    for (int ks = 0; ks < 4; ++ks) ka[ks] = *(const bf16x8*)(Kp + 32 * ks);
#pragma unroll
    for (int tt = 0; tt < 2; ++tt) { const int tn = 2 * (wave & 1) + tt;
        const bf16* Qp = Z + (size_t)(row0 + 16 * tn + li) * Z1LD + ZC_MQ + h * 128 + 8 * g;
        f32x4 acc = {0.f, 0.f, 0.f, 0.f};
#pragma unroll
        for (int ks = 0; ks < 4; ++ks) acc = MFMA16(ka[ks], *(const bf16x8*)(Qp + 32 * ks), acc);
        const int r = 16 * tn + li, s0 = 16 * tm + 4 * g;
#pragma unroll
        for (int d = 0; d < 2; ++d) { float o[4]; const float br = bq[d * 64 + r];
#pragma unroll
            for (int q = 0; q < 4; ++q) { const int s = s0 + q; const bool ok = d == 0 ? (s <= r) : (s >= r);
                o[q] = ok ? acc[q] * QSCALE * __expf(br - bq[d * 64 + s] + lis[d * 64 + s]) : 0.f; }
            u32x2 w; w.x = pg8::cvt_pk_bf16(o[0], o[1]); w.y = pg8::cvt_pk_bf16(o[2], o[3]);
            *(u32x2*)(MS + (((size_t)mt * 2 + d) * 64 + r) * 64 + s0) = w; }
    }
}
constexpr int MQ_OFF = 0, MK_OFF = 17408, MV_OFF = 34816, MSS_OFF = 44032, ME_OFF = 53248, MSTAGE = 54272;
struct MlCtx { const bf16* Z; const bf16* MS; const float* MSC; bf16* MOR; float* DEN; int b, h, d, bh, v0, slice; };
template <int wv> __device__ __forceinline__ void ml_issue(const MlCtx& X, int idx, int lane, v4u (&buf)[16], f32x4& ev) {
    const int cn = chunk_of(idx, X.d), mt = X.bh * NCH + cn, row0 = chunk_row0(X.b, cn);
    const float* sc = X.MSC + ((size_t)mt * 2 + X.d) * 192;
    const char* zrow = (const char*)(X.Z + (size_t)row0 * Z1LD);
    const unsigned o16 = (unsigned)(lane >> 4) * (Z1LD * 2) + (unsigned)(lane & 15) * 16, o8r = (unsigned)(lane >> 3) * (Z1LD * 2) + (unsigned)(lane & 7) * 16, ol = (unsigned)lane * 16;
    const char* bQ = zrow + (ZC_MQ + X.h * 128) * 2; const char* bK = zrow + (ZC_MK + X.h * 128) * 2; const char* bV = zrow + (ZC_MV + X.h * 256 + X.v0) * 2; const char* bS = (const char*)(X.MS + ((size_t)mt * 2 + X.d) * 4096);
#pragma unroll
    for (int i = 0; i < 16; ++i) { const int pb = 64 * (wv + 3 * i);
        const char* base = pb < 1024 ? bQ + (size_t)(pb >> 4) * (Z1LD * 2) : (pb < 2048 ? bK + (size_t)((pb - 1024) >> 4) * (Z1LD * 2) : (pb < 2560 ? bV + (size_t)((pb - 2048) >> 3) * (Z1LD * 2) : bS + (size_t)(pb - 2560) * 16));
        buf[i] = *(const v4u*)(base + (pb < 2048 ? o16 : (pb < 2560 ? o8r : ol))); }
    ev = (f32x4){sc[lane], sc[64 + lane], sc[128], 0.f};
}
template <int wv> __device__ __forceinline__ void ml_store(LAS unsigned char* st, int lane, const v4u (&buf)[16], const f32x4 ev) {
    const unsigned l16 = (unsigned)(lane >> 4) * 272 + (unsigned)(lane & 15) * 16, l8 = (unsigned)(lane >> 3) * 144 + (unsigned)(lane & 7) * 16;
#pragma unroll
    for (int i = 0; i < 16; ++i) { const int pb = 64 * (wv + 3 * i);
        const unsigned uo = pb < 1024 ? (unsigned)(MQ_OFF + (pb >> 4) * 272) : (pb < 2048 ? (unsigned)(MK_OFF + ((pb - 1024) >> 4) * 272) : (pb < 2560 ? (unsigned)(MV_OFF + ((pb - 2048) >> 3) * 144) : (unsigned)(MSS_OFF + ((pb - 2560) >> 3) * 144)));
        *(LAS v4u*)(st + uo + (pb < 2048 ? l16 : l8)) = buf[i]; }
    if (wv == 0) { LAS float* e = (LAS float*)(st + ME_OFF); e[lane] = ev[1]; e[128 + lane] = ev[0]; if (lane == 0) e[64] = ev[2]; }
}
template <int MODE> __device__ __forceinline__ void ml_compute(const MlCtx& X, int idx, const LAS unsigned char* st, int lane, int wave, f32x4 (&CT)[8], bf16x8 (&Cb)[4]) {
    const int g = lane >> 4, li = lane & 15, q4 = li >> 2, p4 = li & 3;
    const int c = chunk_of(idx, X.d), row0 = chunk_row0(X.b, c), d = X.d, h = X.h;
    const LAS float* ep = (const LAS float*)(st + ME_OFF);
    bf16x8 Vf[2], Vw[2];
#pragma unroll
    for (int s2 = 0; s2 < 2; ++s2) {
        const f32x4 ea0 = *(const LAS f32x4*)(ep + 128 + 32 * s2 + 8 * g), ea1 = *(const LAS f32x4*)(ep + 128 + 32 * s2 + 8 * g + 4);
        if (wave < 4) { const LAS unsigned char* vp = st + MV_OFF + (32 * s2 + 8 * g + q4) * 144 + (16 * wave + 4 * p4) * 2;
            const v4i16_t lo = tr16(vp), hi = tr16(vp + 4 * 144); Vf[s2] = cat8(lo, hi);
            const f32x4 a = {bf_lo((unsigned)(unsigned short)lo[0]), bf_lo((unsigned)(unsigned short)lo[1]), bf_lo((unsigned)(unsigned short)lo[2]), bf_lo((unsigned)(unsigned short)lo[3])};
            const f32x4 b2 = {bf_lo((unsigned)(unsigned short)hi[0]), bf_lo((unsigned)(unsigned short)hi[1]), bf_lo((unsigned)(unsigned short)hi[2]), bf_lo((unsigned)(unsigned short)hi[3])};
            Vw[s2] = packacc(a * ea0, b2 * ea1);
        } else { const short one = li == 0 ? (short)0x3f80 : (short)0; Vf[s2] = (bf16x8){one, one, one, one, one, one, one, one};
            const f32x4 z = {0.f, 0.f, 0.f, 0.f}; Vw[s2] = li == 0 ? packacc(ea0, ea1) : packacc(z, z); }
    }
    __builtin_amdgcn_sched_barrier(0);
    if (c >= 4) {
        f32x4 num[4], e4[4]; bf16x8 qf[4][4], sfr[4][2];
#pragma unroll
        for (int t = 0; t < 4; ++t) { const LAS unsigned char* qp = st + MQ_OFF + (16 * t + li) * 272 + (4 * g) * 2;
#pragma unroll
            for (int ks = 0; ks < 4; ++ks) qf[t][ks] = cat8(*(const LAS v4i16_t*)(qp + 64 * ks), *(const LAS v4i16_t*)(qp + 64 * ks + 32));
            const LAS unsigned char* sp = st + MSS_OFF + (16 * t + li) * 144 + (8 * g) * 2;
            sfr[t][0] = *(const LAS bf16x8*)(sp); sfr[t][1] = *(const LAS bf16x8*)(sp + 64);
            e4[t] = *(const LAS f32x4*)(ep + 16 * t + 4 * g); num[t] = (f32x4){0.f, 0.f, 0.f, 0.f}; }
        __builtin_amdgcn_sched_barrier(0);
#pragma unroll
        for (int ks = 0; ks < 4; ++ks)
#pragma unroll
            for (int t = 0; t < 4; ++t) num[t] = MFMA16(qf[t][ks], Cb[ks], num[t]);
#pragma unroll
        for (int t = 0; t < 4; ++t) num[t] = num[t] * e4[t];
#pragma unroll
        for (int s2 = 0; s2 < 2; ++s2)
#pragma unroll
            for (int t = 0; t < 4; ++t) num[t] = MFMA16(sfr[t][s2], Vf[s2], num[t]);
        if (!(MODE & 4)) { asm volatile("" :: "v"(num[0]), "v"(num[1]), "v"(num[2]), "v"(num[3])); } else if (wave < 4) {
#pragma unroll
            for (int t = 0; t < 4; ++t)
#pragma unroll
                for (int q = 0; q < 4; ++q) *(LAS unsigned short*)((LAS unsigned char*)st + MV_OFF + (16 * t + 4 * g + q) * 144 + (16 * wave + li) * 2) = (unsigned short)f2bf(num[t][q]);
        } else if (X.slice == 0 && li == 0) {
#pragma unroll
            for (int t = 0; t < 4; ++t)
#pragma unroll
                for (int q = 0; q < 4; ++q) X.DEN[((size_t)d * ML + row0 + 16 * t + 4 * g + q) * 4 + h] = num[t][q];
        }
    }
    __builtin_amdgcn_sched_barrier(0);
    { const float dec = ep[64]; bf16x8 kf[8][2];
#pragma unroll
      for (int tk = 0; tk < 8; ++tk)
#pragma unroll
          for (int s2 = 0; s2 < 2; ++s2) { const LAS unsigned char* kp = st + MK_OFF + (32 * s2 + 8 * g + q4) * 272 + (16 * tk + 4 * p4) * 2; kf[tk][s2] = cat8(tr16(kp), tr16(kp + 4 * 272)); }
      __builtin_amdgcn_sched_barrier(0);
#pragma unroll
      for (int tk = 0; tk < 8; ++tk) CT[tk] = CT[tk] * dec;
#pragma unroll
      for (int s2 = 0; s2 < 2; ++s2)
#pragma unroll
          for (int tk = 0; tk < 8; ++tk) CT[tk] = MFMA16(kf[tk][s2], Vw[s2], CT[tk]);
    }
#pragma unroll
    for (int ks = 0; ks < 4; ++ks) Cb[ks] = packacc(CT[2 * ks], CT[2 * ks + 1]);
}
template <int WV> __device__ __forceinline__ void ml_flush(const MlCtx& X, int idx, const LAS unsigned char* st, int lane) {
    if (idx < 0 || idx >= NCH) return;
    const int c = chunk_of(idx, X.d); if (c < 4) return;
    const int row0 = chunk_row0(X.b, c);
#pragma unroll
    for (int i = 0; i < 16; ++i) { const int pb = 64 * (WV + 3 * i);
        if (pb >= 2048 && pb < 2560) { const int r = ((pb - 2048) >> 3) + (lane >> 3);
            const v4u o = *(const LAS v4u*)(st + MV_OFF + r * 144 + (lane & 7) * 16);
            *(v4u*)(X.MOR + ((size_t)X.d * ML + row0 + r) * 1024 + X.h * 256 + X.v0 + 8 * (lane & 7)) = o; } }
}
template <int MODE, int WV> __device__ __forceinline__ void ml_loader_loop(const MlCtx& X, LAS unsigned char* st0, LAS unsigned char* st1, int lane) {
    __builtin_amdgcn_s_setprio(3);
    v4u bufA[16], bufB[16]; f32x4 evA = {0.f, 0.f, 0.f, 0.f}, evB = evA;
    if (MODE & 1) { ml_issue<WV>(X, 0, lane, bufA, evA); ml_issue<WV>(X, 1, lane, bufB, evB); }
    for (int idx = -1; idx < NCH; idx += 2) {
        if (!(MODE & 1)) { LDS_BARRIER(); LDS_BARRIER(); continue; }
        if (MODE & 4) ml_flush<WV>(X, idx - 1, st0, lane);
        if (idx + 1 < NCH) ml_store<WV>(st0, lane, bufA, evA); if (idx + 3 < NCH) ml_issue<WV>(X, idx + 3, lane, bufA, evA);
        LDS_BARRIER();
        if (MODE & 4) ml_flush<WV>(X, idx, st1, lane);
        if (idx + 2 < NCH) ml_store<WV>(st1, lane, bufB, evB); if (idx + 4 < NCH) ml_issue<WV>(X, idx + 4, lane, bufB, evB);
        LDS_BARRIER();
    }
}
template <int MODE> __device__ __forceinline__ void mlstm_chunk_job(int job, const bf16* Z, const bf16* MS, const float* MSC, bf16* MOR, float* DEN, LAS unsigned char* lds, int tid, int lane, int wave) {
    const int seq = job & 15, slice = job >> 4;
    MlCtx X; X.Z = Z; X.MS = MS; X.MSC = MSC; X.MOR = MOR; X.DEN = DEN; X.b = seq >> 3; X.h = (seq >> 1) & 3; X.d = seq & 1; X.bh = X.b * 4 + X.h; X.v0 = slice * 64; X.slice = slice;
    LAS unsigned char* st0 = lds; LAS unsigned char* st1 = lds + MSTAGE;
    __syncthreads();
    if (wave >= 5) {
        if (wave == 5) ml_loader_loop<MODE, 0>(X, st0, st1, lane); else if (wave == 6) ml_loader_loop<MODE, 1>(X, st0, st1, lane); else ml_loader_loop<MODE, 2>(X, st0, st1, lane);
    } else {
        f32x4 CT[8]; bf16x8 Cb[4];
#pragma unroll
        for (int t = 0; t < 8; ++t) CT[t] = (f32x4){0.f, 0.f, 0.f, 0.f};
#pragma unroll
        for (int t = 0; t < 4; ++t) Cb[t] = (bf16x8){0, 0, 0, 0, 0, 0, 0, 0};
        LDS_BARRIER();
#pragma unroll 1
        for (int idx = 0; idx < NCH; ++idx) {
            if (MODE & 2) ml_compute<MODE>(X, idx, (idx & 1) ? st1 : st0, lane, wave, CT, Cb);
            LDS_BARRIER();
        }
        LDS_BARRIER();
    }
}
typedef float f32x16 __attribute__((ext_vector_type(16)));
constexpr int GP_Q = 0, GP_K = 17408, GP_V = 34816, GP_A = 52224, GP_M = 87040, GP_X = 95488, GP_S = 132352, AP = 68, AMD = 64 * AP;
__device__ __forceinline__ void gdn_prep_task(int gt, const bf16* Z2, const float* GF, const float* w_conv, const float* a_log, const float* dt_bias, bf16* GQ, bf16* GK, bf16* GW, bf16* GU, bf16* GA, float* GSC,
                                              LAS unsigned char* lds, int tid, int lane, int wave) {
    const int bh = gt / NCH, c = gt - bh * NCH, b = bh >> 3, h = bh & 7, row0 = chunk_row0(b, c);
    const int g = lane >> 4, li = lane & 15, q4 = li >> 2, p4 = li & 3;
    LAS float* Amat = (LAS float*)(lds + GP_A); LAS float* Mtmp = (LAS float*)(lds + GP_M);
    LAS float* gc = (LAS float*)(lds + GP_S); LAS float* be = gc + 128;
    __syncthreads();
    { const int rowbase = c < 4 ? ML + b * CTXL : row0, t0 = c < 4 ? c * 64 : 0, thi = c < 4 ? CTXL : 64;
      float w0[3][5], w1[3][5]; unsigned zr[3][12];
#pragma unroll
      for (int ty = 0; ty < 3; ++ty) { const int ch = ty * 1024 + h * 128 + 2 * lane;
#pragma unroll
          for (int j = 0; j < 5; ++j) { w0[ty][j] = w_conv[j * 3072 + ch]; w1[ty][j] = w_conv[j * 3072 + ch + 1]; }
#pragma unroll
          for (int i = 0; i < 12; ++i) { const int t = t0 + 8 * wave + i - 2; zr[ty][i] = (t >= 0 && t < thi) ? *(const unsigned*)(Z2 + (size_t)(rowbase + t) * Z2LD + ch) : 0u; } }
#pragma unroll
      for (int ty = 0; ty < 3; ++ty) {
#pragma unroll
          for (int i = 0; i < 8; ++i) { float o0 = 0.f, o1 = 0.f;
#pragma unroll
              for (int j = 0; j < 5; ++j) { o0 += w0[ty][j] * bf_lo(zr[ty][i + j]); o1 += w1[ty][j] * bf_hi(zr[ty][i + j]); }
              o0 = silu_fast(o0); o1 = silu_fast(o1);
              if (ty < 2) { const float ss = wave_sum(o0 * o0 + o1 * o1); const float sc = (ty == 0 ? 0.08838834764831845f : 1.f) * __builtin_amdgcn_rsqf(ss + EPSF); o0 *= sc; o1 *= sc; }
              const unsigned pk = pk2(o0, o1); const int r = 8 * wave + i;
              *(LAS unsigned*)(lds + ty * 17408 + r * 272 + lane * 4) = pk;
              if (ty == 0) *(unsigned*)(GQ + (size_t)(row0 + r) * 1024 + h * 128 + 32 * (lane >> 4) + 8 * ((lane & 7) >> 1) + 4 * ((lane >> 3) & 1) + 2 * (lane & 1)) = pk;
              else if (ty == 1) *(unsigned*)(GK + (size_t)(row0 + r) * 1024 + h * 128 + 2 * lane) = pk; } } }
    if (tid < 128) { const int d = tid >> 6, r = d ? 63 - lane : lane;
        const float gv = -expf(a_log[d * 8 + h]) * softplusf_(GF[(size_t)(row0 + r) * GFLD + 16 + d * 8 + h] + dt_bias[d * 8 + h]), bv = sigmoidf_(GF[(size_t)(row0 + r) * GFLD + 32 + d * 8 + h]);
        const float gcs = wave_incl_scan(gv, lane), gl = __shfl(gcs, 63);
        gc[d * 64 + r] = gcs; be[d * 64 + r] = bv;
        float* sc = GSC + ((size_t)gt * 2 + d) * 192; sc[r] = __expf(gcs); sc[64 + r] = __expf(gl - gcs); if (lane == 0) sc[128] = __expf(gl); }
    LDS_BARRIER();
    { const int tn = wave & 3, i = 16 * tn + li;
      bf16x8 kB[4], qB[4]; u32x2 wa[2][2];
#pragma unroll
      for (int ks = 0; ks < 4; ++ks) { kB[ks] = *(const LAS bf16x8*)(lds + GP_K + i * 272 + (32 * ks + 8 * g) * 2); qB[ks] = *(const LAS bf16x8*)(lds + GP_Q + i * 272 + (32 * ks + 8 * g) * 2); }
#pragma unroll
      for (int tt = 0; tt < 2; ++tt) { const int tm = 2 * (wave >> 2) + tt;
          f32x4 aKK = {0.f, 0.f, 0.f, 0.f}, aQK = aKK;
#pragma unroll
          for (int ks = 0; ks < 4; ++ks) { const bf16x8 kA = *(const LAS bf16x8*)(lds + GP_K + (16 * tm + li) * 272 + (32 * ks + 8 * g) * 2);
              aKK = MFMA16(kA, kB[ks], aKK); aQK = MFMA16(kA, qB[ks], aQK); }
          const int j0 = 16 * tm + 4 * g;
#pragma unroll
          for (int d = 0; d < 2; ++d) { const float gci = gc[d * 64 + i], bi = be[d * 64 + i]; const int pi = d ? 63 - i : i; float at[4];
#pragma unroll
              for (int q = 0; q < 4; ++q) { const int j = j0 + q, pj = d ? 63 - j : j; const bool strict = pj < pi, incl = pj <= pi;
                  const float e = incl ? __expf(gci - gc[d * 64 + j]) : 0.f;
                  Amat[d * AMD + pi * AP + pj] = strict ? bi * aKK[q] * e : 0.f;
                  at[q] = aQK[q] * e; }
              wa[d][tt].x = pg8::cvt_pk_bf16(at[0], at[1]); wa[d][tt].y = pg8::cvt_pk_bf16(at[2], at[3]); }
      }
#pragma unroll
      for (int d = 0; d < 2; ++d) { v4u w; w.x = wa[d][0].x; w.y = wa[d][0].y; w.z = wa[d][1].x; w.w = wa[d][1].y;
          *(v4u*)(GA + (((size_t)gt * 2 + d) * 64 + i) * 64 + 32 * (wave >> 2) + 8 * g) = w; } }
    LDS_BARRIER();
    if (wave < 4) { const int d = wave >> 1, blk = wave & 1, cc = lane & 31; LAS float* Ab = Amat + d * AMD + (32 * blk) * AP + 32 * blk;
        float X[32];
#pragma unroll
        for (int p = 0; p < 32; ++p) { f32x4 a4[8];
#pragma unroll
            for (int q = 0; q < (p + 3) / 4; ++q) a4[q] = *(const LAS f32x4*)(Ab + p * AP + 4 * q);
            float s0 = (p == cc) ? 1.f : 0.f, s1 = 0.f;
#pragma unroll
            for (int pp = 0; pp < p; ++pp) { if (pp & 1) s1 -= a4[pp >> 2][pp & 3] * X[pp]; else s0 -= a4[pp >> 2][pp & 3] * X[pp]; }
            X[p] = s0 + s1; }
        if (lane < 32) {
#pragma unroll
            for (int p = 0; p < 32; ++p) Ab[p * AP + cc] = X[p]; }
    }
    LDS_BARRIER();
    if (wave < 2) { const int d = wave, r32 = lane & 31, kk = lane >> 5; LAS float* Ad = Amat + d * AMD; LAS float* Md = Mtmp + d * 1056;
        f32x16 acc;
#pragma unroll
        for (int q = 0; q < 16; ++q) acc[q] = 0.f;
#pragma unroll
        for (int ks = 0; ks < 16; ++ks) acc = __builtin_amdgcn_mfma_f32_32x32x2f32(Ad[(32 + r32) * AP + 2 * ks + kk], Ad[(2 * ks + kk) * AP + r32], acc, 0, 0, 0);
#pragma unroll
        for (int q = 0; q < 16; ++q) Md[((q & 3) + 8 * (q >> 2) + 4 * kk) * 33 + r32] = acc[q];
#pragma unroll
        for (int q = 0; q < 16; ++q) acc[q] = 0.f;
#pragma unroll
        for (int ks = 0; ks < 16; ++ks) acc = __builtin_amdgcn_mfma_f32_32x32x2f32(Ad[(32 + r32) * AP + 32 + 2 * ks + kk], Md[(2 * ks + kk) * 33 + r32], acc, 0, 0, 0);
#pragma unroll
        for (int q = 0; q < 16; ++q) Ad[(32 + (q & 3) + 8 * (q >> 2) + 4 * kk) * AP + r32] = -acc[q];
    }
    LDS_BARRIER();
    { const int d = tid >> 8, i = (tid >> 2) & 63, jq = tid & 3, pi = d ? 63 - i : i; float xu[16], xw[16];
#pragma unroll
      for (int q = 0; q < 16; ++q) { const int j = 16 * jq + q, pj = d ? 63 - j : j; const float xv = Amat[d * AMD + pi * AP + pj] * be[d * 64 + j]; xu[q] = xv; xw[q] = xv * __expf(gc[d * 64 + j]); }
      LAS unsigned char* xo = lds + GP_X + (d * 2) * 9216 + i * 144 + jq * 32;
      v4u o; o.x = pk2(xu[0], xu[1]); o.y = pk2(xu[2], xu[3]); o.z = pk2(xu[4], xu[5]); o.w = pk2(xu[6], xu[7]); *(LAS v4u*)xo = o;
      o.x = pk2(xu[8], xu[9]); o.y = pk2(xu[10], xu[11]); o.z = pk2(xu[12], xu[13]); o.w = pk2(xu[14], xu[15]); *(LAS v4u*)(xo + 16) = o;
      o.x = pk2(xw[0], xw[1]); o.y = pk2(xw[2], xw[3]); o.z = pk2(xw[4], xw[5]); o.w = pk2(xw[6], xw[7]); *(LAS v4u*)(xo + 9216) = o;
      o.x = pk2(xw[8], xw[9]); o.y = pk2(xw[10], xw[11]); o.z = pk2(xw[12], xw[13]); o.w = pk2(xw[14], xw[15]); *(LAS v4u*)(xo + 9216 + 16) = o; }
    LDS_BARRIER();
    { const int d = wave >> 2, ti = wave & 3;
      const LAS unsigned char* xr = lds + GP_X + (d * 2) * 9216 + (16 * ti + li) * 144 + (8 * g) * 2;
      const bf16x8 xa0 = *(const LAS bf16x8*)xr, xa1 = *(const LAS bf16x8*)(xr + 64), xw0 = *(const LAS bf16x8*)(xr + 9216), xw1 = *(const LAS bf16x8*)(xr + 9216 + 64);
#pragma unroll 1
      for (int ts = 0; ts < 4; ++ts) { u32x2 ww[2];
#pragma unroll
        for (int hi = 0; hi < 2; ++hi) { const int tv = 2 * ts + hi;
          const LAS unsigned char* vp = lds + GP_V + (8 * g + q4) * 272 + (16 * tv + 4 * p4) * 2;
          f32x4 acc = {0.f, 0.f, 0.f, 0.f};
          acc = MFMA16(xa0, cat8(tr16(vp), tr16(vp + 4 * 272)), acc);
          acc = MFMA16(xa1, cat8(tr16(vp + 32 * 272), tr16(vp + 36 * 272)), acc);
          u32x2 w; w.x = pg8::cvt_pk_bf16(acc[0], acc[1]); w.y = pg8::cvt_pk_bf16(acc[2], acc[3]);
          *(u32x2*)(GU + (((size_t)gt * 2 + d) * 128 + 16 * tv + li) * 64 + 16 * ti + 4 * g) = w;
          const LAS unsigned char* kp = lds + GP_K + (8 * g + q4) * 272 + (16 * tv + 4 * p4) * 2;
          f32x4 acw = {0.f, 0.f, 0.f, 0.f};
          acw = MFMA16(cat8(tr16(kp), tr16(kp + 4 * 272)), xw0, acw);
          acw = MFMA16(cat8(tr16(kp + 32 * 272), tr16(kp + 36 * 272)), xw1, acw);
          ww[hi].x = pg8::cvt_pk_bf16(-acw[0], -acw[1]); ww[hi].y = pg8::cvt_pk_bf16(-acw[2], -acw[3]); }
        v4u w4; w4.x = ww[0].x; w4.y = ww[0].y; w4.z = ww[1].x; w4.w = ww[1].y;
        *(v4u*)(GW + (((size_t)gt * 2 + d) * 64 + 16 * ti + li) * 128 + 32 * ts + 8 * g) = w4;
      } }
}
constexpr int KP = 288, APITCH = 160, GS_W = 0, GS_Q = 18432, GS_K = 36864, GS_A = 55296, GS_U = 65536, GS_E = 74752, GSTAGE = 75280;
struct GdCtx { const bf16* GQ; const bf16* GK; const bf16* GW; const bf16* GU; const bf16* GA; const float* GSC; bf16* GO; int b, h, d, bh, c0; };
template <int wv> __device__ __forceinline__ void gd_issue(const GdCtx& X, int idx, int lane, v4u (&buf)[16], float& ev) {
    const int cn = chunk_of(idx, X.d), gt = X.bh * NCH + cn, row0 = chunk_row0(X.b, cn);
    const size_t td = (size_t)gt * 2 + X.d;
    const unsigned o16 = (unsigned)(lane >> 4) * 2048 + (unsigned)(lane & 15) * 16, ol = (unsigned)lane * 16;
    const char* bW = (const char*)(X.GW + td * 8192); const char* bQ = (const char*)(X.GQ + (size_t)row0 * 1024 + X.h * 128); const char* bK = (const char*)(X.GK + (size_t)row0 * 1024 + X.h * 128);
    const char* bA = (const char*)(X.GA + td * 4096); const char* bU = (const char*)(X.GU + (td * 128 + X.c0) * 64);
#pragma unroll
    for (int i = 0; i < 16; ++i) { const int pb = 64 * (wv < 3 ? (i < 14 ? wv + 4 * i : 3 + 8 * wv + 4 * (i - 14)) : (i < 8 ? 27 + 4 * i : 48 + i));
        const bool rowk = pb >= 1024 && pb < 3072;
        const char* base = pb < 1024 ? bW + (size_t)pb * 16 : (pb < 2048 ? bQ + (size_t)((pb - 1024) >> 4) * 2048 : (pb < 3072 ? bK + (size_t)((pb - 2048) >> 4) * 2048 : (pb < 3584 ? bA + (size_t)(pb - 3072) * 16 : bU + (size_t)(pb - 3584) * 16)));
        buf[i] = *(const v4u*)(base + (rowk ? o16 : ol)); }
    ev = X.GSC[td * 192 + (wv < 2 ? 64 * wv + lane : 128)];
}
template <int wv> __device__ __forceinline__ void gd_store(LAS unsigned char* st, int lane, const v4u (&buf)[16], float ev) {
    const unsigned l16 = (unsigned)(lane >> 4) * KP + (unsigned)(lane & 15) * 16, l8a = (unsigned)(lane >> 3) * APITCH + (unsigned)(lane & 7) * 16, l8 = (unsigned)(lane >> 3) * 144 + (unsigned)(lane & 7) * 16;
#pragma unroll
    for (int i = 0; i < 16; ++i) { const int pb = 64 * (wv < 3 ? (i < 14 ? wv + 4 * i : 3 + 8 * wv + 4 * (i - 14)) : (i < 8 ? 27 + 4 * i : 48 + i));
        const unsigned uo = pb < 3072 ? (unsigned)((pb >> 10) * 18432 + ((pb & 1023) >> 4) * KP) : (pb < 3584 ? (unsigned)(GS_A + ((pb - 3072) >> 3) * APITCH) : (unsigned)(GS_U + ((pb - 3584) >> 3) * 144));
        *(LAS v4u*)(st + uo + (pb < 3072 ? l16 : (pb < 3584 ? l8a : l8))) = buf[i]; }
    if (wv < 2) ((LAS float*)(st + GS_E))[64 * wv + lane] = ev; else if (wv == 2 && lane == 0) ((LAS float*)(st + GS_E))[128] = ev;
}
#define SCHED_FENCE() __builtin_amdgcn_sched_barrier(0)
#define LD16(p) (*(const LAS bf16x8*)(p))
template <int G> __device__ __forceinline__ void gd_ld(const LAS unsigned char* st, int g, int li, int q4, int p4, bf16x8 (&F)[4]) {
    if constexpr (G < 8) { constexpr int t = G >> 1, hf = G & 1;
        const LAS unsigned char* wp = st + GS_W + (16 * t + li) * KP + 16 * g + 128 * hf; const LAS unsigned char* qp = wp + (GS_Q - GS_W);
        F[0] = LD16(wp); F[1] = LD16(qp); F[2] = LD16(wp + 64); F[3] = LD16(qp + 64);
    } else if constexpr (G < 10) { constexpr int t0 = 2 * (G - 8);
        const LAS unsigned char* ap = st + GS_A + (16 * t0 + li) * APITCH + 16 * g;
        F[0] = LD16(ap); F[1] = LD16(ap + 16 * APITCH); F[2] = LD16(ap + 64); F[3] = LD16(ap + 16 * APITCH + 64);
    } else { constexpr int tk0 = 2 * (G - 10);
        const LAS unsigned char* kp = st + GS_K + (4 * g + q4) * KP + (16 * tk0 + 4 * p4) * 2;
        F[0] = cat8(tr16(kp), tr16(kp + 16 * KP)); F[1] = cat8(tr16(kp + 32), tr16(kp + 32 + 16 * KP)); F[2] = cat8(tr16(kp + 32 * KP), tr16(kp + 48 * KP)); F[3] = cat8(tr16(kp + 32 + 32 * KP), tr16(kp + 32 + 48 * KP));
    }
}
template <int MODE> __device__ __forceinline__ void gd_compute(const GdCtx& X, int idx, const LAS unsigned char* st, int lane, int wave, f32x4 (&S)[8], bf16x8 (&Sb)[4]) {
    const int g = lane >> 4, li = lane & 15, q4 = li >> 2, p4 = li & 3;
    const int c = chunk_of(idx, X.d);
    const LAS float* eg = (const LAS float*)(st + GS_E);
    bf16x8 F0[4], F1[4], F2[4];
    f32x4 vn[4], o1[4], o2[4], ed4[4], e4[4]; u32x2 uu[4]; bf16x8 vb0, vb1, vs0, vs1; float dec;
#define GD_WQ(G, F) { constexpr int t_ = (G) >> 1, hf_ = (G) & 1; \
        if (hf_ == 0) { vn[t_] = (f32x4){bf_lo(uu[t_].x), bf_hi(uu[t_].x), bf_lo(uu[t_].y), bf_hi(uu[t_].y)}; o1[t_] = (f32x4){0.f, 0.f, 0.f, 0.f}; } \
        vn[t_] = MFMA16(F[0], Sb[2 * hf_], vn[t_]); o1[t_] = MFMA16(F[1], Sb[2 * hf_], o1[t_]); vn[t_] = MFMA16(F[2], Sb[2 * hf_ + 1], vn[t_]); o1[t_] = MFMA16(F[3], Sb[2 * hf_ + 1], o1[t_]); }
#define GD_AT(G, F) { constexpr int t_ = 2 * ((G) - 8); o2[t_] = (f32x4){0.f, 0.f, 0.f, 0.f}; o2[t_ + 1] = o2[t_]; \
        o2[t_] = MFMA16(F[0], vb0, o2[t_]); o2[t_ + 1] = MFMA16(F[1], vb0, o2[t_ + 1]); o2[t_] = MFMA16(F[2], vb1, o2[t_]); o2[t_ + 1] = MFMA16(F[3], vb1, o2[t_ + 1]); }
#define GD_KT(G, F) { constexpr int k_ = 2 * ((G) - 10); S[k_] = S[k_] * dec; S[k_ + 1] = S[k_ + 1] * dec; \
        S[k_] = MFMA16(F[0], vs0, S[k_]); S[k_ + 1] = MFMA16(F[1], vs0, S[k_ + 1]); S[k_] = MFMA16(F[2], vs1, S[k_]); S[k_ + 1] = MFMA16(F[3], vs1, S[k_ + 1]); }
#pragma unroll
    for (int t = 0; t < 4; ++t) uu[t] = *(const LAS u32x2*)(st + GS_U + (16 * wave + li) * 144 + (16 * t + 4 * g) * 2);
    gd_ld<0>(st, g, li, q4, p4, F0); gd_ld<1>(st, g, li, q4, p4, F1);
    SCHED_FENCE();
    gd_ld<2>(st, g, li, q4, p4, F2); SCHED_FENCE(); GD_WQ(0, F0); SCHED_FENCE();
    gd_ld<3>(st, g, li, q4, p4, F0); SCHED_FENCE(); GD_WQ(1, F1); SCHED_FENCE();
    gd_ld<4>(st, g, li, q4, p4, F1); SCHED_FENCE(); GD_WQ(2, F2); SCHED_FENCE();
    gd_ld<5>(st, g, li, q4, p4, F2); SCHED_FENCE(); GD_WQ(3, F0); SCHED_FENCE();
    gd_ld<6>(st, g, li, q4, p4, F0); SCHED_FENCE(); GD_WQ(4, F1); SCHED_FENCE();
    gd_ld<7>(st, g, li, q4, p4, F1); SCHED_FENCE(); GD_WQ(5, F2); SCHED_FENCE();
    gd_ld<8>(st, g, li, q4, p4, F2);
#pragma unroll
    for (int t = 0; t < 4; ++t) ed4[t] = *(const LAS f32x4*)(eg + 64 + 16 * t + 4 * g);
    dec = eg[128];
    SCHED_FENCE(); GD_WQ(6, F0); SCHED_FENCE();
    gd_ld<9>(st, g, li, q4, p4, F0); SCHED_FENCE(); GD_WQ(7, F1); SCHED_FENCE();
    vb0 = packacc(vn[0], vn[1]); vb1 = packacc(vn[2], vn[3]);
    gd_ld<10>(st, g, li, q4, p4, F1);
#pragma unroll
    for (int t = 0; t < 4; ++t) e4[t] = *(const LAS f32x4*)(eg + 16 * t + 4 * g);
    SCHED_FENCE(); GD_AT(8, F2);
#pragma unroll
    for (int t = 0; t < 4; ++t) vn[t] = vn[t] * ed4[t];
    vs0 = packacc(vn[0], vn[1]); vs1 = packacc(vn[2], vn[3]);
    SCHED_FENCE();
    gd_ld<11>(st, g, li, q4, p4, F2); SCHED_FENCE(); GD_AT(9, F0); SCHED_FENCE();
    gd_ld<12>(st, g, li, q4, p4, F0); SCHED_FENCE(); GD_KT(10, F1);
    if (!(MODE & 4)) { asm volatile("" :: "v"(o1[0]), "v"(o1[1]), "v"(o1[2]), "v"(o1[3]), "v"(o2[0]), "v"(o2[1]), "v"(o2[2]), "v"(o2[3]), "v"(e4[0]), "v"(e4[1]), "v"(e4[2]), "v"(e4[3])); } else if (c >= 4) {
#pragma unroll
        for (int t = 0; t < 4; ++t) { const f32x4 o = o1[t] * e4[t] + o2[t];
            u32x2 w; w.x = pg8::cvt_pk_bf16(o[0], o[1]); w.y = pg8::cvt_pk_bf16(o[2], o[3]);
            *(LAS u32x2*)((LAS unsigned char*)st + GS_U + (16 * wave + li) * 144 + (16 * t + 4 * g) * 2) = w; } }
    SCHED_FENCE();
    gd_ld<13>(st, g, li, q4, p4, F1); SCHED_FENCE(); GD_KT(11, F2); SCHED_FENCE();
    GD_KT(12, F0); SCHED_FENCE();
    GD_KT(13, F1);
#pragma unroll
    for (int ks = 0; ks < 4; ++ks) Sb[ks] = packacc(S[2 * ks], S[2 * ks + 1]);
#undef GD_WQ
#undef GD_AT
#undef GD_KT
}
template <int WV> __device__ __forceinline__ void gd_flush(const GdCtx& X, int idx, const LAS unsigned char* st, int lane) {
    if (WV != 3) return;
    if (idx < 0 || idx >= NCH) return;
    const int c = chunk_of(idx, X.d); if (c < 4) return;
    const int row0 = chunk_row0(X.b, c), g = lane >> 4, li = lane & 15, q4 = li >> 2, p4 = li & 3, gi = g >> 1, gp = g & 1;
    const LAS unsigned char* tp0 = st + GS_U + (8 * (4 * gp + p4) + q4) * 144 + (4 * gi) * 2;
    bf16* dst0 = X.GO + ((size_t)X.d * ML + row0 + 4 * gi + (li & 3)) * 1024 + X.h * 128 + X.c0 + 8 * (4 * gp + (li >> 2));
#pragma unroll 1
    for (int ib = 0; ib < 8; ++ib) {
        const bf16x8 o = cat8(tr16(tp0 + 16 * ib), tr16(tp0 + 16 * ib + 4 * 144));
        *(bf16x8*)(dst0 + (size_t)(8 * ib) * 1024) = o; }
}
template <int MODE, int WV> __device__ __forceinline__ void gd_loader_loop(const GdCtx& X, LAS unsigned char* st0, LAS unsigned char* st1, int lane) {
    __builtin_amdgcn_s_setprio(3);
    v4u bufA[16], bufB[16]; float evA = 0.f, evB = 0.f;
    if (MODE & 1) { gd_issue<WV>(X, 0, lane, bufA, evA); gd_issue<WV>(X, 1, lane, bufB, evB); }
    for (int idx = -1; idx < NCH; idx += 2) {
        if (!(MODE & 1)) { LDS_BARRIER(); LDS_BARRIER(); continue; }
        if (MODE & 4) gd_flush<WV>(X, idx - 1, st0, lane);
        if (idx + 1 < NCH) gd_store<WV>(st0, lane, bufA, evA); if (idx + 3 < NCH) gd_issue<WV>(X, idx + 3, lane, bufA, evA);
        LDS_BARRIER();
        if (MODE & 4) gd_flush<WV>(X, idx, st1, lane);
        if (idx + 2 < NCH) gd_store<WV>(st1, lane, bufB, evB); if (idx + 4 < NCH) gd_issue<WV>(X, idx + 4, lane, bufB, evB);
        LDS_BARRIER();
    }
}
template <int MODE> __device__ __forceinline__ void gdn_chunk_job(int job, const bf16* GQ, const bf16* GK, const bf16* GW, const bf16* GU, const bf16* GA, const float* GSC, bf16* GO,
                                              LAS unsigned char* lds, int tid, int lane, int wave) {
    const int seq = job & 31;
    GdCtx X; X.GQ = GQ; X.GK = GK; X.GW = GW; X.GU = GU; X.GA = GA; X.GSC = GSC; X.GO = GO; X.b = seq >> 4; X.h = (seq >> 1) & 7; X.d = seq & 1; X.bh = X.b * 8 + X.h; X.c0 = (job >> 5) * 64;
    LAS unsigned char* st0 = lds; LAS unsigned char* st1 = lds + GSTAGE;
    LDS_BARRIER();
    if (wave >= 4) {
        if (wave == 4) gd_loader_loop<MODE, 0>(X, st0, st1, lane); else if (wave == 5) gd_loader_loop<MODE, 1>(X, st0, st1, lane); else if (wave == 6) gd_loader_loop<MODE, 2>(X, st0, st1, lane); else gd_loader_loop<MODE, 3>(X, st0, st1, lane);
    } else {
        f32x4 S[8]; bf16x8 Sb[4];
#pragma unroll
        for (int t = 0; t < 8; ++t) S[t] = (f32x4){0.f, 0.f, 0.f, 0.f};
#pragma unroll
        for (int t = 0; t < 4; ++t) Sb[t] = (bf16x8){0, 0, 0, 0, 0, 0, 0, 0};
        LDS_BARRIER();
#pragma unroll 1
        for (int idx = 0; idx < NCH; ++idx) {
            if (MODE & 2) gd_compute<MODE>(X, idx, (idx & 1) ? st1 : st0, lane, wave, S, Sb);
            LDS_BARRIER();
        }
        LDS_BARRIER();
    }
}
__device__ __forceinline__ void ph_cprep(const bf16* Z1, const bf16* Z2, const float* GF, const float* w_conv, const float* b_gate, const float* a_log, const float* dt_bias, bf16* MS, float* MSC,
                                         bf16* GQ, bf16* GK, bf16* GW, bf16* GU, bf16* GA, float* GSC, LAS unsigned char* lds, int tid, int lane, int wave) {
    for (int gt = blockIdx.x; gt < 16 * NCH; gt += gridDim.x) gdn_prep_task(gt, Z2, GF, w_conv, a_log, dt_bias, GQ, GK, GW, GU, GA, GSC, lds, tid, lane, wave);
    for (int mt = blockIdx.x; mt < 8 * NCH; mt += gridDim.x) mlstm_prep_task(mt, Z1, GF, b_gate, MS, MSC, (LAS float*)lds, tid, lane, wave);
}
__device__ __forceinline__ float red16(float v) { v += __shfl_xor(v, 1); v += __shfl_xor(v, 2); v += __shfl_xor(v, 4); v += __shfl_xor(v, 8); return v; }
__device__ __forceinline__ void ph_scan(const bf16* Z1, const bf16* MS, const float* MSC, const bf16* GQ, const bf16* GK, const bf16* GW, const bf16* GU, const bf16* GA, const float* GSC,
                                        bf16* MO, float* DEN, bf16* GO, const float* w1, const float* w3, const float* w2, unsigned char* ws, LAS unsigned char* lds, int tid, int lane, int wave) {
    for (int job = blockIdx.x; job < 256; job += gridDim.x) {
        if (job < 64) {
            if (SCAN_PROBE_MODE && (SCAN_PROBE_WHICH & 1)) { mlstm_chunk_job<SCAN_PROBE_MODE>(job, Z1, MS, MSC, MO, DEN, lds, tid, lane, wave); __syncthreads(); }
            mlstm_chunk_job<7>(job, Z1, MS, MSC, MO, DEN, lds, tid, lane, wave);
        } else if (job < 128) {
            if (SCAN_PROBE_MODE && (SCAN_PROBE_WHICH & 2)) { gdn_chunk_job<SCAN_PROBE_MODE>(job - 64, GQ, GK, GW, GU, GA, GSC, GO, lds, tid, lane, wave); __syncthreads(); }
            gdn_chunk_job<7>(job - 64, GQ, GK, GW, GU, GA, GSC, GO, lds, tid, lane, wave);
        } else if (job < 128 + TR_BLOCKS) {
            ph_transposes_experts(w1, w3, w2, ws, lds, (job - 128) * NWAVES + wave, TR_BLOCKS * NWAVES, wave, lane);

        }
        __syncthreads();
    }
}

__device__ __forceinline__ void unpack16(const bf16* p, float (&v)[16]) {
    const v4u a = *(const v4u*)p, b = *(const v4u*)(p + 8);
    v[0] = bf_lo(a.x); v[1] = bf_hi(a.x); v[2] = bf_lo(a.y); v[3] = bf_hi(a.y); v[4] = bf_lo(a.z); v[5] = bf_hi(a.z); v[6] = bf_lo(a.w); v[7] = bf_hi(a.w);
    v[8] = bf_lo(b.x); v[9] = bf_hi(b.x); v[10] = bf_lo(b.y); v[11] = bf_hi(b.y); v[12] = bf_lo(b.z); v[13] = bf_hi(b.z); v[14] = bf_lo(b.w); v[15] = bf_hi(b.w);
}
__device__ __forceinline__ void pack16(bf16* p, const float (&v)[16]) {
    v4u a, b; a.x = pk2(v[0], v[1]); a.y = pk2(v[2], v[3]); a.z = pk2(v[4], v[5]); a.w = pk2(v[6], v[7]); b.x = pk2(v[8], v[9]); b.y = pk2(v[10], v[11]); b.z = pk2(v[12], v[13]); b.w = pk2(v[14], v[15]);
    *(v4u*)p = a; *(v4u*)(p + 8) = b;
}
__device__ __forceinline__ void unpack8(const bf16* p, float (&v)[8]) {
    const v4u a = *(const v4u*)p;
    v[0] = bf_lo(a.x); v[1] = bf_hi(a.x); v[2] = bf_lo(a.y); v[3] = bf_hi(a.y); v[4] = bf_lo(a.z); v[5] = bf_hi(a.z); v[6] = bf_lo(a.w); v[7] = bf_hi(a.w);
}
__device__ __forceinline__ void pack8s(bf16* p, const float (&v)[8]) { v4u a; a.x = pk2(v[0], v[1]); a.y = pk2(v[2], v[3]); a.z = pk2(v[4], v[5]); a.w = pk2(v[6], v[7]); *(v4u*)p = a; }
__device__ __forceinline__ void ph_combine(const bf16* Z, const bf16* MO, const float* DEN, const bf16* GO, const float* g_head_m, const float* g_head_d, bf16* Y, int gw, int NGW, int lane) {
    for (int row = gw; row < ML; row += NGW) {
#pragma unroll
        for (int hf = 0; hf < 2; ++hf) { const int c0 = 512 * hf + 8 * lane;
            { float a[8], b2[8], g[8], o[8];
              unpack8(MO + (size_t)row * 1024 + c0, a); unpack8(MO + ((size_t)ML + row) * 1024 + c0, b2); unpack8(Z + (size_t)row * Z1LD + ZC_MO + c0, g);
              const int hd = 2 * hf + (lane >> 5);
              const float i0 = 1.f / fmaxf(fabsf(DEN[(size_t)row * 4 + hd]), 1.f), i1 = 1.f / fmaxf(fabsf(DEN[((size_t)ML + row) * 4 + hd]), 1.f);
              float ss = 0.f;
#pragma unroll
              for (int j = 0; j < 8; ++j) { a[j] = a[j] * i0 + b2[j] * i1; ss += a[j] * a[j]; }
              ss = red16(ss); ss += __shfl_xor(ss, 16);
              const float r = 1.f / sqrtf(ss * (1.f / 256.f) + EPSF);
              const f32x4 w0 = *(const f32x4*)(g_head_m + c0), w1 = *(const f32x4*)(g_head_m + c0 + 4);
#pragma unroll
              for (int j = 0; j < 8; ++j) o[j] = a[j] * r * (j < 4 ? w0[j & 3] : w1[j & 3]) * sigmoidf_(g[j]);
              pack8s(Y + (size_t)row * DM + c0, o); }
            { float a[8], b2[8], g[8], o[8];
              unpack8(GO + (size_t)row * 1024 + c0, a); unpack8(GO + ((size_t)ML + row) * 1024 + c0, b2); unpack8(Z + (size_t)row * Z1LD + ZC_GO + c0, g);
              float ss = 0.f;
#pragma unroll
              for (int j = 0; j < 8; ++j) { a[j] += b2[j]; ss += a[j] * a[j]; }
              ss = red16(ss);
              const float r = 1.f / sqrtf(ss * (1.f / 128.f) + EPSF);
              const f32x4 w0 = *(const f32x4*)(g_head_d + c0), w1 = *(const f32x4*)(g_head_d + c0 + 4);
#pragma unroll
              for (int j = 0; j < 8; ++j) o[j] = a[j] * r * (j < 4 ? w0[j & 3] : w1[j & 3]) * siluf_(g[j]);
              pack8s(Y + (size_t)row * DM + 1024 + c0, o); }
        }
    }
}
typedef float f32x4v __attribute__((ext_vector_type(4)));
constexpr int HB_LD = 2052;
typedef float f32x2_t __attribute__((ext_vector_type(2)));
template <bool DRY> __device__ __forceinline__ void ph_norm2_route(const bf16* X1, const float* g2, const float* ADA, const float* w_grp, const float* b_grp, const float* w_rtr, const float* b_rtr,
                                               bf16* HL2, int* TOK_E, int* TOK_P, float* TOK_W, unsigned* cnt, LAS float* sf, int tid, int lane, int wave) {
    for (int grp16 = blockIdx.x; grp16 < ML / 16; grp16 += gridDim.x) {
#pragma unroll 1
        for (int rr = 0; rr < 2; ++rr) {
            const int r = 2 * wave + rr, row = grp16 * 16 + r;
            const u32x2* src = (const u32x2*)(X1 + (size_t)row * DM); const float* sh = ADA + (size_t)(row / SEQ) * 12288 + 6144; const float* sc = sh + 2048;
            f32x4 v[8]; float s = 0.f;
#pragma unroll
            for (int j = 0; j < 8; ++j) { const u32x2 w = src[lane + 64 * j]; v[j] = (f32x4){bf_lo(w.x), bf_hi(w.x), bf_lo(w.y), bf_hi(w.y)}; s += (v[j].x * v[j].x + v[j].y * v[j].y) + (v[j].z * v[j].z + v[j].w * v[j].w); }
            const float rstd = 1.f / sqrtf(wave_sum(s) * (1.f / DM) + EPSF);
#pragma unroll
            for (int j = 0; j < 8; ++j) { const int col = 4 * (lane + 64 * j);
                const f32x4 g = *(const f32x4*)(g2 + col), a = *(const f32x4*)(sc + col), b = *(const f32x4*)(sh + col);
                const f32x4 o = (v[j] * rstd) * g * (a + 1.f) + b;
                *(LAS f32x4*)(sf + r * HB_LD + col) = o; }
        }
        __syncthreads();
        f32x4v acc0 = {0.f, 0.f, 0.f, 0.f}, acc1 = acc0, acc2 = acc0;
        { const int arow = lane & 15, kg = lane >> 4, bc = lane & 15;
#pragma unroll 1
          for (int kb = 0; kb < 64; kb += 16) {
              float av[16], b0[16], b1[16], b2[16];
#pragma unroll
              for (int u = 0; u < 16; ++u) { const int k = 256 * wave + 4 * (kb + u) + kg;
                  av[u] = sf[arow * HB_LD + k]; const f32x2_t bw = *(const f32x2_t*)(w_rtr + k * 32 + 2 * bc); b0[u] = bw.x; b1[u] = bw.y; b2[u] = bc < 4 ? w_grp[k * 4 + bc] : 0.f; }
              __builtin_amdgcn_sched_barrier(0);
#pragma unroll
              for (int u = 0; u < 16; ++u) {
                  acc0 = __builtin_amdgcn_mfma_f32_16x16x4f32(av[u], b0[u], acc0, 0, 0, 0);
                  acc1 = __builtin_amdgcn_mfma_f32_16x16x4f32(av[u], b1[u], acc1, 0, 0, 0);
                  acc2 = __builtin_amdgcn_mfma_f32_16x16x4f32(av[u], b2[u], acc2, 0, 0, 0); } } }
        __syncthreads();
        { LAS float* red = sf; const int col = lane & 15, r4 = 4 * (lane >> 4);
#pragma unroll
          for (int q = 0; q < 4; ++q) { red[((wave * 3 + 0) * 16 + r4 + q) * 16 + col] = acc0[q]; red[((wave * 3 + 1) * 16 + r4 + q) * 16 + col] = acc1[q]; red[((wave * 3 + 2) * 16 + r4 + q) * 16 + col] = acc2[q]; } }
        __syncthreads();
        for (int i = tid; i < 768; i += NTHREADS) { float s = 0.f;
#pragma unroll
            for (int w = 0; w < 8; ++w) s += sf[w * 768 + i];
            sf[8 * 768 + i] = s; }
        __syncthreads();
        if (tid < 16) {
            const int r = tid, row = grp16 * 16 + r; const LAS float* lg = sf + 8 * 768;
            float gl[4];
#pragma unroll
            for (int i = 0; i < 4; ++i) gl[i] = lg[(2 * 16 + r) * 16 + i] + b_grp[i];
            int gbest = 0; float gmax = gl[0];
#pragma unroll
            for (int i = 1; i < 4; ++i) if (gl[i] > gmax) { gmax = gl[i]; gbest = i; }
            float gsum = 0.f;
#pragma unroll
            for (int i = 0; i < 4; ++i) gsum += expf(gl[i] - gmax);
            const float pgrp = 1.f / gsum;
            float l0 = -3.0e38f, l1 = -3.0e38f; int e0 = 0, e1 = 0;
#pragma unroll
            for (int j = 0; j < 8; ++j) { const int idx = gbest * 8 + j; const float l = lg[((idx & 1) * 16 + r) * 16 + (idx >> 1)] + b_rtr[idx];
                if (l > l0) { l1 = l0; e1 = e0; l0 = l; e0 = j; } else if (l > l1) { l1 = l; e1 = j; } }
            const float t = expf(l1 - l0);
            const float w0 = pgrp / (1.f + t), w1 = pgrp * t / (1.f + t);
            const int ea = gbest * 8 + e0, eb = gbest * 8 + e1;
            if (DRY) { asm volatile("" :: "v"(w0), "v"(w1), "v"(ea), "v"(eb)); } else {
            const int pa = (int)atomicAdd(cnt + 64 * ea, 1u), pb = (int)atomicAdd(cnt + 64 * eb, 1u);
            TOK_E[row * 2] = ea; TOK_E[row * 2 + 1] = eb; TOK_P[row * 2] = pa; TOK_P[row * 2 + 1] = pb; TOK_W[row * 2] = w0; TOK_W[row * 2 + 1] = w1; }
        }
        __syncthreads();
    }
}
__device__ __forceinline__ void build_moe_tables(const unsigned* cnt, LAS int* tb, int tid) {
    __syncthreads();
    if (tid < NE) tb[320 + tid] = (int)__hip_atomic_load(cnt + 64 * tid, __ATOMIC_RELAXED, __HIP_MEMORY_SCOPE_AGENT);
    __syncthreads();
    if (tid == 0) { int acc = 0;
        for (int e = 0; e < NE; ++e) { const int nb = (tb[320 + e] + 255) >> 8; tb[e] = acc;
            for (int p = 0; p < nb; ++p) tb[64 + acc + p] = e;
            acc += nb; }
        tb[32] = acc; }
    __syncthreads();
}
__device__ __forceinline__ void ph_gather(const bf16* X1, const float* g2, const float* ADA, const int* TOK_E, const int* TOK_P, int* TOK_D, bf16* XB, const LAS int* tb, int gw, int NGW, int lane) {
    for (int tok = gw; tok < ML; tok += NGW) {
        const u32x2* src = (const u32x2*)(X1 + (size_t)tok * DM); const float* sh = ADA + (size_t)(tok / SEQ) * 12288 + 6144; const float* sc = sh + 2048;
        f32x4 v[8]; float s = 0.f;
#pragma unroll
        for (int j = 0; j < 8; ++j) { const u32x2 w = src[lane + 64 * j]; v[j] = (f32x4){bf_lo(w.x), bf_hi(w.x), bf_lo(w.y), bf_hi(w.y)}; s += (v[j].x * v[j].x + v[j].y * v[j].y) + (v[j].z * v[j].z + v[j].w * v[j].w); }
        const float rstd = 1.f / sqrtf(wave_sum(s) * (1.f / DM) + EPSF);
        const int e0 = TOK_E[tok * 2], e1 = TOK_E[tok * 2 + 1], d0 = tb[e0] * 256 + TOK_P[tok * 2], d1 = tb[e1] * 256 + TOK_P[tok * 2 + 1];
        unsigned long long* o0 = (unsigned long long*)(XB + (size_t)d0 * DM) + lane; unsigned long long* o1 = (unsigned long long*)(XB + (size_t)d1 * DM) + lane;
#pragma unroll
        for (int j = 0; j < 8; ++j) { const int col = 4 * (lane + 64 * j);
            const f32x4 g = *(const f32x4*)(g2 + col), a = *(const f32x4*)(sc + col), b = *(const f32x4*)(sh + col);
            const f32x4 o = (v[j] * rstd) * g * (a + 1.f) + b;
            const unsigned long long w = (unsigned long long)pk2(o.x, o.y) | ((unsigned long long)pk2(o.z, o.w) << 32);
            o0[64 * j] = w; o1[64 * j] = w; }
        if (lane == 0) { TOK_D[tok * 2] = d0; TOK_D[tok * 2 + 1] = d1; }
    }
}
__device__ __forceinline__ void ph_final(const bf16* X1, float* dst, const bf16* YE, const int* TOK_D, const float* TOK_W, const float* ADA, const float* g_final, int gw, int NGW, int lane) {
    for (int tok = gw; tok < ML; tok += NGW) {
        const int d0 = TOK_D[tok * 2], d1 = TOK_D[tok * 2 + 1]; const float w0 = TOK_W[tok * 2], w1 = TOK_W[tok * 2 + 1];
        const float* gt = ADA + (size_t)(tok / SEQ) * 12288 + 10240;
        const u32x2* xr = (const u32x2*)(X1 + (size_t)tok * DM) + lane;
        const u32x2* y0 = (const u32x2*)(YE + (size_t)d0 * DM) + lane; const u32x2* y1 = (const u32x2*)(YE + (size_t)d1 * DM) + lane;
        f32x4 v[8]; float s = 0.f;
#pragma unroll
        for (int j = 0; j < 8; ++j) { const int col = 4 * (lane + 64 * j);
            const u32x2 xw = xr[64 * j]; const f32x4 xv = {bf_lo(xw.x), bf_hi(xw.x), bf_lo(xw.y), bf_hi(xw.y)}, g = *(const f32x4*)(gt + col); const u32x2 a = y0[64 * j], b = y1[64 * j];
            const f32x4 ya = {bf_lo(a.x), bf_hi(a.x), bf_lo(a.y), bf_hi(a.y)}, yb = {bf_lo(b.x), bf_hi(b.x), bf_lo(b.y), bf_hi(b.y)};
            v[j] = xv + g * (ya * w0 + yb * w1);
            s += (v[j].x * v[j].x + v[j].y * v[j].y) + (v[j].z * v[j].z + v[j].w * v[j].w); }
        const float rstd = 1.f / sqrtf(wave_sum(s) * (1.f / DM) + EPSF);
#pragma unroll
        for (int j = 0; j < 8; ++j) { const int col = 4 * (lane + 64 * j); ((f32x4*)(dst + (size_t)tok * DM))[lane + 64 * j] = (v[j] * rstd) * *(const f32x4*)(g_final + col); }
    }
}
constexpr int NPH = 13;
struct Args { const float* in[24]; float* out; unsigned char* ws; int ph_lo, ph_hi; };
__global__ void __launch_bounds__(NTHREADS, 2) fwd_kernel(Args args) {
    extern __shared__ __attribute__((aligned(16))) unsigned char lds_raw[];
    LAS unsigned char* lds = (LAS unsigned char*)lds_raw;
    LAS float* sf = (LAS float*)lds;
    LAS int* tb = (LAS int*)(lds + TBL_OFF + 256);
    const int tid = threadIdx.x, lane = tid & 63, wave = __builtin_amdgcn_readfirstlane(tid >> 6);
    const int G = gridDim.x, bx = blockIdx.x;
    const int vcu = (G % 8 == 0) ? (bx % 8) * (G / 8) + bx / 8 : bx;
    const int gw = vcu * NWAVES + wave, NGW = G * NWAVES;
    unsigned char* const ws = args.ws;
    unsigned* const ctl = (unsigned*)(ws + WS_CTL);
#define xin ((const float*)args.in[0])
#define cvec ((const float*)args.in[1])
#define ctx ((const float*)args.in[2])
#define c_ctx ((const float*)args.in[3])
#define w_ada ((const float*)args.in[4])
#define b_ada ((const float*)args.in[5])
#define g_norm1 ((const float*)args.in[6])
#define g_norm2 ((const float*)args.in[7])
#define w_in ((const float*)args.in[8])
#define b_gate ((const float*)args.in[9])
#define a_log ((const float*)args.in[10])
#define dt_bias ((const float*)args.in[11])
#define w_conv ((const float*)args.in[12])
#define g_head_m ((const float*)args.in[13])
#define g_head_d ((const float*)args.in[14])
#define w_out ((const float*)args.in[15])
#define w_grp ((const float*)args.in[16])
#define b_grp ((const float*)args.in[17])
#define w_rtr ((const float*)args.in[18])
#define b_rtr ((const float*)args.in[19])
#define w1 ((const float*)args.in[20])
#define w3 ((const float*)args.in[21])
#define w2 ((const float*)args.in[22])
#define g_final ((const float*)args.in[23])
#define out (args.out)
#define cnt (ctl + CW_CNT)
#define ADA ((float*)(ws + WS_ADA))
#define GF ((float*)(ws + WS_GF))
#define MLG ((float*)(ws + WS_MLG))
#define GDG ((float*)(ws + WS_GDG))
#define TOK_E ((int*)(ws + WS_TOK))
#define TOK_P ((int*)(ws + WS_TOK) + 2 * ML)
#define TOK_W ((float*)(ws + WS_TOK) + 4 * ML)
#define TOK_D ((int*)(ws + WS_TOK) + 6 * ML)
#define WinT ((bf16*)(ws + WS_WIN))
#define WoutT ((bf16*)(ws + WS_WOUT))
#define W13T ((bf16*)(ws + WS_W13))
#define W2T ((bf16*)(ws + WS_W2))
#define HL ((bf16*)(ws + WS_HL))
#define Y ((bf16*)(ws + WS_Y))
#define Z1 ((bf16*)(ws + WS_Z1))
#define Z2 ((bf16*)(ws + WS_Z2))
#define GQ ((bf16*)(ws + WS_GQ))
#define GK ((bf16*)(ws + WS_GK))
#define GV ((bf16*)(ws + WS_GV))
#define MO ((bf16*)(ws + WS_MO))
#define GO ((bf16*)(ws + WS_GO))
#define GW ((bf16*)(ws + WS_GW))
#define GU ((bf16*)(ws + WS_GU))
#define GA ((bf16*)(ws + WS_GA))
#define GSC ((float*)(ws + WS_GSC))
#define MS ((bf16*)(ws + WS_MS))
#define MSC ((float*)(ws + WS_MSC))
#define DEN ((float*)(ws + WS_DEN))
#define HL2 ((bf16*)(ws + WS_HL2))
#define XB ((bf16*)(ws + WS_XB))
#define HB ((bf16*)(ws + WS_H))
#define YE ((bf16*)(ws + WS_YE))
#define X1B ((bf16*)(ws + WS_X1B))

    const int lo = args.ph_lo, hi = args.ph_hi;
    volatile LAS unsigned* MISC = (volatile LAS unsigned*)(lds + TBL_OFF);
    if (tid < 64) MISC[tid] = 0u;
    __syncthreads();
    XcdBarrier bar; bar.bar = ctl + CW_BAR; bar.x = 0; bar.st = nullptr;
    if (hi - lo > 1) bar = xcd_barrier_post(ctl + CW_BAR, MISC + 8);
#define IN(k) (lo <= (k) && (k) < hi)
#define SEAM(k) do { if (IN(k) && IN((k) + 1)) { xcd_barrier(bar); \
        if (USE_CG_SYNC && (k) == 0) { cg::this_grid().sync(); if (tid == 0) { __builtin_amdgcn_fence(__ATOMIC_ACQUIRE, "agent"); asm volatile("s_waitcnt vmcnt(0)" ::: "memory"); } __syncthreads(); } } } while (0)

#define RUN(k, ...) do { if (IN(k)) { __VA_ARGS__ if ((REPEAT_MASK >> (k)) & 1) { xcd_barrier(bar); __VA_ARGS__ } } } while (0)
    RUN(0, ph_ada(cvec, c_ctx, w_ada, b_ada, ADA, sf, tid, lane, wave); __syncthreads(); ph_transposes_io(w_in, w_out, ws, lds, gw, NGW, wave, lane););
    SEAM(0);
    RUN(1, ph_norm1(xin, ctx, g_norm1, ADA, HL, gw, NGW, lane););
    SEAM(1);
    RUN(2, { pg8::DenseSched S; S.init(HL, WinT, MT, NZ, DM, G, bx); pg8::EpiZ E{Z1, Z2, GF}; pg8::gemm_phase<pg8::EpiZ, pg8::DenseSched, true, true>(lds, DM, S, E); });
    SEAM(2);
    RUN(4, ph_cprep(Z1, Z2, GF, w_conv, b_gate, a_log, dt_bias, MS, MSC, GQ, GK, GW, GU, GA, GSC, lds, tid, lane, wave););
    SEAM(4);
    RUN(5, ph_scan(Z1, MS, MSC, GQ, GK, GW, GU, GA, GSC, MO, DEN, GO, w1, w3, w2, ws, lds, tid, lane, wave););
    SEAM(5);
    RUN(6, ph_combine(Z1, MO, DEN, GO, g_head_m, g_head_d, Y, gw, NGW, lane););
    SEAM(6);
    RUN(7, { pg8::DenseSched S; S.init(Y, WoutT, ML, DM, DM, G, bx); pg8::EpiX1 E{xin, X1B, ADA}; pg8::gemm_phase<pg8::EpiX1, pg8::DenseSched, true, true>(lds, DM, S, E); });
    SEAM(7);
    if (IN(8)) { if ((REPEAT_MASK >> 8) & 1) { ph_norm2_route<true>(X1B, g_norm2, ADA, w_grp, b_grp, w_rtr, b_rtr, HL2, TOK_E, TOK_P, TOK_W, cnt, sf, tid, lane, wave); xcd_barrier(bar); }
                 ph_norm2_route<false>(X1B, g_norm2, ADA, w_grp, b_grp, w_rtr, b_rtr, HL2, TOK_E, TOK_P, TOK_W, cnt, sf, tid, lane, wave); }
    SEAM(8);
    RUN(9, build_moe_tables(cnt, tb, tid); ph_gather(X1B, g_norm2, ADA, TOK_E, TOK_P, TOK_D, XB, tb, gw, NGW, lane););
    SEAM(9);
    RUN(10, { build_moe_tables(cnt, tb, tid);
                 pg8::MoeSched S; S.A = (const char*)XB; S.Bt = (const char*)W13T; S.a_tstep = (size_t)256 * DM * 2; S.b_estep = (size_t)1536 * DM * 2; S.b_tstep = (size_t)256 * DM * 2;
                 S.nN = 6; S.nunits = tb[32] * 6; S.G = G; S.c = vcu; S.blk2e = tb + 64;
                 pg8::EpiSwiglu E{HB};
                 pg8::gemm_phase<pg8::EpiSwiglu, pg8::MoeSched, true, true>(lds, DM, S, E); });
    SEAM(10);
    RUN(11, { build_moe_tables(cnt, tb, tid);
                  pg8::MoeSched S; S.A = (const char*)HB; S.Bt = (const char*)W2T; S.a_tstep = (size_t)256 * DE * 2; S.b_estep = (size_t)DM * DE * 2; S.b_tstep = (size_t)256 * DE * 2;
                  S.nN = 8; S.nunits = tb[32] * 8; S.G = G; S.c = vcu; S.blk2e = tb + 64;
                  pg8::EpiBf E{YE, DM};
                  pg8::gemm_phase<pg8::EpiBf, pg8::MoeSched, true, true>(lds, DE, S, E); });
    SEAM(11);
    if (IN(12)) { if ((REPEAT_MASK >> 12) & 1) { ph_final(X1B, (float*)(ws + WS_XB), YE, TOK_D, TOK_W, ADA, g_final, gw, NGW, lane); xcd_barrier(bar); }
                  ph_final(X1B, out, YE, TOK_D, TOK_W, ADA, g_final, gw, NGW, lane); }
#undef RUN
#undef IN
#undef SEAM
#undef xin
#undef cvec
#undef ctx
#undef c_ctx
#undef w_ada
#undef b_ada
#undef g_norm1
#undef g_norm2
#undef w_in
#undef b_gate
#undef a_log
#undef dt_bias
#undef w_conv
#undef g_head_m
#undef g_head_d
#undef w_out
#undef w_grp
#undef b_grp
#undef w_rtr
#undef b_rtr
#undef w1
#undef w3
#undef w2
#undef g_final
#undef out
#undef cnt
#undef ADA
#undef GF
#undef MLG
#undef GDG
#undef TOK_E
#undef TOK_P
#undef TOK_W
#undef TOK_D
#undef WinT
#undef WoutT
#undef W13T
#undef W2T
#undef HL
#undef Y
#undef Z1
#undef Z2
#undef GQ
#undef GK
#undef GV
#undef MO
#undef GO
#undef GW
#undef GU
#undef GA
#undef GSC
#undef MS
#undef MSC
#undef DEN
#undef HL2
#undef XB
#undef HB
#undef YE
#undef X1B
}

#ifndef MK_MULTI
#define MK_MULTI 0
#endif
extern "C" void kernel_launch(void* const* d_in, const int* in_sizes, int n_in, void* d_out, int out_size, void* d_ws, size_t ws_size, hipStream_t stream) {
    static int grid = 0;
    if (grid == 0) {
        if (n_in != 24 || in_sizes[0] != ML * DM || out_size != ML * DM || ws_size < WS_END) {
            fprintf(stderr, "kernel_launch: built for 24 inputs, x/out of %d floats, >= %zu bytes of workspace; got n_in %d, in0 %d, out %d, ws %zu; nothing launched\n", ML * DM, (size_t)WS_END, n_in, n_in > 0 ? in_sizes[0] : -1, out_size, ws_size);
            grid = -1; return; }
        int dev = 0, cus = 0, per_cu = 0;
        if (hipGetDevice(&dev) != hipSuccess || hipDeviceGetAttribute(&cus, hipDeviceAttributeMultiprocessorCount, dev) != hipSuccess) { fprintf(stderr, "kernel_launch: device query failed\n"); grid = -1; return; }
        if (hipFuncSetAttribute((const void*)fwd_kernel, hipFuncAttributeMaxDynamicSharedMemorySize, LDS_BYTES) != hipSuccess) { fprintf(stderr, "kernel_launch: hipFuncSetAttribute failed\n"); grid = -1; return; }
        if (hipOccupancyMaxActiveBlocksPerMultiprocessor(&per_cu, (const void*)fwd_kernel, NTHREADS, LDS_BYTES) != hipSuccess || per_cu < 1) { fprintf(stderr, "kernel_launch: occupancy query says %d blocks per CU\n", per_cu); (void)hipGetLastError(); grid = -1; return; }
        grid = cus;
        fprintf(stderr, "kernel_launch: %d CUs, occupancy %d per CU, grid %d\n", cus, per_cu, grid);
    }
    if (grid < 0) return;
    if (hipMemsetAsync((char*)d_ws + WS_CTL, 0, CTL_ZERO_BYTES, stream) != hipSuccess) { fprintf(stderr, "kernel_launch: memset failed\n"); return; }
    Args a{};
    for (int i = 0; i < 24; ++i) a.in[i] = (const float*)d_in[i];
    a.out = (float*)d_out; a.ws = (unsigned char*)d_ws;
#if MK_MULTI
    for (int ph = 0; ph < NPH; ++ph) { a.ph_lo = ph; a.ph_hi = ph + 1; hipLaunchKernelGGL(fwd_kernel, dim3(grid), dim3(NTHREADS), LDS_BYTES, stream, a); }
#else
    a.ph_lo = 0; a.ph_hi = NPH;
    void* params[] = {&a};
    const hipError_t e = hipLaunchCooperativeKernel((const void*)fwd_kernel, dim3(grid), dim3(NTHREADS), params, LDS_BYTES, stream);
    if (e != hipSuccess) fprintf(stderr, "kernel_launch: cooperative launch failed: %s (grid %d)\n", hipGetErrorString(e), grid);
#endif
}
```

```cpp
#include <hip/hip_runtime.h>
#include <hip/hip_cooperative_groups.h>
#include <cstdio>
#include <cstdint>
namespace cg = cooperative_groups;

constexpr int DM = 2048, NB = 2, SEQ = 8192, CTXL = 256;
constexpr int ML = NB * SEQ;
constexpr int MC = NB * CTXL;
constexpr int MT = ML + MC;
constexpr int DIN = 7216, NZ = 7424, ZLD = 7168, GFLD = 64;
constexpr int NE = 32, DE = 768;
constexpr float EPSF = 1e-6f;
constexpr int ZC_MQ = 0, ZC_MK = 512, ZC_MV = 1024, ZC_MO = 2048, ZC_GO = 3072;

constexpr size_t MiB = 1u << 20;
constexpr size_t WS_CTL = 0, CTL_ZERO_BYTES = 1 * MiB;
constexpr size_t WS_ADA = 1 * MiB;
constexpr size_t WS_GF = 2 * MiB;
constexpr size_t WS_MLG = 7 * MiB;
constexpr size_t WS_GDG = 9 * MiB;
constexpr size_t WS_TOK = 12 * MiB;
constexpr size_t WS_WIN = 13 * MiB;
constexpr size_t WS_WOUT = 42 * MiB;
constexpr size_t WS_W13 = 50 * MiB;
constexpr size_t WS_W2 = 242 * MiB;
constexpr size_t WS_Z2 = 50 * MiB;
constexpr size_t WS_HL = 149 * MiB;
constexpr size_t WS_GV = 215 * MiB;
constexpr size_t WS_Z1 = 338 * MiB;
constexpr size_t WS_GQ = 470 * MiB, WS_GK = 503 * MiB;
constexpr size_t WS_Y = 470 * MiB;
constexpr size_t WS_GW = 536 * MiB, WS_GU = 602 * MiB, WS_GA = 668 * MiB, WS_GSC = 701 * MiB;
constexpr size_t WS_MS = 705 * MiB, WS_MSC = 722 * MiB;
constexpr size_t WS_MO = 724 * MiB, WS_GO = 788 * MiB;
constexpr size_t WS_DEN = 12 * MiB + 512 * 1024;
constexpr size_t WS_HL2 = 338 * MiB;
constexpr size_t WS_XB = 402 * MiB;
constexpr size_t WS_H = 562 * MiB;
constexpr size_t WS_YE = 622 * MiB;
constexpr size_t WS_X1B = 788 * MiB;
constexpr size_t WS_END = 852 * MiB;
constexpr int Z1LD = 4096, Z2LD = 3072;
static_assert(WS_Z2 + (size_t)MT * Z2LD * 2 <= WS_HL && WS_HL + (size_t)MT * 2048 * 2 <= WS_GV && WS_GV + (size_t)MT * 1024 * 2 <= WS_Z1, "ws map: pre-scan overlays of the expert region");
static_assert(WS_Z1 + (size_t)MT * Z1LD * 2 <= WS_GQ && WS_GK + (size_t)MT * 1024 * 2 <= WS_GW && WS_GSC + (size_t)2112 * 2 * 192 * 4 <= WS_MS && WS_MS + (size_t)1056 * 2 * 4096 * 2 <= WS_MSC && WS_MSC + (size_t)1056 * 2 * 192 * 4 <= WS_MO && WS_GO + (size_t)2 * ML * 1024 * 2 <= WS_END, "ws map A");
static_assert(WS_GW + (size_t)2112 * 2 * 8192 * 2 <= WS_GU && WS_GU + (size_t)2112 * 2 * 8192 * 2 <= WS_GA && WS_GA + (size_t)2112 * 2 * 4096 * 2 <= WS_GSC, "ws map gdn operands");
static_assert(WS_HL2 + (size_t)ML * 2048 * 2 <= WS_XB && WS_XB + (size_t)40960 * 4096 <= WS_H && WS_H + (size_t)40960 * 1536 <= WS_YE && WS_YE + (size_t)40960 * 4096 <= WS_END, "ws map B");
static_assert(WS_WIN + (size_t)NZ * 2048 * 2 <= WS_WOUT && WS_W13 + (size_t)32 * 1536 * 2048 * 2 <= WS_W2 && WS_W2 + (size_t)32 * 2048 * 768 * 2 <= WS_Z1 && WS_Y + (size_t)ML * 2048 * 2 <= WS_GW, "ws map W");
constexpr int CW_TMO = 0, CW_CNT = 1024, CW_BAR = 4096;

constexpr int SCR_BYTES = 161792;
constexpr int TBL_OFF = SCR_BYTES;
constexpr int LDS_BYTES = 163840;
constexpr int NWAVES = 8, NTHREADS = 512;
#ifndef MLSTM_CHUNKED
#define MLSTM_CHUNKED 1
#endif
#ifndef GDN_CHUNKED
#define GDN_CHUNKED 1
#endif
#ifndef USE_CG_SYNC
#define USE_CG_SYNC 1
#endif
#ifndef NOPMASK
#define NOPMASK 3104
#endif
#ifndef TR_BLOCKS
#define TR_BLOCKS 96
#endif
#ifndef SCAN_PROBE_WHICH
#define SCAN_PROBE_WHICH 3
#endif
#ifndef SCAN_PROBE_MODE
#define SCAN_PROBE_MODE 0
#endif
#ifndef REPEAT_MASK
#define REPEAT_MASK 0
#endif
#ifndef E6_ABS
#define E6_ABS 0.02f
#endif
#ifndef E6_REL
#define E6_REL 0.05f
#endif
#ifndef GDN_E5
#define GDN_E5 0
#endif
#ifndef GDN_SCAN_SEQ
#define GDN_SCAN_SEQ 0
#endif

namespace pg8 {
#define PG8_LAS __attribute__((address_space(3)))
typedef unsigned short bf16_t;
typedef short bf16x8 __attribute__((ext_vector_type(8)));
typedef float f32x4 __attribute__((ext_vector_type(4)));
typedef unsigned u32x4 __attribute__((ext_vector_type(4)));
constexpr int BM = 256, BK = 64, HALF = 128, HTB = HALF * BK * 2  , STAGE_BYTES = 8 * HTB, NXCD = 8, WGM = 8;

__host__ __device__ __forceinline__ int lds_byte(int r, int c) { const int st = (r >> 4) * 2 + (c >> 5), rr = r & 15, cc = c & 31, ob = rr * 64 + cc * 2; return st * 1024 + (ob ^ (((ob >> 9) & 1) << 5)); }
__host__ __device__ __forceinline__ void stage_rc(int b, int& R, int& C) { const int st = b / 1024, sb = b % 1024, swz = sb ^ (((sb >> 9) & 1) << 5); R = (st >> 1) * 16 + swz / 64; C = (st & 1) * 32 + (swz % 64) / 2; }
__host__ __device__ __forceinline__ int perm32(int rho) { const int n = rho >> 4, i = rho & 15; return 8 * (i >> 2) + 4 * n + (i & 3); }

struct Unit { int pm, pn; };

struct DenseSched {
    const char* A; const char* Bt; size_t tstep; int nM, nN, nwg, G, c;
    __device__ __forceinline__ void init(const void* A_, const void* Bt_, int M, int N, int K, int G_, int c_) { A = (const char*)A_; Bt = (const char*)Bt_; tstep = (size_t)BM * K * 2; nM = M / BM; nN = N / BM; nwg = nM * nN; G = G_; c = c_; }
    __device__ __forceinline__ bool next(int i, Unit& u) const {
        const long L = (long)i * G + c; if (L >= nwg) return false;
        int wgid = (int)L; { const int q = nwg / NXCD, r = nwg % NXCD, xcd = wgid % NXCD, off = wgid / NXCD; wgid = (xcd < r ? xcd * (q + 1) : r * (q + 1) + (xcd - r) * q) + off; }
        const int nig = WGM * nN, gid = wgid / nig, fm = gid * WGM, gsz = (nM - fm) < WGM ? (nM - fm) : WGM;
        u.pm = fm + ((wgid % nig) % gsz); u.pn = (wgid % nig) / gsz; return true;
    }
    __device__ __forceinline__ const char* a_base(const Unit& u) const { return A + (size_t)u.pm * tstep; }
    __device__ __forceinline__ const char* b_base(const Unit& u) const { return Bt + (size_t)u.pn * tstep; }
    __device__ __forceinline__ void a_ready(const Unit&) const {}
    __device__ __forceinline__ void done(const Unit&) const {}
};
struct MoeSched {
    const char* A; const char* Bt; size_t a_tstep, b_estep, b_tstep; int nN, nunits, G, c; const PG8_LAS int* blk2e;
    __device__ __forceinline__ bool next(int i, Unit& u) const { const long L = (long)i * G + c; if (L >= nunits) return false; u.pm = (int)L / nN; u.pn = (int)L % nN; return true; }
    __device__ __forceinline__ const char* a_base(const Unit& u) const { return A + (size_t)u.pm * a_tstep; }
    __device__ __forceinline__ const char* b_base(const Unit& u) const { return Bt + (size_t)blk2e[u.pm] * b_estep + (size_t)u.pn * b_tstep; }
    __device__ __forceinline__ void a_ready(const Unit&) const {}
    __device__ __forceinline__ void done(const Unit&) const {}
};

typedef float f32x2_cv __attribute__((ext_vector_type(2)));
typedef __bf16 bf16x2_cv __attribute__((ext_vector_type(2)));
__device__ __forceinline__ unsigned cvt_pk_bf16(float lo, float hi) { const f32x2_cv v = {lo, hi}; const bf16x2_cv b = __builtin_convertvector(v, bf16x2_cv); return __builtin_bit_cast(unsigned, b); }
__device__ __forceinline__ u32x4 pack8(const f32x4 v0, const f32x4 v1) { u32x4 w; w.x = cvt_pk_bf16(v0[0], v0[1]); w.y = cvt_pk_bf16(v0[2], v0[3]); w.z = cvt_pk_bf16(v1[0], v1[1]); w.w = cvt_pk_bf16(v1[2], v1[3]); return w; }

struct EpiZ {
    static constexpr bool PERM = true, AFTER_DRAIN = false;
    bf16_t* Z1; bf16_t* Z2; float* GF;
    __device__ __forceinline__ void operator()(const f32x4 (&acc)[2][2][4][2], const Unit& u, int wr, int wc, int fr, int fq) const {
        const int row0 = u.pm * BM + wr * 64 + fr;
        if (u.pn < 28) {
            const bool second = u.pn >= 12 && u.pn < 24;
            bf16_t* base = second ? Z2 : Z1; const int ld = second ? 3072 : 4096;
            const int col0 = (second ? u.pn - 12 : (u.pn < 12 ? u.pn : u.pn - 12)) * BM + wc * 32 + 8 * fq;
#pragma unroll
            for (int ai = 0; ai < 2; ++ai)
#pragma unroll
                for (int m = 0; m < 4; ++m) { bf16_t* rowp = base + (size_t)(row0 + ai * HALF + m * 16) * ld + col0;
#pragma unroll
                    for (int bj = 0; bj < 2; ++bj) *(u32x4*)(rowp + bj * HALF) = pack8(acc[ai][bj][m][0], acc[ai][bj][m][1]); }
        } else if (wc < 2) {
            const int col0 = wc * 32 + 8 * fq;
#pragma unroll
            for (int ai = 0; ai < 2; ++ai)
#pragma unroll
                for (int m = 0; m < 4; ++m) { float* rowp = GF + (size_t)(row0 + ai * HALF + m * 16) * 64 + col0;
                    *(f32x4*)(rowp) = acc[ai][0][m][0]; *(f32x4*)(rowp + 4) = acc[ai][0][m][1]; }
        }
    }
};
struct EpiX1 {
    static constexpr bool PERM = true, AFTER_DRAIN = false;
    const float* x; bf16_t* out; const float* ada;
    __device__ __forceinline__ void operator()(const f32x4 (&acc)[2][2][4][2], const Unit& u, int wr, int wc, int fr, int fq) const {
        const int row0 = u.pm * BM + wr * 64 + fr, col0 = u.pn * BM + wc * 32 + 8 * fq;
        const float* gt = ada + (size_t)((u.pm * BM) / 8192) * 12288 + 4096 + col0;
        f32x4 g[2][2];
#pragma unroll
        for (int bj = 0; bj < 2; ++bj)
#pragma unroll
            for (int n = 0; n < 2; ++n) g[bj][n] = *(const f32x4*)(gt + bj * HALF + 4 * n);
#pragma unroll
        for (int ai = 0; ai < 2; ++ai)
#pragma unroll
            for (int m = 0; m < 4; ++m) { const size_t off = (size_t)(row0 + ai * HALF + m * 16) * 2048 + col0;
#pragma unroll
                for (int bj = 0; bj < 2; ++bj) { const f32x4 x0 = *(const f32x4*)(x + off + bj * HALF), x1 = *(const f32x4*)(x + off + bj * HALF + 4);
                    *(u32x4*)(out + off + bj * HALF) = pack8(x0 + g[bj][0] * acc[ai][bj][m][0], x1 + g[bj][1] * acc[ai][bj][m][1]); } }
    }
};
struct EpiSwiglu {
    static constexpr bool PERM = true, AFTER_DRAIN = false;
    bf16_t* H;
    __device__ __forceinline__ void operator()(const f32x4 (&acc)[2][2][4][2], const Unit& u, int wr, int wc, int fr, int fq) const {
        const int row0 = u.pm * BM + wr * 64 + fr, col0 = u.pn * HALF + wc * 32 + 8 * fq;
#pragma unroll
        for (int ai = 0; ai < 2; ++ai)
#pragma unroll
            for (int m = 0; m < 4; ++m) { f32x4 h[2];
#pragma unroll
                for (int n = 0; n < 2; ++n)
#pragma unroll
                    for (int r = 0; r < 4; ++r) { const float a = acc[ai][0][m][n][r]; h[n][r] = a / (1.f + __expf(-a)) * acc[ai][1][m][n][r]; }
                *(u32x4*)(H + (size_t)(row0 + ai * HALF + m * 16) * 768 + col0) = pack8(h[0], h[1]); }
    }
};
struct EpiBf {
    static constexpr bool PERM = true, AFTER_DRAIN = false;
    bf16_t* O; int ldc;
    __device__ __forceinline__ void operator()(const f32x4 (&acc)[2][2][4][2], const Unit& u, int wr, int wc, int fr, int fq) const {
        const int row0 = u.pm * BM + wr * 64 + fr, col0 = u.pn * BM + wc * 32 + 8 * fq;
#pragma unroll
        for (int ai = 0; ai < 2; ++ai)
#pragma unroll
            for (int m = 0; m < 4; ++m) { bf16_t* rowp = O + (size_t)(row0 + ai * HALF + m * 16) * ldc + col0;
#pragma unroll
                for (int bj = 0; bj < 2; ++bj) *(u32x4*)(rowp + bj * HALF) = pack8(acc[ai][bj][m][0], acc[ai][bj][m][1]); }
    }
};

template <class Epi, class Sched, bool ALIGN_EPI = false, bool SP2 = false>
__device__ __forceinline__ void gemm_phase(PG8_LAS unsigned char* lds, const int K, const Sched& S, const Epi& E) {
    const int tid = threadIdx.x, wid = __builtin_amdgcn_readfirstlane(tid >> 6), lane = tid & 63, wr = wid >> 2, wc = wid & 3, fr = lane & 15, fq = lane >> 4;
    const int nt = K / BK;
    unsigned voffA[2], voffB[2];
#pragma unroll
    for (int i = 0; i < 2; ++i) { int R, C; stage_rc(tid * 16 + i * 8192, R, C); const int Rb = Epi::PERM ? ((R & ~31) + perm32(R & 31)) : R;
        voffA[i] = (unsigned)(R * K + C) * 2u; voffB[i] = (unsigned)(Rb * K + C) * 2u; }
    const size_t kstep = (size_t)(BK * 2);
    const size_t hstep = (size_t)HALF * K * 2;
    const unsigned ldsw = (unsigned)wid * 1024u;
    const int aoff = lds_byte(wr * 64 + fr, fq * 8), boff = lds_byte(wc * 32 + fr, fq * 8);
#define PG8_SA(b, h) (((b) * 2 + (h)) * HTB)
#define PG8_SB(b, h) ((4 + (b) * 2 + (h)) * HTB)
#define PG8_STAGE(bufoff, gbase, voff) do { _Pragma("unroll") for (int _i = 0; _i < 2; ++_i) \
        __builtin_amdgcn_global_load_lds((const unsigned*)((const char*)(gbase) + (voff)[_i]), (PG8_LAS unsigned*)(lds + (bufoff) + ldsw + _i * 8192), 16, 0, 0); } while (0)
#define PG8_LDA(dst, b, h) do { _Pragma("unroll") for (int m = 0; m < 4; ++m) _Pragma("unroll") for (int k = 0; k < 2; ++k) dst[m][k] = *(const PG8_LAS bf16x8*)(lds + PG8_SA(b, h) + aoff + m * 2048 + k * 1024); } while (0)
#define PG8_LDB(dst, b, h) do { _Pragma("unroll") for (int n = 0; n < 2; ++n) _Pragma("unroll") for (int k = 0; k < 2; ++k) dst[n][k] = *(const PG8_LAS bf16x8*)(lds + PG8_SB(b, h) + boff + n * 2048 + k * 1024); } while (0)
#define PG8_MMA(ai, bj, At, Bt) do { __builtin_amdgcn_s_setprio(1); _Pragma("unroll") for (int m = 0; m < 4; ++m) _Pragma("unroll") for (int n = 0; n < 2; ++n) _Pragma("unroll") for (int k = 0; k < 2; ++k) \
        acc[ai][bj][m][n] = __builtin_amdgcn_mfma_f32_16x16x32_bf16(Bt[n][k], At[m][k], acc[ai][bj][m][n], 0, 0, 0); __builtin_amdgcn_s_setprio(0); } while (0)
#define PG8_WAIT_V(n) asm volatile("s_waitcnt vmcnt(" #n ")" ::: "memory")
#define PG8_WAIT_L(n) asm volatile("s_waitcnt lgkmcnt(" #n ")" ::: "memory")
#define PG8_BAR __builtin_amdgcn_s_barrier()
#define PG8_SCHED __builtin_amdgcn_sched_barrier(0)
    Unit cur, nxt; int ui = 0;
    if (!S.next(0, cur)) return;
    f32x4 acc[2][2][4][2];
#pragma unroll
    for (int a = 0; a < 2; ++a)
#pragma unroll
        for (int b = 0; b < 2; ++b)
#pragma unroll
            for (int m = 0; m < 4; ++m)
#pragma unroll
                for (int n = 0; n < 2; ++n) acc[a][b][m][n] = (f32x4){0.f, 0.f, 0.f, 0.f};
    bf16x8 At[4][2], B0[2][2], B1[2][2];
    const char* cA = S.a_base(cur); const char* cB = S.b_base(cur);
    S.a_ready(cur);
    if constexpr (SP2) {
        PG8_STAGE(PG8_SB(0, 0), cB, voffB); PG8_STAGE(PG8_SB(0, 1), cB + hstep, voffB); PG8_STAGE(PG8_SA(0, 0), cA, voffA); PG8_STAGE(PG8_SA(0, 1), cA + hstep, voffA);
        if (wr == 1) PG8_BAR;
        PG8_WAIT_V(2); PG8_BAR;
        PG8_STAGE(PG8_SB(1, 0), cB + kstep, voffB); PG8_STAGE(PG8_SA(1, 0), cA + kstep, voffA); PG8_STAGE(PG8_SB(1, 1), cB + hstep + kstep, voffB);
        PG8_WAIT_V(6); PG8_BAR;
    } else {
        PG8_STAGE(PG8_SB(0, 0), cB, voffB); PG8_STAGE(PG8_SA(0, 0), cA, voffA); PG8_STAGE(PG8_SB(0, 1), cB + hstep, voffB); PG8_STAGE(PG8_SA(0, 1), cA + hstep, voffA);
        if (wr == 1) PG8_BAR;
        PG8_WAIT_V(4); PG8_BAR;
        PG8_STAGE(PG8_SB(1, 0), cB + kstep, voffB); PG8_STAGE(PG8_SA(1, 0), cA + kstep, voffA); PG8_STAGE(PG8_SB(1, 1), cB + hstep + kstep, voffB);
        PG8_WAIT_V(6); PG8_BAR;
    }
    for (;;) {
        const bool has_next = S.next(ui + 1, nxt);
        const char* nA = has_next ? S.a_base(nxt) : cA; const char* nB = has_next ? S.b_base(nxt) : cB;
        for (int t = 0; t < nt; t += 2) {
            const bool last = (t == nt - 2);
            const char* a1 = cA + (size_t)(t + 1) * kstep;
            const char* a2 = last ? nA : cA + (size_t)(t + 2) * kstep; const char* b2 = last ? nB : cB + (size_t)(t + 2) * kstep;
            const char* a3 = a2 + kstep; const char* b3 = b2 + kstep;
            if (last && has_next) S.a_ready(nxt);
            if constexpr (SP2) {
            PG8_LDB(B0, 0, 0); PG8_LDB(B1, 0, 1); PG8_SCHED; PG8_LDA(At, 0, 0); PG8_STAGE(PG8_SA(1, 1), a1 + hstep, voffA);
            PG8_WAIT_V(8); PG8_WAIT_L(0); PG8_BAR; PG8_MMA(0, 0, At, B0); PG8_MMA(0, 1, At, B1); PG8_BAR; PG8_SCHED;
            PG8_LDA(At, 0, 1); PG8_STAGE(PG8_SB(0, 0), b2, voffB); PG8_STAGE(PG8_SB(0, 1), b2 + hstep, voffB); PG8_STAGE(PG8_SA(0, 0), a2, voffA);
            PG8_WAIT_V(8); PG8_WAIT_L(0); PG8_BAR; PG8_MMA(1, 0, At, B0); PG8_MMA(1, 1, At, B1); PG8_BAR; PG8_SCHED;
            PG8_LDB(B0, 1, 0); PG8_LDB(B1, 1, 1); PG8_SCHED; PG8_LDA(At, 1, 0); PG8_STAGE(PG8_SA(0, 1), a2 + hstep, voffA);
            PG8_WAIT_V(8); PG8_WAIT_L(0); PG8_BAR; PG8_MMA(0, 0, At, B0); PG8_MMA(0, 1, At, B1); PG8_BAR; PG8_SCHED;
            PG8_LDA(At, 1, 1); PG8_STAGE(PG8_SB(1, 0), b3, voffB); PG8_STAGE(PG8_SB(1, 1), b3 + hstep, voffB); PG8_STAGE(PG8_SA(1, 0), a3, voffA);
            PG8_WAIT_V(8); PG8_WAIT_L(0); PG8_BAR; PG8_MMA(1, 0, At, B0); PG8_MMA(1, 1, At, B1); PG8_BAR; PG8_SCHED;
            } else {
            PG8_LDB(B0, 0, 0); PG8_SCHED; PG8_LDA(At, 0, 0); PG8_STAGE(PG8_SA(1, 1), a1 + hstep, voffA);
            PG8_WAIT_L(8); PG8_BAR; PG8_WAIT_L(0); PG8_MMA(0, 0, At, B0); PG8_BAR; PG8_SCHED;
            PG8_LDB(B1, 0, 1); PG8_STAGE(PG8_SB(0, 0), b2, voffB);
            PG8_BAR; PG8_WAIT_L(0); PG8_MMA(0, 1, At, B1); PG8_BAR;
            PG8_LDA(At, 0, 1); PG8_STAGE(PG8_SA(0, 0), a2, voffA);
            PG8_BAR; PG8_WAIT_L(0); PG8_MMA(1, 0, At, B0); PG8_BAR; PG8_SCHED;
            PG8_STAGE(PG8_SB(0, 1), b2 + hstep, voffB);
            PG8_WAIT_V(6); PG8_BAR; PG8_MMA(1, 1, At, B1); PG8_BAR;
            PG8_LDB(B0, 1, 0); PG8_SCHED; PG8_LDA(At, 1, 0); PG8_STAGE(PG8_SA(0, 1), a2 + hstep, voffA);
            PG8_WAIT_L(8); PG8_BAR; PG8_WAIT_L(0); PG8_MMA(0, 0, At, B0); PG8_BAR; PG8_SCHED;
            PG8_LDB(B1, 1, 1); PG8_STAGE(PG8_SB(1, 0), b3, voffB);
            PG8_BAR; PG8_WAIT_L(0); PG8_MMA(0, 1, At, B1); PG8_BAR;
            PG8_LDA(At, 1, 1); PG8_STAGE(PG8_SA(1, 0), a3, voffA);
            PG8_BAR; PG8_WAIT_L(0); PG8_MMA(1, 0, At, B0); PG8_BAR; PG8_SCHED;
            PG8_STAGE(PG8_SB(1, 1), b3 + hstep, voffB);
            PG8_WAIT_V(6); PG8_BAR; PG8_MMA(1, 1, At, B1); PG8_BAR;
            }
        }
        if constexpr (ALIGN_EPI) { if (wr == 0) PG8_BAR; }
        if constexpr (!Epi::AFTER_DRAIN) { E(acc, cur, wr, wc, fr, fq); S.done(cur); }
        if (!has_next) break;
#pragma unroll
        for (int a = 0; a < 2; ++a)
#pragma unroll
            for (int b = 0; b < 2; ++b)
#pragma unroll
                for (int m = 0; m < 4; ++m)
#pragma unroll
                    for (int n = 0; n < 2; ++n) acc[a][b][m][n] = (f32x4){0.f, 0.f, 0.f, 0.f};
        cur = nxt; cA = nA; cB = nB; ++ui;
        if constexpr (ALIGN_EPI) { if (wr == 1) PG8_BAR; }
    }
    PG8_WAIT_V(0);
    if constexpr (!ALIGN_EPI) { if (wr == 0) PG8_BAR; }
    PG8_BAR;
    if constexpr (Epi::AFTER_DRAIN) { E.fused(acc, cur, wr, wc, fr, fq, lds, wid, lane); S.done(cur); }
#undef PG8_SA
#undef PG8_SB
#undef PG8_STAGE
#undef PG8_LDA
#undef PG8_LDB
#undef PG8_MMA
#undef PG8_WAIT_V
#undef PG8_WAIT_L
#undef PG8_BAR
#undef PG8_SCHED
}
}
#define GAS __attribute__((address_space(1)))
#define LAS __attribute__((address_space(3)))
typedef unsigned short bf16;
typedef unsigned v4u __attribute__((ext_vector_type(4)));
typedef float f32x4 __attribute__((ext_vector_type(4)));
typedef short bf16x8 __attribute__((ext_vector_type(8)));
typedef GAS unsigned gu32;
typedef GAS unsigned long long gu64;
#define RLX_AGENT __ATOMIC_RELAXED, __HIP_MEMORY_SCOPE_AGENT
#define LDS_WAIT() asm volatile("s_waitcnt lgkmcnt(0)" ::: "memory")
#define VM_WAIT() asm volatile("s_waitcnt vmcnt(0)" ::: "memory")
__device__ __forceinline__ unsigned long long rt() { return __builtin_amdgcn_s_memrealtime(); }
__device__ __forceinline__ unsigned f2bf(float f) { unsigned u = __builtin_bit_cast(unsigned, f); return (u + 0x7fffu + ((u >> 16) & 1u)) >> 16; }
__device__ __forceinline__ unsigned pk2(float lo, float hi) { return f2bf(lo) | (f2bf(hi) << 16); }
typedef unsigned u32x4v_t __attribute__((ext_vector_type(4)));
typedef short v4i16_t __attribute__((ext_vector_type(4)));
__device__ __forceinline__ v4i16_t tr16(const LAS unsigned char* p) { return __builtin_amdgcn_ds_read_tr16_b64_v4i16((LAS v4i16_t*)p); }
__device__ __forceinline__ bf16x8 cat8(v4i16_t lo, v4i16_t hi) { bf16x8 r; r[0] = lo[0]; r[1] = lo[1]; r[2] = lo[2]; r[3] = lo[3]; r[4] = hi[0]; r[5] = hi[1]; r[6] = hi[2]; r[7] = hi[3]; return r; }
__device__ __forceinline__ bf16x8 packacc(const f32x4 a, const f32x4 b) {
    u32x4v_t w; w[0] = pg8::cvt_pk_bf16(a[0], a[1]); w[1] = pg8::cvt_pk_bf16(a[2], a[3]); w[2] = pg8::cvt_pk_bf16(b[0], b[1]); w[3] = pg8::cvt_pk_bf16(b[2], b[3]); return __builtin_bit_cast(bf16x8, w);
}
#define LDS_BARRIER() do { asm volatile("s_waitcnt lgkmcnt(0)" ::: "memory"); __builtin_amdgcn_s_barrier(); asm volatile("" ::: "memory"); } while (0)
#define MFMA16(a, b, c) __builtin_amdgcn_mfma_f32_16x16x32_bf16((a), (b), (c), 0, 0, 0)

#define XB_TMO      128
#define XB_XCNT(j)  (256  + 64 * (j))
#define XB_XSUB(j)  (1280 + 64 * (j))
#define XB_XGEN(j)  (2304 + 64 * (j))
#define XB_TOP      3328
#define XB_TOPGEN   3392
#define XCD_BAR_WORDS 3456
#define XB_SPIN_CAP (1u << 18)

__device__ __forceinline__ unsigned xb_ld(unsigned* p)              { return __hip_atomic_load(p, __ATOMIC_RELAXED, __HIP_MEMORY_SCOPE_AGENT); }
__device__ __forceinline__ unsigned xb_add(unsigned* p, unsigned v) { return __hip_atomic_fetch_add(p, v, __ATOMIC_RELAXED, __HIP_MEMORY_SCOPE_AGENT); }
__device__ __forceinline__ unsigned xb_xcc_id() { return (unsigned)__builtin_amdgcn_s_getreg((3 << 11) | 20) & 0xFu; }
#define XB_SPIN(cond, bar) do { unsigned _sp = 0; while (cond) { __builtin_amdgcn_s_sleep(1); \
    if ((++_sp & 255u) == 0u) { if (xb_ld(&(bar)[XB_TMO])) break; if (_sp > XB_SPIN_CAP) { atomicAdd(&(bar)[XB_TMO], 1u); break; } } } } while (0)

struct XcdBarrier {
    unsigned* bar; unsigned x;
    volatile LAS unsigned* st;
};

__device__ __forceinline__ XcdBarrier xcd_barrier_post(unsigned* bar, volatile LAS unsigned* st) {
    XcdBarrier b; b.bar = bar; b.x = xb_xcc_id(); b.st = st;
    if (threadIdx.x == 0) (void)xb_add(&bar[XB_XCNT(b.x)], 1u);
    return b;
}
__device__ __forceinline__ void xcd_barrier_complete(unsigned* bar, unsigned x, unsigned& nloc, unsigned& nx) {
    const unsigned G = gridDim.x * gridDim.y * gridDim.z;
    unsigned sum, cnt, mine, sp = 0u;
    for (;;) {
        sum = 0u; cnt = 0u; mine = 0u;
#pragma unroll
        for (unsigned j = 0; j < 16; ++j) { const unsigned c = xb_ld(&bar[XB_XCNT(j)]); sum += c; cnt += (c > 0u) ? 1u : 0u; mine = (j == x) ? c : mine; }
        if (sum == G) break;
        __builtin_amdgcn_s_sleep(1);
        if ((++sp & 255u) == 0u) { if (xb_ld(&bar[XB_TMO])) break; if (sp > XB_SPIN_CAP) { atomicAdd(&bar[XB_TMO], 1u); break; } }
    }
    nloc = mine > 0u ? mine : 1u; nx = cnt > 0u ? cnt : 1u;
}

__device__ __forceinline__ void xcd_barrier(const XcdBarrier& b) {
    asm volatile("s_waitcnt vmcnt(0)" ::: "memory");
    __syncthreads();
    if (threadIdx.x == 0) {
        unsigned* bar = b.bar;
        __builtin_amdgcn_s_waitcnt(0);
        unsigned nloc = b.st[0], nx = b.st[1];
        if (nloc == 0u) { xcd_barrier_complete(bar, b.x, nloc, nx); b.st[0] = nloc; b.st[1] = nx; }
        const unsigned old = xb_add(&bar[XB_XSUB(b.x)], 1u);
        const unsigned gen = old / nloc;
        if (old + 1u == (gen + 1u) * nloc) {
            __builtin_amdgcn_fence(__ATOMIC_RELEASE, "agent");
            asm volatile("s_waitcnt vmcnt(0)" ::: "memory");
            const unsigned og = xb_add(&bar[XB_TOP], 1u);
            const unsigned tg = og / nx;
            if (og + 1u == (tg + 1u) * nx) xb_add(&bar[XB_TOPGEN], 1u);
            else XB_SPIN(xb_ld(&bar[XB_TOPGEN]) == tg, bar);
            __builtin_amdgcn_fence(__ATOMIC_ACQUIRE, "agent");
            xb_add(&bar[XB_XGEN(b.x)], 1u);
            asm volatile("s_waitcnt vmcnt(0)" ::: "memory");
        } else {
            XB_SPIN(xb_ld(&bar[XB_XGEN(b.x)]) == gen, bar);
            __builtin_amdgcn_fence(__ATOMIC_ACQUIRE, "agent");
            asm volatile("s_waitcnt vmcnt(0)" ::: "memory");
        }
    }
    __syncthreads();
}
typedef float f32x2 __attribute__((ext_vector_type(2)));
typedef unsigned u32x2 __attribute__((ext_vector_type(2)));
__device__ __forceinline__ float wave_sum(float v) {
#pragma unroll
    for (int o = 1; o < 64; o <<= 1) v += __shfl_xor(v, o);
    return v;
}
__device__ __forceinline__ float bf_lo(unsigned u) { return __builtin_bit_cast(float, u << 16); }
__device__ __forceinline__ float bf_hi(unsigned u) { return __builtin_bit_cast(float, u & 0xffff0000u); }
__device__ __forceinline__ float sigmoidf_(float v) { return 1.f / (1.f + expf(-v)); }
__device__ __forceinline__ float siluf_(float v) { return v / (1.f + expf(-v)); }
__device__ __forceinline__ float softplusf_(float v) { return fmaxf(v, 0.f) + log1pf(expf(-fabsf(v))); }

__device__ __forceinline__ void ph_ada(const float* c, const float* c_ctx, const float* w_ada, const float* b_ada, float* ADA, LAS float* sf, int tid, int lane, int wave) {
    if ((int)blockIdx.x >= 192) return;
    for (int i = tid; i < 3 * 2048; i += NTHREADS) { const float v = (i < 4096) ? c[i] : c_ctx[i - 4096]; sf[i] = siluf_(v); }
    __syncthreads();
    for (int task = blockIdx.x; task < 192; task += gridDim.x) {
        const int r4 = lane >> 4, c4 = lane & 15;
        const float* wp = w_ada + (size_t)(wave * 256 + r4) * 12288 + task * 64 + 4 * c4;
        f32x4 a0 = {0.f, 0.f, 0.f, 0.f}, a1 = a0, a2 = a0;
#pragma unroll 1
        for (int jb = 0; jb < 64; jb += 16) { f32x4 w[16];
#pragma unroll
            for (int j = 0; j < 16; ++j) w[j] = *(const f32x4*)(wp + (size_t)(4 * (jb + j)) * 12288);
#pragma unroll
            for (int j = 0; j < 16; ++j) { const int kk = wave * 256 + 4 * (jb + j) + r4; a0 += w[j] * sf[kk]; a1 += w[j] * sf[2048 + kk]; a2 += w[j] * sf[4096 + kk]; } }
#pragma unroll
        for (int q = 0; q < 4; ++q) { a0[q] += __shfl_xor(a0[q], 16); a0[q] += __shfl_xor(a0[q], 32); a1[q] += __shfl_xor(a1[q], 16); a1[q] += __shfl_xor(a1[q], 32); a2[q] += __shfl_xor(a2[q], 16); a2[q] += __shfl_xor(a2[q], 32); }
        LAS float* red = sf + 6144;
        if (r4 == 0) { *(LAS f32x4*)(red + (wave * 3 + 0) * 64 + 4 * c4) = a0; *(LAS f32x4*)(red + (wave * 3 + 1) * 64 + 4 * c4) = a1; *(LAS f32x4*)(red + (wave * 3 + 2) * 64 + 4 * c4) = a2; }
        __syncthreads();
        if (tid < 192) { const int r = tid >> 6, l = tid & 63; float s = 0.f;
#pragma unroll
            for (int w = 0; w < 8; ++w) s += red[(w * 3 + r) * 64 + l];
            ADA[r * 12288 + task * 64 + l] = s + b_ada[task * 64 + l]; }
        __syncthreads();
    }
}
__device__ __forceinline__ int rowmap(int n, int mode, int s128, int off) {
    if (mode == 0) return (n >> 7) * s128 + (n & 127) + off;
    if (n < 3072) return n;
    if (n < 3088) return 7168 + (n - 3072);
    if (n < 7184) return n - 16;
    return n;
}
__device__ __forceinline__ void transpose_item(const float* W, int K, int N, bf16* WT, int mode, int s128, int off, LAS float* scr, int item, int lane) {
    const int nblk = (N + 31) >> 5, kb = item / nblk, nb = item - kb * nblk, k0 = 64 * kb, n0 = 32 * nb;
    const int nn = n0 + (lane & 31); const bool ok = nn < N;
#pragma unroll 8
    for (int i = 0; i < 32; ++i) { const int kk = 2 * i + (lane >> 5); scr[kk * 33 + (lane & 31)] = ok ? W[(size_t)(k0 + kk) * N + nn] : 0.f; }
    LDS_WAIT(); asm volatile("" ::: "memory");
    const int cc = lane & 7;
#pragma unroll
    for (int j = 0; j < 4; ++j) { const int n = (lane >> 3) + 8 * j;
        if (n0 + n < N) { const LAS float* s = scr + (8 * cc) * 33 + n;
            v4u o; o.x = pk2(s[0 * 33], s[1 * 33]); o.y = pk2(s[2 * 33], s[3 * 33]); o.z = pk2(s[4 * 33], s[5 * 33]); o.w = pk2(s[6 * 33], s[7 * 33]);
            *(GAS v4u*)(WT + (size_t)rowmap(n0 + n, mode, s128, off) * K + k0 + 8 * cc) = o; } }
    LDS_WAIT(); asm volatile("" ::: "memory");
}
struct T64Src { const float* W; bf16* WT; int K, N, mode, s128, off, item; };
__device__ __forceinline__ void tile64_load(const T64Src& S, int lane, f32x4 (&v)[16]) {
    const int nblk = S.N >> 6, kb = S.item / nblk, nb = S.item - kb * nblk;
    const float* src = S.W + (size_t)(64 * kb + (lane >> 4)) * S.N + 64 * nb + 4 * (lane & 15);
#pragma unroll
    for (int j = 0; j < 16; ++j) v[j] = *(const f32x4*)(src + (size_t)(4 * j) * S.N);
}
__device__ __forceinline__ void tile64_finish(const T64Src& S, int lane, const f32x4 (&v)[16], LAS unsigned char* tile) {
    const int nblk = S.N >> 6, kb = S.item / nblk, nb = S.item - kb * nblk, k0 = 64 * kb, n0 = 64 * nb;
#pragma unroll
    for (int j = 0; j < 16; ++j) { u32x2 w; w.x = pg8::cvt_pk_bf16(v[j][0], v[j][1]); w.y = pg8::cvt_pk_bf16(v[j][2], v[j][3]);
        *(LAS u32x2*)(tile + (4 * j + (lane >> 4)) * 144 + (lane & 15) * 8) = w; }
    LDS_WAIT(); asm volatile("" ::: "memory");
    const int g = lane >> 4, li = lane & 15, q4 = li >> 2, p4 = li & 3, gi = g >> 1, gp = g & 1;
    const LAS unsigned char* tp0 = tile + (8 * (4 * gp + p4) + q4) * 144 + (4 * gi) * 2;
#pragma unroll
    for (int ib = 0; ib < 8; ++ib) {
        const bf16x8 o = cat8(tr16(tp0 + 16 * ib), tr16(tp0 + 16 * ib + 4 * 144));
        const int n = n0 + 8 * ib + 4 * gi + (li & 3);
        *(bf16x8*)(S.WT + (size_t)rowmap(n, S.mode, S.s128, S.off) * S.K + k0 + 8 * (4 * gp + (li >> 2))) = o; }
    LDS_WAIT(); asm volatile("" ::: "memory");
}
__device__ __forceinline__ T64Src expert_item(const float* w1, const float* w3, const float* w2, unsigned char* ws, int it) {
    constexpr int I_E = 32 * 12, I_E2 = 12 * 32;
    bf16* W13T = (bf16*)(ws + WS_W13); bf16* W2T = (bf16*)(ws + WS_W2);
    const int e = it / (2 * I_E + I_E2); int r = it - e * (2 * I_E + I_E2);
    T64Src S;
    if (r < I_E) { S.W = w1 + (size_t)e * 2048 * 768; S.WT = W13T + (size_t)e * 1536 * 2048; S.K = 2048; S.N = 768; S.mode = 0; S.s128 = 256; S.off = 0; S.item = r; }
    else if (r < 2 * I_E) { S.W = w3 + (size_t)e * 2048 * 768; S.WT = W13T + (size_t)e * 1536 * 2048; S.K = 2048; S.N = 768; S.mode = 0; S.s128 = 256; S.off = 128; S.item = r - I_E; }
    else { S.W = w2 + (size_t)e * 768 * 2048; S.WT = W2T + (size_t)e * 2048 * 768; S.K = 768; S.N = 2048; S.mode = 0; S.s128 = 128; S.off = 0; S.item = r - 2 * I_E; }
    return S;
}
__device__ __forceinline__ void ph_transposes_experts(const float* w1, const float* w3, const float* w2, unsigned char* ws, LAS unsigned char* lds, int gw, int NGW, int wave, int lane) {
    asm volatile("" : "+v"(lane));
    LAS unsigned char* tile = lds + wave * 9216;
    constexpr int NIT = 32 * (2 * 32 * 12 + 12 * 32);
    f32x4 va[16], vb[16];
    int it = gw;
    if (it >= NIT) return;
    T64Src A = expert_item(w1, w3, w2, ws, it), B = A;
    tile64_load(A, lane, va);
    for (;;) {
        const bool hb = it + NGW < NIT;
        if (hb) { B = expert_item(w1, w3, w2, ws, it + NGW); tile64_load(B, lane, vb); }
        tile64_finish(A, lane, va, tile);
        if (!hb) break;
        it += 2 * NGW;
        const bool ha = it < NIT;
        if (ha) { A = expert_item(w1, w3, w2, ws, it); tile64_load(A, lane, va); }
        tile64_finish(B, lane, vb, tile);
        if (!ha) break;
    }
}

__device__ __forceinline__ T64Src io_item(const float* w_in, const float* w_out, unsigned char* ws, int it) {
    T64Src S; constexpr int I_IN = 32 * 112;
    if (it < I_IN) { S.W = w_in; S.WT = (bf16*)(ws + WS_WIN); S.K = 2048; S.N = DIN; S.mode = 1; S.s128 = 0; S.off = 0; S.item = it; }
    else { S.W = w_out; S.WT = (bf16*)(ws + WS_WOUT); S.K = 2048; S.N = 2048; S.mode = 0; S.s128 = 128; S.off = 0; S.item = it - I_IN; }
    return S;
}
__device__ __forceinline__ void ph_transposes_io(const float* w_in, const float* w_out, unsigned char* ws, LAS unsigned char* lds, int gw, int NGW, int wave, int lane) {
    LAS unsigned char* tile = lds + wave * 9216;
    constexpr int NIT = 32 * 112 + 32 * 32;
    f32x4 va[16], vb[16];
    int it = gw;
    if (it < NIT) {
        T64Src A = io_item(w_in, w_out, ws, it), B = A;
        tile64_load(A, lane, va);
        for (;;) {
            const bool hb = it + NGW < NIT;
            if (hb) { B = io_item(w_in, w_out, ws, it + NGW); tile64_load(B, lane, vb); }
            tile64_finish(A, lane, va, tile);
            if (!hb) break;
            it += 2 * NGW;
            const bool ha = it < NIT;
            if (ha) { A = io_item(w_in, w_out, ws, it); tile64_load(A, lane, va); }
            tile64_finish(B, lane, vb, tile);
            if (!ha) break;
        }
    }
    LAS float* scr = (LAS float*)(lds + 73728 + wave * 8448);
    for (int t = gw; t < 64; t += NGW) transpose_item(w_in, 2048, DIN, (bf16*)(ws + WS_WIN), 1, 0, 0, scr, (t >> 1) * 226 + 224 + (t & 1), lane);
}
__device__ __forceinline__ void ph_norm1(const float* x, const float* ctx, const float* g1, const float* ADA, bf16* HL, int gw, int NGW, int lane) {
    for (int row = gw; row < MT; row += NGW) {
        const float* src = row < ML ? x + (size_t)row * DM : ctx + (size_t)(row - ML) * DM;
        const float* sh = ADA + (size_t)(row < ML ? row / SEQ : 2) * 12288; const float* sc = sh + 2048;
        f32x4 v[8]; float s = 0.f;
#pragma unroll
        for (int j = 0; j < 8; ++j) { v[j] = ((const f32x4*)src)[lane + 64 * j]; s += (v[j].x * v[j].x + v[j].y * v[j].y) + (v[j].z * v[j].z + v[j].w * v[j].w); }
        const float rstd = 1.f / sqrtf(wave_sum(s) * (1.f / DM) + EPSF);
        unsigned long long* o8 = (unsigned long long*)(HL + (size_t)row * DM) + lane;
#pragma unroll
        for (int j = 0; j < 8; ++j) { const int col = 4 * (lane + 64 * j);
            const f32x4 g = *(const f32x4*)(g1 + col), a = *(const f32x4*)(sc + col), b = *(const f32x4*)(sh + col);
            const f32x4 o = (v[j] * rstd) * g * (a + 1.f) + b;
            o8[64 * j] = (unsigned long long)pk2(o.x, o.y) | ((unsigned long long)pk2(o.z, o.w) << 32); }
    }
}

__device__ __forceinline__ float silu_fast(float v) { return v * __builtin_amdgcn_rcpf(1.f + __expf(-v)); }
__device__ __forceinline__ void ph_prep(const bf16* Z, const float* GF, const float* w_conv, const float* b_gate, const float* a_log, const float* dt_bias,
                                        bf16* GQ, bf16* GK, bf16* GV, float* MLG, float* GDG, int tid, int lane, int gw, int NGW) {
    for (int it = gw; it < 264 * 24 * 2; it += NGW) {
        const int ci = it / 48, rem = it - ci * 48, gi = rem >> 1, half = rem & 1;
        int rowbase, tlo, thi, t0;
        if (ci < 256) { rowbase = (ci >> 7) * SEQ + (ci & 127) * 64; tlo = 0; thi = 64; t0 = 0; }
        else { const int cc = ci - 256; rowbase = ML + (cc >> 2) * CTXL; tlo = 0; thi = 256; t0 = (cc & 3) * 64; }
        const int type = gi >> 3, head = gi & 7, ch = type * 1024 + head * 128 + 2 * lane;
        float w0[5], w1[5];
#pragma unroll
        for (int j = 0; j < 5; ++j) { w0[j] = w_conv[j * 3072 + ch]; w1[j] = w_conv[j * 3072 + ch + 1]; }
        bf16* dst = (type == 0 ? GQ : (type == 1 ? GK : GV)) + head * 128 + 2 * lane;
        const float qs = type == 0 ? 0.08838834764831845f : 1.f;
#pragma unroll 1
        for (int sub = 2 * half; sub < 2 * half + 2; ++sub) {
            unsigned zr[20];
#pragma unroll
            for (int i = 0; i < 20; ++i) { const int t = t0 + sub * 16 + i - 2; zr[i] = (t >= tlo && t < thi) ? *(const unsigned*)(Z + (size_t)(rowbase + t) * Z2LD + ch) : 0u; }
            float o0[16], o1[16];
#pragma unroll
            for (int i = 0; i < 16; ++i) { float a0 = 0.f, a1 = 0.f;
#pragma unroll
                for (int j = 0; j < 5; ++j) { a0 += w0[j] * bf_lo(zr[i + j]); a1 += w1[j] * bf_hi(zr[i + j]); }
                o0[i] = silu_fast(a0); o1[i] = silu_fast(a1); }
            if (type < 2) {
#pragma unroll
                for (int i = 0; i < 16; ++i) { const float ss = wave_sum(o0[i] * o0[i] + o1[i] * o1[i]); const float sc = qs * __builtin_amdgcn_rsqf(ss + EPSF); o0[i] *= sc; o1[i] *= sc; } }
#pragma unroll
            for (int i = 0; i < 16; ++i) *(unsigned*)(dst + (size_t)(rowbase + t0 + sub * 16 + i) * 1024) = pk2(o0[i], o1[i]);
        }
    }
    const int gt = blockIdx.x * NTHREADS + (int)threadIdx.x, NGT = gridDim.x * NTHREADS;
    for (int e = gt; e < MT * 48; e += NGT) {
        const int row = e / 48, idx = e - row * 48; const float v = GF[(size_t)row * GFLD + idx];
        if (idx < 16) { float p = v + b_gate[idx]; p = 15.f * tanhf(p * (1.f / 15.f)); const int type = (idx >> 2) & 1;
            MLG[(size_t)row * 16 + idx] = type == 0 ? p : -softplusf_(-p); }
        else if (idx < 32) { const int j = idx - 16; GDG[(size_t)row * 32 + j] = -expf(a_log[j]) * softplusf_(v + dt_bias[j]); }
        else { const int j = idx - 32; GDG[(size_t)row * 32 + 16 + j] = sigmoidf_(v); }
    }
}
constexpr int NCH = 132;
constexpr float QSCALE = 0.08838834764831845f;
__device__ __forceinline__ int chunk_row0(int b, int c) { return c < 4 ? ML + b * CTXL + c * 64 : b * SEQ + (c - 4) * 64; }
__device__ __forceinline__ int chunk_of(int idx, int d) { return d == 0 ? idx : (idx < 4 ? 3 - idx : 135 - idx); }
__device__ __forceinline__ float wave_incl_scan(float v, int lane) {
#pragma unroll
    for (int o = 1; o < 64; o <<= 1) { const float t = __shfl_up(v, o); if (lane >= o) v += t; }
    return v;
}
__device__ __forceinline__ void mlstm_prep_task(int mt, const bf16* Z, const float* GF, const float* b_gate, bf16* MS, float* MSC, LAS float* sf, int tid, int lane, int wave) {
    const int bh = mt / NCH, c = mt - bh * NCH, b = bh >> 2, h = bh & 3, row0 = chunk_row0(b, c);
    LAS float* bq = sf; LAS float* lis = sf + 128;
    __syncthreads();
    if (tid < 128) { const int d = tid >> 6, r = d ? 63 - lane : lane;
        float pf = GF[(size_t)(row0 + r) * GFLD + d * 8 + 4 + h] + b_gate[d * 8 + 4 + h], pi = GF[(size_t)(row0 + r) * GFLD + d * 8 + h] + b_gate[d * 8 + h];
        pf = 15.f * tanhf(pf * (1.f / 15.f)); pi = 15.f * tanhf(pi * (1.f / 15.f));
        const float lfv = -softplusf_(-pf), liv = pi;
        const float bc = wave_incl_scan(lfv, lane), bl = __shfl(bc, 63);
        bq[d * 64 + r] = bc; lis[d * 64 + r] = liv;
        float* sc = MSC + ((size_t)mt * 2 + d) * 192;
        sc[r] = __expf(bl - bc + liv); sc[64 + r] = QSCALE * __expf(bc); if (lane == 0) sc[128] = __expf(bl); }
    __syncthreads();
    const int g = lane >> 4, li = lane & 15, tm = wave >> 1;
    const bf16* Kp = Z + (size_t)(row0 + 16 * tm + li) * Z1LD + ZC_MK + h * 128 + 8 * g;
    bf16x8 ka[4];
#pragma unroll
    for (int ks = 0; ks < 4; ++ks) ka[ks] = *(const bf16x8*)(Kp + 32 * ks);
#pragma unroll
    for (int tt = 0; tt < 2; ++tt) { const int tn = 2 * (wave & 1) + tt;
        const bf16* Qp = Z + (size_t)(row0 + 16 * tn + li) * Z1LD + ZC_MQ + h * 128 + 8 * g;
        f32x4 acc = {0.f, 0.f, 0.f, 0.f};
#pragma unroll
        for (int ks = 0; ks < 4; ++ks) acc = MFMA16(ka[ks], *(const bf16x8*)(Qp + 32 * ks), acc);
        const int r = 16 * tn + li, s0 = 16 * tm + 4 * g;
#pragma unroll
        for (int d = 0; d < 2; ++d) { float o[4]; const float br = bq[d * 64 + r];
#pragma unroll
            for (int q = 0; q < 4; ++q) { const int s = s0 + q; const bool ok = d == 0 ? (s <= r) : (s >= r);
                o[q] = ok ? acc[q] * QSCALE * __expf(br - bq[d * 64 + s] + lis[d * 64 + s]) : 0.f; }
            u32x2 w; w.x = pg8::cvt_pk_bf16(o[0], o[1]); w.y = pg8::cvt_pk_bf16(o[2], o[3]);
            *(u32x2*)(MS + (((size_t)mt * 2 + d) * 64 + r) * 64 + s0) = w; }
    }
}
constexpr int MQP = 288, MSP = 160, MQ_OFF = 0, MK_OFF = 18432, MV_OFF = 35840, MSS_OFF = 45056, ME_OFF = 55296, MSTAGE = 56320;
struct MlCtx { const bf16* Z; const bf16* MS; const float* MSC; bf16* MOR; float* DEN; int b, h, d, bh, v0, slice; };
template <int wv> __device__ __forceinline__ void ml_issue(const MlCtx& X, int idx, int lane, v4u (&buf)[16], f32x4& ev) {
    const int cn = chunk_of(idx, X.d), mt = X.bh * NCH + cn, row0 = chunk_row0(X.b, cn);
    const float* sc = X.MSC + ((size_t)mt * 2 + X.d) * 192;
    const char* zrow = (const char*)(X.Z + (size_t)row0 * Z1LD);
    const unsigned o16 = (unsigned)(lane >> 4) * (Z1LD * 2) + (unsigned)(lane & 15) * 16, o8r = (unsigned)(lane >> 3) * (Z1LD * 2) + (unsigned)(lane & 7) * 16, ol = (unsigned)lane * 16;
    const char* bQ = zrow + (ZC_MQ + X.h * 128) * 2; const char* bK = zrow + (ZC_MK + X.h * 128) * 2; const char* bV = zrow + (ZC_MV + X.h * 256 + X.v0) * 2; const char* bS = (const char*)(X.MS + ((size_t)mt * 2 + X.d) * 4096);
#pragma unroll
    for (int i = 0; i < 16; ++i) { const int pb = 64 * (wv + 3 * i);
        const char* base = pb < 1024 ? bQ + (size_t)(pb >> 4) * (Z1LD * 2) : (pb < 2048 ? bK + (size_t)((pb - 1024) >> 4) * (Z1LD * 2) : (pb < 2560 ? bV + (size_t)((pb - 2048) >> 3) * (Z1LD * 2) : bS + (size_t)(pb - 2560) * 16));
        buf[i] = *(const v4u*)(base + (pb < 2048 ? o16 : (pb < 2560 ? o8r : ol))); }
    ev = (f32x4){sc[lane], sc[64 + lane], sc[128], 0.f};
}
template <int wv> __device__ __forceinline__ void ml_store(LAS unsigned char* st, int lane, const v4u (&buf)[16], const f32x4 ev) {
    const unsigned l16 = (unsigned)(lane >> 4) * 272 + (unsigned)(lane & 15) * 16, l8 = (unsigned)(lane >> 3) * 144 + (unsigned)(lane & 7) * 16, l8s = (unsigned)(lane >> 3) * MSP + (unsigned)(lane & 7) * 16;
    const unsigned m16 = (unsigned)(lane & 15), lq = (unsigned)(lane >> 4) * MQP + 64 * (m16 >> 2) + 32 * (m16 & 1) + 8 * ((m16 >> 1) & 1);
#pragma unroll
    for (int i = 0; i < 16; ++i) { const int pb = 64 * (wv + 3 * i);
        if (pb < 1024) { LAS unsigned char* q = st + MQ_OFF + (pb >> 4) * MQP + lq; u32x2 lo, hi; lo.x = buf[i].x; lo.y = buf[i].y; hi.x = buf[i].z; hi.y = buf[i].w; *(LAS u32x2*)q = lo; *(LAS u32x2*)(q + 16) = hi; }
        else { const unsigned uo = pb < 2048 ? (unsigned)(MK_OFF + ((pb - 1024) >> 4) * 272) : (pb < 2560 ? (unsigned)(MV_OFF + ((pb - 2048) >> 3) * 144) : (unsigned)(MSS_OFF + ((pb - 2560) >> 3) * MSP));
            *(LAS v4u*)(st + uo + (pb < 2048 ? l16 : (pb < 2560 ? l8 : l8s))) = buf[i]; } }
    if (wv == 0) { LAS float* e = (LAS float*)(st + ME_OFF); e[lane] = ev[1]; e[128 + lane] = ev[0]; if (lane == 0) e[64] = ev[2]; }
}
template <int MODE> __device__ __forceinline__ void ml_compute(const MlCtx& X, int idx, const LAS unsigned char* st, int lane, int wave, f32x4 (&CT)[8], bf16x8 (&Cb)[4]) {
    const int g = lane >> 4, li = lane & 15, q4 = li >> 2, p4 = li & 3;
    const int c = chunk_of(idx, X.d), row0 = chunk_row0(X.b, c), d = X.d, h = X.h;
    const LAS float* ep = (const LAS float*)(st + ME_OFF);
    bf16x8 Vf[2], Vw[2];
#pragma unroll
    for (int s2 = 0; s2 < 2; ++s2) {
        const f32x4 ea0 = *(const LAS f32x4*)(ep + 128 + 32 * s2 + 8 * g), ea1 = *(const LAS f32x4*)(ep + 128 + 32 * s2 + 8 * g + 4);
        if (wave < 4) { const LAS unsigned char* vp = st + MV_OFF + (32 * s2 + 8 * g + q4) * 144 + (16 * wave + 4 * p4) * 2;
            const v4i16_t lo = tr16(vp), hi = tr16(vp + 4 * 144); Vf[s2] = cat8(lo, hi);
            const f32x4 a = {bf_lo((unsigned)(unsigned short)lo[0]), bf_lo((unsigned)(unsigned short)lo[1]), bf_lo((unsigned)(unsigned short)lo[2]), bf_lo((unsigned)(unsigned short)lo[3])};
            const f32x4 b2 = {bf_lo((unsigned)(unsigned short)hi[0]), bf_lo((unsigned)(unsigned short)hi[1]), bf_lo((unsigned)(unsigned short)hi[2]), bf_lo((unsigned)(unsigned short)hi[3])};
            Vw[s2] = packacc(a * ea0, b2 * ea1);
        } else { const short one = li == 0 ? (short)0x3f80 : (short)0; Vf[s2] = (bf16x8){one, one, one, one, one, one, one, one};
            const f32x4 z = {0.f, 0.f, 0.f, 0.f}; Vw[s2] = li == 0 ? packacc(ea0, ea1) : packacc(z, z); }
    }
    __builtin_amdgcn_sched_barrier(0);
    if (c >= 4) {
        f32x4 num[4], e4[4]; bf16x8 qf[4][4], sfr[4][2];
#pragma unroll
        for (int t = 0; t < 4; ++t) { const LAS unsigned char* qp = st + MQ_OFF + (16 * t + li) * MQP + 16 * g;
#pragma unroll
            for (int ks = 0; ks < 4; ++ks) qf[t][ks] = *(const LAS bf16x8*)(qp + 64 * ks);
            const LAS unsigned char* sp = st + MSS_OFF + (16 * t + li) * MSP + (8 * g) * 2;
            sfr[t][0] = *(const LAS bf16x8*)(sp); sfr[t][1] = *(const LAS bf16x8*)(sp + 64);
            e4[t] = *(const LAS f32x4*)(ep + 16 * t + 4 * g); num[t] = (f32x4){0.f, 0.f, 0.f, 0.f}; }
        __builtin_amdgcn_sched_barrier(0);
#pragma unroll
        for (int ks = 0; ks < 4; ++ks)
#pragma unroll
            for (int t = 0; t < 4; ++t) num[t] = MFMA16(qf[t][ks], Cb[ks], num[t]);
#pragma unroll
        for (int t = 0; t < 4; ++t) num[t] = num[t] * e4[t];
#pragma unroll
        for (int s2 = 0; s2 < 2; ++s2)
#pragma unroll
            for (int t = 0; t < 4; ++t) num[t] = MFMA16(sfr[t][s2], Vf[s2], num[t]);
        if (!(MODE & 4)) { asm volatile("" :: "v"(num[0]), "v"(num[1]), "v"(num[2]), "v"(num[3])); } else if (wave < 4) {
#pragma unroll
            for (int t = 0; t < 4; ++t)
#pragma unroll
                for (int q = 0; q < 4; ++q) *(LAS unsigned short*)((LAS unsigned char*)st + MV_OFF + (16 * t + 4 * g + q) * 144 + (16 * wave + li) * 2) = (unsigned short)f2bf(num[t][q]);
        } else if (X.slice == 0 && li == 0) {
#pragma unroll
            for (int t = 0; t < 4; ++t)
#pragma unroll
                for (int q = 0; q < 4; ++q) X.DEN[((size_t)d * ML + row0 + 16 * t + 4 * g + q) * 4 + h] = num[t][q];
        }
    }
    __builtin_amdgcn_sched_barrier(0);
    { const float dec = ep[64]; bf16x8 kf[8][2];
#pragma unroll
      for (int tk = 0; tk < 8; ++tk)
#pragma unroll
          for (int s2 = 0; s2 < 2; ++s2) { const LAS unsigned char* kp = st + MK_OFF + (32 * s2 + 8 * g + q4) * 272 + (16 * tk + 4 * p4) * 2; kf[tk][s2] = cat8(tr16(kp), tr16(kp + 4 * 272)); }
      __builtin_amdgcn_sched_barrier(0);
#pragma unroll
      for (int tk = 0; tk < 8; ++tk) CT[tk] = CT[tk] * dec;
#pragma unroll
      for (int s2 = 0; s2 < 2; ++s2)
#pragma unroll
          for (int tk = 0; tk < 8; ++tk) CT[tk] = MFMA16(kf[tk][s2], Vw[s2], CT[tk]);
    }
#pragma unroll
    for (int ks = 0; ks < 4; ++ks) Cb[ks] = packacc(CT[2 * ks], CT[2 * ks + 1]);
}
template <int WV> __device__ __forceinline__ void ml_flush(const MlCtx& X, int idx, const LAS unsigned char* st, int lane) {
    if (idx < 0 || idx >= NCH) return;
    const int c = chunk_of(idx, X.d); if (c < 4) return;
    const int row0 = chunk_row0(X.b, c);
#pragma unroll
    for (int i = 0; i < 16; ++i) { const int pb = 64 * (WV + 3 * i);
        if (pb >= 2048 && pb < 2560) { const int r = ((pb - 2048) >> 3) + (lane >> 3);
            const v4u o = *(const LAS v4u*)(st + MV_OFF + r * 144 + (lane & 7) * 16);
            *(v4u*)(X.MOR + ((size_t)X.d * ML + row0 + r) * 1024 + X.h * 256 + X.v0 + 8 * (lane & 7)) = o; } }
}
template <int MODE, int WV> __device__ __forceinline__ void ml_loader_loop(const MlCtx& X, LAS unsigned char* st0, LAS unsigned char* st1, int lane) {
    asm volatile("" : "+v"(lane));
    __builtin_amdgcn_s_setprio(3);
    v4u bufA[16], bufB[16]; f32x4 evA = {0.f, 0.f, 0.f, 0.f}, evB = evA;
    if (MODE & 1) { ml_issue<WV>(X, 0, lane, bufA, evA); ml_issue<WV>(X, 1, lane, bufB, evB); }
    for (int idx = -1; idx < NCH; idx += 2) {
        if (!(MODE & 1)) { LDS_BARRIER(); LDS_BARRIER(); continue; }
        if (MODE & 4) ml_flush<WV>(X, idx - 1, st0, lane);
        if (idx + 1 < NCH) ml_store<WV>(st0, lane, bufA, evA); if (idx + 3 < NCH) ml_issue<WV>(X, idx + 3, lane, bufA, evA);
        LDS_BARRIER();
        if (MODE & 4) ml_flush<WV>(X, idx, st1, lane);
        if (idx + 2 < NCH) ml_store<WV>(st1, lane, bufB, evB); if (idx + 4 < NCH) ml_issue<WV>(X, idx + 4, lane, bufB, evB);
        LDS_BARRIER();
    }
}
template <int MODE> __device__ __forceinline__ void mlstm_chunk_job(int job, const bf16* Z, const bf16* MS, const float* MSC, bf16* MOR, float* DEN, LAS unsigned char* lds, int tid, int lane, int wave) {
    const int seq = job & 15, slice = job >> 4;
    MlCtx X; X.Z = Z; X.MS = MS; X.MSC = MSC; X.MOR = MOR; X.DEN = DEN; X.b = seq >> 3; X.h = (seq >> 1) & 3; X.d = seq & 1; X.bh = X.b * 4 + X.h; X.v0 = slice * 64; X.slice = slice;
    LAS unsigned char* st0 = lds; LAS unsigned char* st1 = lds + MSTAGE;
    __syncthreads();
    if (wave >= 5) {
        if (wave == 5) ml_loader_loop<MODE, 0>(X, st0, st1, lane); else if (wave == 6) ml_loader_loop<MODE, 1>(X, st0, st1, lane); else ml_loader_loop<MODE, 2>(X, st0, st1, lane);
    } else {
        asm volatile("" : "+v"(lane));
        f32x4 CT[8]; bf16x8 Cb[4];
#pragma unroll
        for (int t = 0; t < 8; ++t) CT[t] = (f32x4){0.f, 0.f, 0.f, 0.f};
#pragma unroll
        for (int t = 0; t < 4; ++t) Cb[t] = (bf16x8){0, 0, 0, 0, 0, 0, 0, 0};
        LDS_BARRIER();
#pragma unroll 1
        for (int idx = 0; idx < NCH; ++idx) {
            if (MODE & 2) ml_compute<MODE>(X, idx, (idx & 1) ? st1 : st0, lane, wave, CT, Cb);
            LDS_BARRIER();
        }
        LDS_BARRIER();
    }
}
typedef float f32x16 __attribute__((ext_vector_type(16)));
constexpr int GP_Q = 0, GP_K = 17408, GP_V = 34816, GP_A = 52224, GP_M = 87040, GP_X = 95488, GP_S = 132352, AP = 68, AMD = 64 * AP;
__device__ __forceinline__ void gdn_prep_task(int gt, const bf16* Z2, const float* GF, const float* w_conv, const float* a_log, const float* dt_bias, bf16* GQ, bf16* GK, bf16* GW, bf16* GU, bf16* GA, float* GSC,
                                              LAS unsigned char* lds, int tid, int lane, int wave) {
    const int bh = gt / NCH, c = gt - bh * NCH, b = bh >> 3, h = bh & 7, row0 = chunk_row0(b, c);
    const int g = lane >> 4, li = lane & 15, q4 = li >> 2, p4 = li & 3;
    LAS float* Amat = (LAS float*)(lds + GP_A); LAS float* Mtmp = (LAS float*)(lds + GP_M);
    LAS float* gc = (LAS float*)(lds + GP_S); LAS float* be = gc + 128;
    __syncthreads();
    { const int rowbase = c < 4 ? ML + b * CTXL : row0, t0 = c < 4 ? c * 64 : 0, thi = c < 4 ? CTXL : 64;
      float w0[3][5], w1[3][5]; unsigned zr[3][12];
#pragma unroll
      for (int ty = 0; ty < 3; ++ty) { const int ch = ty * 1024 + h * 128 + 2 * lane;
#pragma unroll
          for (int j = 0; j < 5; ++j) { w0[ty][j] = w_conv[j * 3072 + ch]; w1[ty][j] = w_conv[j * 3072 + ch + 1]; }
#pragma unroll
          for (int i = 0; i < 12; ++i) { const int t = t0 + 8 * wave + i - 2; zr[ty][i] = (t >= 0 && t < thi) ? *(const unsigned*)(Z2 + (size_t)(rowbase + t) * Z2LD + ch) : 0u; } }
#pragma unroll
      for (int ty = 0; ty < 3; ++ty) {
#pragma unroll
          for (int i = 0; i < 8; ++i) { float o0 = 0.f, o1 = 0.f;
#pragma unroll
              for (int j = 0; j < 5; ++j) { o0 += w0[ty][j] * bf_lo(zr[ty][i + j]); o1 += w1[ty][j] * bf_hi(zr[ty][i + j]); }
              o0 = silu_fast(o0); o1 = silu_fast(o1);
              if (ty < 2) { const float ss = wave_sum(o0 * o0 + o1 * o1); const float sc = (ty == 0 ? 0.08838834764831845f : 1.f) * __builtin_amdgcn_rsqf(ss + EPSF); o0 *= sc; o1 *= sc; }
              const unsigned pk = pk2(o0, o1); const int r = 8 * wave + i;
              *(LAS unsigned*)(lds + ty * 17408 + r * 272 + lane * 4) = pk;
              if (ty == 0) *(unsigned*)(GQ + (size_t)(row0 + r) * 1024 + h * 128 + 32 * (lane >> 4) + 8 * ((lane & 7) >> 1) + 4 * ((lane >> 3) & 1) + 2 * (lane & 1)) = pk;
              else if (ty == 1) *(unsigned*)(GK + (size_t)(row0 + r) * 1024 + h * 128 + 2 * lane) = pk; } } }
    if (tid < 128) { const int d = tid >> 6, r = d ? 63 - lane : lane;
        const float gv = -expf(a_log[d * 8 + h]) * softplusf_(GF[(size_t)(row0 + r) * GFLD + 16 + d * 8 + h] + dt_bias[d * 8 + h]), bv = sigmoidf_(GF[(size_t)(row0 + r) * GFLD + 32 + d * 8 + h]);
        const float gcs = wave_incl_scan(gv, lane), gl = __shfl(gcs, 63);
        gc[d * 64 + r] = gcs; be[d * 64 + r] = bv;
        float* sc = GSC + ((size_t)gt * 2 + d) * 192; sc[r] = __expf(gcs); sc[64 + r] = __expf(gl - gcs); if (lane == 0) sc[128] = __expf(gl); }
    LDS_BARRIER();
    { const int tn = wave & 3, i = 16 * tn + li;
      bf16x8 kB[4], qB[4]; u32x2 wa[2][2];
#pragma unroll
      for (int ks = 0; ks < 4; ++ks) { kB[ks] = *(const LAS bf16x8*)(lds + GP_K + i * 272 + (32 * ks + 8 * g) * 2); qB[ks] = *(const LAS bf16x8*)(lds + GP_Q + i * 272 + (32 * ks + 8 * g) * 2); }
#pragma unroll
      for (int tt = 0; tt < 2; ++tt) { const int tm = 2 * (wave >> 2) + tt;
          f32x4 aKK = {0.f, 0.f, 0.f, 0.f}, aQK = aKK;
#pragma unroll
          for (int ks = 0; ks < 4; ++ks) { const bf16x8 kA = *(const LAS bf16x8*)(lds + GP_K + (16 * tm + li) * 272 + (32 * ks + 8 * g) * 2);
              aKK = MFMA16(kA, kB[ks], aKK); aQK = MFMA16(kA, qB[ks], aQK); }
          const int j0 = 16 * tm + 4 * g;
#pragma unroll
          for (int d = 0; d < 2; ++d) { const float gci = gc[d * 64 + i], bi = be[d * 64 + i]; const int pi = d ? 63 - i : i; float at[4];
#pragma unroll
              for (int q = 0; q < 4; ++q) { const int j = j0 + q, pj = d ? 63 - j : j; const bool strict = pj < pi, incl = pj <= pi;
                  const float e = incl ? __expf(gci - gc[d * 64 + j]) : 0.f;
                  Amat[d * AMD + pi * AP + pj] = strict ? bi * aKK[q] * e : 0.f;
                  at[q] = aQK[q] * e; }
              wa[d][tt].x = pg8::cvt_pk_bf16(at[0], at[1]); wa[d][tt].y = pg8::cvt_pk_bf16(at[2], at[3]); }
      }
#pragma unroll
      for (int d = 0; d < 2; ++d) { v4u w; w.x = wa[d][0].x; w.y = wa[d][0].y; w.z = wa[d][1].x; w.w = wa[d][1].y;
          *(v4u*)(GA + (((size_t)gt * 2 + d) * 64 + i) * 64 + 32 * (wave >> 2) + 8 * g) = w; } }
    LDS_BARRIER();
    if (wave < 4) { const int d = wave >> 1, blk = wave & 1, cc = lane & 31; LAS float* Ab = Amat + d * AMD + (32 * blk) * AP + 32 * blk;
        float X[32];
#pragma unroll
        for (int p = 0; p < 32; ++p) { f32x4 a4[8];
#pragma unroll
            for (int q = 0; q < (p + 3) / 4; ++q) a4[q] = *(const LAS f32x4*)(Ab + p * AP + 4 * q);
            float s0 = (p == cc) ? 1.f : 0.f, s1 = 0.f;
#pragma unroll
            for (int pp = 0; pp < p; ++pp) { if (pp & 1) s1 -= a4[pp >> 2][pp & 3] * X[pp]; else s0 -= a4[pp >> 2][pp & 3] * X[pp]; }
            X[p] = s0 + s1; }
        if (lane < 32) {
#pragma unroll
            for (int p = 0; p < 32; ++p) Ab[p * AP + cc] = X[p]; }
    }
    LDS_BARRIER();
    if (wave < 2) { const int d = wave, r32 = lane & 31, kk = lane >> 5; LAS float* Ad = Amat + d * AMD; LAS float* Md = Mtmp + d * 1056;
        f32x16 acc;
#pragma unroll
        for (int q = 0; q < 16; ++q) acc[q] = 0.f;
#pragma unroll
        for (int ks = 0; ks < 16; ++ks) acc = __builtin_amdgcn_mfma_f32_32x32x2f32(Ad[(32 + r32) * AP + 2 * ks + kk], Ad[(2 * ks + kk) * AP + r32], acc, 0, 0, 0);
#pragma unroll
        for (int q = 0; q < 16; ++q) Md[((q & 3) + 8 * (q >> 2) + 4 * kk) * 33 + r32] = acc[q];
#pragma unroll
        for (int q = 0; q < 16; ++q) acc[q] = 0.f;
#pragma unroll
        for (int ks = 0; ks < 16; ++ks) acc = __builtin_amdgcn_mfma_f32_32x32x2f32(Ad[(32 + r32) * AP + 32 + 2 * ks + kk], Md[(2 * ks + kk) * 33 + r32], acc, 0, 0, 0);
#pragma unroll
        for (int q = 0; q < 16; ++q) Ad[(32 + (q & 3) + 8 * (q >> 2) + 4 * kk) * AP + r32] = -acc[q];
    }
    LDS_BARRIER();
    { const int d = tid >> 8, i = (tid >> 2) & 63, jq = tid & 3, pi = d ? 63 - i : i; float xu[16], xw[16];
#pragma unroll
      for (int q = 0; q < 16; ++q) { const int j = 16 * jq + q, pj = d ? 63 - j : j; const float xv = Amat[d * AMD + pi * AP + pj] * be[d * 64 + j]; xu[q] = xv; xw[q] = xv * __expf(gc[d * 64 + j]); }
      LAS unsigned char* xo = lds + GP_X + (d * 2) * 9216 + i * 144 + jq * 32;
      v4u o; o.x = pk2(xu[0], xu[1]); o.y = pk2(xu[2], xu[3]); o.z = pk2(xu[4], xu[5]); o.w = pk2(xu[6], xu[7]); *(LAS v4u*)xo = o;
      o.x = pk2(xu[8], xu[9]); o.y = pk2(xu[10], xu[11]); o.z = pk2(xu[12], xu[13]); o.w = pk2(xu[14], xu[15]); *(LAS v4u*)(xo + 16) = o;
      o.x = pk2(xw[0], xw[1]); o.y = pk2(xw[2], xw[3]); o.z = pk2(xw[4], xw[5]); o.w = pk2(xw[6], xw[7]); *(LAS v4u*)(xo + 9216) = o;
      o.x = pk2(xw[8], xw[9]); o.y = pk2(xw[10], xw[11]); o.z = pk2(xw[12], xw[13]); o.w = pk2(xw[14], xw[15]); *(LAS v4u*)(xo + 9216 + 16) = o; }
    LDS_BARRIER();
    { const int d = wave >> 2, ti = wave & 3;
      const LAS unsigned char* xr = lds + GP_X + (d * 2) * 9216 + (16 * ti + li) * 144 + (8 * g) * 2;
      const bf16x8 xa0 = *(const LAS bf16x8*)xr, xa1 = *(const LAS bf16x8*)(xr + 64), xw0 = *(const LAS bf16x8*)(xr + 9216), xw1 = *(const LAS bf16x8*)(xr + 9216 + 64);
#pragma unroll 1
      for (int ts = 0; ts < 4; ++ts) { u32x2 ww[2];
#pragma unroll
        for (int hi = 0; hi < 2; ++hi) { const int tv = 2 * ts + hi;
          const LAS unsigned char* vp = lds + GP_V + (8 * g + q4) * 272 + (16 * tv + 4 * p4) * 2;
          f32x4 acc = {0.f, 0.f, 0.f, 0.f};
          acc = MFMA16(xa0, cat8(tr16(vp), tr16(vp + 4 * 272)), acc);
          acc = MFMA16(xa1, cat8(tr16(vp + 32 * 272), tr16(vp + 36 * 272)), acc);
          u32x2 w; w.x = pg8::cvt_pk_bf16(acc[0], acc[1]); w.y = pg8::cvt_pk_bf16(acc[2], acc[3]);
          *(u32x2*)(GU + (((size_t)gt * 2 + d) * 128 + 16 * tv + li) * 64 + 16 * ti + 4 * g) = w;
          const LAS unsigned char* kp = lds + GP_K + (8 * g + q4) * 272 + (16 * tv + 4 * p4) * 2;
          f32x4 acw = {0.f, 0.f, 0.f, 0.f};
          acw = MFMA16(cat8(tr16(kp), tr16(kp + 4 * 272)), xw0, acw);
          acw = MFMA16(cat8(tr16(kp + 32 * 272), tr16(kp + 36 * 272)), xw1, acw);
          ww[hi].x = pg8::cvt_pk_bf16(-acw[0], -acw[1]); ww[hi].y = pg8::cvt_pk_bf16(-acw[2], -acw[3]); }
        v4u w4; w4.x = ww[0].x; w4.y = ww[0].y; w4.z = ww[1].x; w4.w = ww[1].y;
        *(v4u*)(GW + (((size_t)gt * 2 + d) * 64 + 16 * ti + li) * 128 + 32 * ts + 8 * g) = w4;
      } }
}
constexpr int KP = 288, APITCH = 160, GS_W = 0, GS_Q = 18432, GS_K = 36864, GS_A = 55296, GS_U = 65536, GS_E = 74752, GSTAGE = 75280;
struct GdCtx { const bf16* GQ; const bf16* GK; const bf16* GW; const bf16* GU; const bf16* GA; const float* GSC; bf16* GO; int b, h, d, bh, c0; };
template <int wv> __device__ __forceinline__ void gd_issue(const GdCtx& X, int idx, int lane, v4u (&buf)[16], float& ev) {
    const int cn = chunk_of(idx, X.d), gt = X.bh * NCH + cn, row0 = chunk_row0(X.b, cn);
    const size_t td = (size_t)gt * 2 + X.d;
    const unsigned o16 = (unsigned)(lane >> 4) * 2048 + (unsigned)(lane & 15) * 16, ol = (unsigned)lane * 16;
    const char* bW = (const char*)(X.GW + td * 8192); const char* bQ = (const char*)(X.GQ + (size_t)row0 * 1024 + X.h * 128); const char* bK = (const char*)(X.GK + (size_t)row0 * 1024 + X.h * 128);
    const char* bA = (const char*)(X.GA + td * 4096); const char* bU = (const char*)(X.GU + (td * 128 + X.c0) * 64);
#pragma unroll
    for (int i = 0; i < 16; ++i) { const int pb = 64 * (wv < 3 ? (i < 14 ? wv + 4 * i : 3 + 8 * wv + 4 * (i - 14)) : (i < 8 ? 27 + 4 * i : 48 + i));
        const bool rowk = pb >= 1024 && pb < 3072;
        const char* base = pb < 1024 ? bW + (size_t)pb * 16 : (pb < 2048 ? bQ + (size_t)((pb - 1024) >> 4) * 2048 : (pb < 3072 ? bK + (size_t)((pb - 2048) >> 4) * 2048 : (pb < 3584 ? bA + (size_t)(pb - 3072) * 16 : bU + (size_t)(pb - 3584) * 16)));
        buf[i] = *(const v4u*)(base + (rowk ? o16 : ol)); }
    ev = X.GSC[td * 192 + (wv < 2 ? 64 * wv + lane : 128)];
}
template <int wv> __device__ __forceinline__ void gd_store(LAS unsigned char* st, int lane, const v4u (&buf)[16], float ev) {
    const unsigned l16 = (unsigned)(lane >> 4) * KP + (unsigned)(lane & 15) * 16, l8a = (unsigned)(lane >> 3) * APITCH + (unsigned)(lane & 7) * 16, l8 = (unsigned)(lane >> 3) * 144 + (unsigned)(lane & 7) * 16;
#pragma unroll
    for (int i = 0; i < 16; ++i) { const int pb = 64 * (wv < 3 ? (i < 14 ? wv + 4 * i : 3 + 8 * wv + 4 * (i - 14)) : (i < 8 ? 27 + 4 * i : 48 + i));
        const unsigned uo = pb < 3072 ? (unsigned)((pb >> 10) * 18432 + ((pb & 1023) >> 4) * KP) : (pb < 3584 ? (unsigned)(GS_A + ((pb - 3072) >> 3) * APITCH) : (unsigned)(GS_U + ((pb - 3584) >> 3) * 144));
        *(LAS v4u*)(st + uo + (pb < 3072 ? l16 : (pb < 3584 ? l8a : l8))) = buf[i]; }
    if (wv < 2) ((LAS float*)(st + GS_E))[64 * wv + lane] = ev; else if (wv == 2 && lane == 0) ((LAS float*)(st + GS_E))[128] = ev;
}
#define SCHED_FENCE() __builtin_amdgcn_sched_barrier(0)
#define LD16(p) (*(const LAS bf16x8*)(p))
template <int G> __device__ __forceinline__ void gd_ld(const LAS unsigned char* st, int g, int li, int q4, int p4, bf16x8 (&F)[4]) {
    if constexpr (G < 8) { constexpr int t = G >> 1, hf = G & 1;
        const LAS unsigned char* wp = st + GS_W + (16 * t + li) * KP + 16 * g + 128 * hf; const LAS unsigned char* qp = wp + (GS_Q - GS_W);
        F[0] = LD16(wp); F[1] = LD16(qp); F[2] = LD16(wp + 64); F[3] = LD16(qp + 64);
    } else if constexpr (G < 10) { constexpr int t0 = 2 * (G - 8);
        const LAS unsigned char* ap = st + GS_A + (16 * t0 + li) * APITCH + 16 * g;
        F[0] = LD16(ap); F[1] = LD16(ap + 16 * APITCH); F[2] = LD16(ap + 64); F[3] = LD16(ap + 16 * APITCH + 64);
    } else { constexpr int tk0 = 2 * (G - 10);
        const LAS unsigned char* kp = st + GS_K + (4 * g + q4) * KP + (16 * tk0 + 4 * p4) * 2;
        F[0] = cat8(tr16(kp), tr16(kp + 16 * KP)); F[1] = cat8(tr16(kp + 32), tr16(kp + 32 + 16 * KP)); F[2] = cat8(tr16(kp + 32 * KP), tr16(kp + 48 * KP)); F[3] = cat8(tr16(kp + 32 + 32 * KP), tr16(kp + 32 + 48 * KP));
    }
}
template <int MODE> __device__ __forceinline__ void gd_compute(const GdCtx& X, int idx, const LAS unsigned char* st, int lane, int wave, f32x4 (&S)[8], bf16x8 (&Sb)[4]) {
    const int g = lane >> 4, li = lane & 15, q4 = li >> 2, p4 = li & 3;
    const int c = chunk_of(idx, X.d);
    const LAS float* eg = (const LAS float*)(st + GS_E);
    bf16x8 F0[4], F1[4], F2[4];
    f32x4 vn[4], o1[4], o2[4], ed4[4], e4[4]; u32x2 uu[4]; bf16x8 vb0, vb1, vs0, vs1; float dec;
#define GD_WQ(G, F) { constexpr int t_ = (G) >> 1, hf_ = (G) & 1; \
        if (hf_ == 0) { vn[t_] = (f32x4){bf_lo(uu[t_].x), bf_hi(uu[t_].x), bf_lo(uu[t_].y), bf_hi(uu[t_].y)}; o1[t_] = (f32x4){0.f, 0.f, 0.f, 0.f}; } \
        vn[t_] = MFMA16(F[0], Sb[2 * hf_], vn[t_]); o1[t_] = MFMA16(F[1], Sb[2 * hf_], o1[t_]); vn[t_] = MFMA16(F[2], Sb[2 * hf_ + 1], vn[t_]); o1[t_] = MFMA16(F[3], Sb[2 * hf_ + 1], o1[t_]); }
#define GD_AT(G, F) { constexpr int t_ = 2 * ((G) - 8); o2[t_] = (f32x4){0.f, 0.f, 0.f, 0.f}; o2[t_ + 1] = o2[t_]; \
        o2[t_] = MFMA16(F[0], vb0, o2[t_]); o2[t_ + 1] = MFMA16(F[1], vb0, o2[t_ + 1]); o2[t_] = MFMA16(F[2], vb1, o2[t_]); o2[t_ + 1] = MFMA16(F[3], vb1, o2[t_ + 1]); }
#define GD_KT(G, F) { constexpr int k_ = 2 * ((G) - 10); S[k_] = S[k_] * dec; S[k_ + 1] = S[k_ + 1] * dec; \
        S[k_] = MFMA16(F[0], vs0, S[k_]); S[k_ + 1] = MFMA16(F[1], vs0, S[k_ + 1]); S[k_] = MFMA16(F[2], vs1, S[k_]); S[k_ + 1] = MFMA16(F[3], vs1, S[k_ + 1]); }
#pragma unroll
    for (int t = 0; t < 4; ++t) uu[t] = *(const LAS u32x2*)(st + GS_U + (16 * wave + li) * 144 + (16 * t + 4 * g) * 2);
    gd_ld<0>(st, g, li, q4, p4, F0); gd_ld<1>(st, g, li, q4, p4, F1);
    SCHED_FENCE();
    gd_ld<2>(st, g, li, q4, p4, F2); SCHED_FENCE(); GD_WQ(0, F0); SCHED_FENCE();
    gd_ld<3>(st, g, li, q4, p4, F0); SCHED_FENCE(); GD_WQ(1, F1); SCHED_FENCE();
    gd_ld<4>(st, g, li, q4, p4, F1); SCHED_FENCE(); GD_WQ(2, F2); SCHED_FENCE();
    gd_ld<5>(st, g, li, q4, p4, F2); SCHED_FENCE(); GD_WQ(3, F0); SCHED_FENCE();
    gd_ld<6>(st, g, li, q4, p4, F0); SCHED_FENCE(); GD_WQ(4, F1); SCHED_FENCE();
    gd_ld<7>(st, g, li, q4, p4, F1); SCHED_FENCE(); GD_WQ(5, F2); SCHED_FENCE();
    gd_ld<8>(st, g, li, q4, p4, F2);
#pragma unroll
    for (int t = 0; t < 4; ++t) ed4[t] = *(const LAS f32x4*)(eg + 64 + 16 * t + 4 * g);
    dec = eg[128];
    SCHED_FENCE(); GD_WQ(6, F0); SCHED_FENCE();
    gd_ld<9>(st, g, li, q4, p4, F0); SCHED_FENCE(); GD_WQ(7, F1); SCHED_FENCE();
    vb0 = packacc(vn[0], vn[1]); vb1 = packacc(vn[2], vn[3]);
    gd_ld<10>(st, g, li, q4, p4, F1);
#pragma unroll
    for (int t = 0; t < 4; ++t) e4[t] = *(const LAS f32x4*)(eg + 16 * t + 4 * g);
    SCHED_FENCE(); GD_AT(8, F2);
#pragma unroll
    for (int t = 0; t < 4; ++t) vn[t] = vn[t] * ed4[t];
    vs0 = packacc(vn[0], vn[1]); vs1 = packacc(vn[2], vn[3]);
    SCHED_FENCE();
    gd_ld<11>(st, g, li, q4, p4, F2); SCHED_FENCE(); GD_AT(9, F0); SCHED_FENCE();
    gd_ld<12>(st, g, li, q4, p4, F0); SCHED_FENCE(); GD_KT(10, F1);
    if (!(MODE & 4)) { asm volatile("" :: "v"(o1[0]), "v"(o1[1]), "v"(o1[2]), "v"(o1[3]), "v"(o2[0]), "v"(o2[1]), "v"(o2[2]), "v"(o2[3]), "v"(e4[0]), "v"(e4[1]), "v"(e4[2]), "v"(e4[3])); } else if (c >= 4) {
#pragma unroll
        for (int t = 0; t < 4; ++t) { const f32x4 o = o1[t] * e4[t] + o2[t];
            u32x2 w; w.x = pg8::cvt_pk_bf16(o[0], o[1]); w.y = pg8::cvt_pk_bf16(o[2], o[3]);
            *(LAS u32x2*)((LAS unsigned char*)st + GS_U + (16 * wave + li) * 144 + (16 * t + 4 * g) * 2) = w; } }
    SCHED_FENCE();
    gd_ld<13>(st, g, li, q4, p4, F1); SCHED_FENCE(); GD_KT(11, F2); SCHED_FENCE();
    GD_KT(12, F0); SCHED_FENCE();
    GD_KT(13, F1);
#pragma unroll
    for (int ks = 0; ks < 4; ++ks) Sb[ks] = packacc(S[2 * ks], S[2 * ks + 1]);
#undef GD_WQ
#undef GD_AT
#undef GD_KT
}
template <int WV> __device__ __forceinline__ void gd_flush(const GdCtx& X, int idx, const LAS unsigned char* st, int lane) {
    if (WV != 3) return;
    if (idx < 0 || idx >= NCH) return;
    const int c = chunk_of(idx, X.d); if (c < 4) return;
    const int row0 = chunk_row0(X.b, c), g = lane >> 4, li = lane & 15, q4 = li >> 2, p4 = li & 3, gi = g >> 1, gp = g & 1;
    const LAS unsigned char* tp0 = st + GS_U + (8 * (4 * gp + p4) + q4) * 144 + (4 * gi) * 2;
    bf16* dst0 = X.GO + ((size_t)X.d * ML + row0 + 4 * gi + (li & 3)) * 1024 + X.h * 128 + X.c0 + 8 * (4 * gp + (li >> 2));
#pragma unroll 1
    for (int ib = 0; ib < 8; ++ib) {
        const bf16x8 o = cat8(tr16(tp0 + 16 * ib), tr16(tp0 + 16 * ib + 4 * 144));
        *(bf16x8*)(dst0 + (size_t)(8 * ib) * 1024) = o; }
}
template <int MODE, int WV> __device__ __forceinline__ void gd_loader_loop(const GdCtx& X, LAS unsigned char* st0, LAS unsigned char* st1, int lane) {
    asm volatile("" : "+v"(lane));
    __builtin_amdgcn_s_setprio(3);
    v4u bufA[16], bufB[16]; float evA = 0.f, evB = 0.f;
    if (MODE & 1) { gd_issue<WV>(X, 0, lane, bufA, evA); gd_issue<WV>(X, 1, lane, bufB, evB); }
    for (int idx = -1; idx < NCH; idx += 2) {
        if (!(MODE & 1)) { LDS_BARRIER(); LDS_BARRIER(); continue; }
        if (MODE & 4) gd_flush<WV>(X, idx - 1, st0, lane);
        if (idx + 1 < NCH) gd_store<WV>(st0, lane, bufA, evA); if (idx + 3 < NCH) gd_issue<WV>(X, idx + 3, lane, bufA, evA);
        LDS_BARRIER();
        if (MODE & 4) gd_flush<WV>(X, idx, st1, lane);
        if (idx + 2 < NCH) gd_store<WV>(st1, lane, bufB, evB); if (idx + 4 < NCH) gd_issue<WV>(X, idx + 4, lane, bufB, evB);
        LDS_BARRIER();
    }
}
template <int MODE> __device__ __forceinline__ void gdn_chunk_job(int job, const bf16* GQ, const bf16* GK, const bf16* GW, const bf16* GU, const bf16* GA, const float* GSC, bf16* GO,
                                              LAS unsigned char* lds, int tid, int lane, int wave) {
    const int seq = job & 31;
    GdCtx X; X.GQ = GQ; X.GK = GK; X.GW = GW; X.GU = GU; X.GA = GA; X.GSC = GSC; X.GO = GO; X.b = seq >> 4; X.h = (seq >> 1) & 7; X.d = seq & 1; X.bh = X.b * 8 + X.h; X.c0 = (job >> 5) * 64;
    LAS unsigned char* st0 = lds; LAS unsigned char* st1 = lds + GSTAGE;
    LDS_BARRIER();
    if (wave >= 4) {
        if (wave == 4) gd_loader_loop<MODE, 0>(X, st0, st1, lane); else if (wave == 5) gd_loader_loop<MODE, 1>(X, st0, st1, lane); else if (wave == 6) gd_loader_loop<MODE, 2>(X, st0, st1, lane); else gd_loader_loop<MODE, 3>(X, st0, st1, lane);
    } else {
        asm volatile("" : "+v"(lane));
        f32x4 S[8]; bf16x8 Sb[4];
#pragma unroll
        for (int t = 0; t < 8; ++t) S[t] = (f32x4){0.f, 0.f, 0.f, 0.f};
#pragma unroll
        for (int t = 0; t < 4; ++t) Sb[t] = (bf16x8){0, 0, 0, 0, 0, 0, 0, 0};
        LDS_BARRIER();
#pragma unroll 1
        for (int idx = 0; idx < NCH; ++idx) {
            if (MODE & 2) gd_compute<MODE>(X, idx, (idx & 1) ? st1 : st0, lane, wave, S, Sb);
            LDS_BARRIER();
        }
        LDS_BARRIER();
    }
}
__device__ __forceinline__ void ph_cprep(const bf16* Z1, const bf16* Z2, const float* GF, const float* w_conv, const float* b_gate, const float* a_log, const float* dt_bias, bf16* MS, float* MSC,
                                         bf16* GQ, bf16* GK, bf16* GW, bf16* GU, bf16* GA, float* GSC, LAS unsigned char* lds, int tid, int lane, int wave) {
    for (int gt = blockIdx.x; gt < 16 * NCH; gt += gridDim.x) gdn_prep_task(gt, Z2, GF, w_conv, a_log, dt_bias, GQ, GK, GW, GU, GA, GSC, lds, tid, lane, wave);
    for (int mt = blockIdx.x; mt < 8 * NCH; mt += gridDim.x) mlstm_prep_task(mt, Z1, GF, b_gate, MS, MSC, (LAS float*)lds, tid, lane, wave);
}
__device__ __forceinline__ float red16(float v) { v += __shfl_xor(v, 1); v += __shfl_xor(v, 2); v += __shfl_xor(v, 4); v += __shfl_xor(v, 8); return v; }
__device__ __forceinline__ void ph_scan(const bf16* Z1, const bf16* MS, const float* MSC, const bf16* GQ, const bf16* GK, const bf16* GW, const bf16* GU, const bf16* GA, const float* GSC,
                                        bf16* MO, float* DEN, bf16* GO, const float* w1, const float* w3, const float* w2, unsigned char* ws, LAS unsigned char* lds, int tid, int lane, int wave) {
    for (int job = blockIdx.x; job < 256; job += gridDim.x) {
        if (job < 64) {
            if (SCAN_PROBE_MODE && (SCAN_PROBE_WHICH & 1)) { mlstm_chunk_job<SCAN_PROBE_MODE>(job, Z1, MS, MSC, MO, DEN, lds, tid, lane, wave); __syncthreads(); }
            mlstm_chunk_job<7>(job, Z1, MS, MSC, MO, DEN, lds, tid, lane, wave);
        } else if (job < 128) {
            if (SCAN_PROBE_MODE && (SCAN_PROBE_WHICH & 2)) { gdn_chunk_job<SCAN_PROBE_MODE>(job - 64, GQ, GK, GW, GU, GA, GSC, GO, lds, tid, lane, wave); __syncthreads(); }
            gdn_chunk_job<7>(job - 64, GQ, GK, GW, GU, GA, GSC, GO, lds, tid, lane, wave);
        } else if (job < 128 + TR_BLOCKS) {
            ph_transposes_experts(w1, w3, w2, ws, lds, (job - 128) * NWAVES + wave, TR_BLOCKS * NWAVES, wave, lane);

        }
        __syncthreads();
    }
}

__device__ __forceinline__ void unpack16(const bf16* p, float (&v)[16]) {
    const v4u a = *(const v4u*)p, b = *(const v4u*)(p + 8);
    v[0] = bf_lo(a.x); v[1] = bf_hi(a.x); v[2] = bf_lo(a.y); v[3] = bf_hi(a.y); v[4] = bf_lo(a.z); v[5] = bf_hi(a.z); v[6] = bf_lo(a.w); v[7] = bf_hi(a.w);
    v[8] = bf_lo(b.x); v[9] = bf_hi(b.x); v[10] = bf_lo(b.y); v[11] = bf_hi(b.y); v[12] = bf_lo(b.z); v[13] = bf_hi(b.z); v[14] = bf_lo(b.w); v[15] = bf_hi(b.w);
}
__device__ __forceinline__ void pack16(bf16* p, const float (&v)[16]) {
    v4u a, b; a.x = pk2(v[0], v[1]); a.y = pk2(v[2], v[3]); a.z = pk2(v[4], v[5]); a.w = pk2(v[6], v[7]); b.x = pk2(v[8], v[9]); b.y = pk2(v[10], v[11]); b.z = pk2(v[12], v[13]); b.w = pk2(v[14], v[15]);
    *(v4u*)p = a; *(v4u*)(p + 8) = b;
}
__device__ __forceinline__ void unpack8(const bf16* p, float (&v)[8]) {
    const v4u a = *(const v4u*)p;
    v[0] = bf_lo(a.x); v[1] = bf_hi(a.x); v[2] = bf_lo(a.y); v[3] = bf_hi(a.y); v[4] = bf_lo(a.z); v[5] = bf_hi(a.z); v[6] = bf_lo(a.w); v[7] = bf_hi(a.w);
}
__device__ __forceinline__ void pack8s(bf16* p, const float (&v)[8]) { v4u a; a.x = pk2(v[0], v[1]); a.y = pk2(v[2], v[3]); a.z = pk2(v[4], v[5]); a.w = pk2(v[6], v[7]); *(v4u*)p = a; }
__device__ __forceinline__ void ph_combine(const bf16* Z, const bf16* MO, const float* DEN, const bf16* GO, const float* g_head_m, const float* g_head_d, bf16* Y, int gw, int NGW, int lane) {
    for (int row = gw; row < ML; row += NGW) {
#pragma unroll
        for (int hf = 0; hf < 2; ++hf) { const int c0 = 512 * hf + 8 * lane;
            { float a[8], b2[8], g[8], o[8];
              unpack8(MO + (size_t)row * 1024 + c0, a); unpack8(MO + ((size_t)ML + row) * 1024 + c0, b2); unpack8(Z + (size_t)row * Z1LD + ZC_MO + c0, g);
              const int hd = 2 * hf + (lane >> 5);
              const float i0 = 1.f / fmaxf(fabsf(DEN[(size_t)row * 4 + hd]), 1.f), i1 = 1.f / fmaxf(fabsf(DEN[((size_t)ML + row) * 4 + hd]), 1.f);
              float ss = 0.f;
#pragma unroll
              for (int j = 0; j < 8; ++j) { a[j] = a[j] * i0 + b2[j] * i1; ss += a[j] * a[j]; }
              ss = red16(ss); ss += __shfl_xor(ss, 16);
              const float r = 1.f / sqrtf(ss * (1.f / 256.f) + EPSF);
              const f32x4 w0 = *(const f32x4*)(g_head_m + c0), w1 = *(const f32x4*)(g_head_m + c0 + 4);
#pragma unroll
              for (int j = 0; j < 8; ++j) o[j] = a[j] * r * (j < 4 ? w0[j & 3] : w1[j & 3]) * sigmoidf_(g[j]);
              pack8s(Y + (size_t)row * DM + c0, o); }
            { float a[8], b2[8], g[8], o[8];
              unpack8(GO + (size_t)row * 1024 + c0, a); unpack8(GO + ((size_t)ML + row) * 1024 + c0, b2); unpack8(Z + (size_t)row * Z1LD + ZC_GO + c0, g);
              float ss = 0.f;
#pragma unroll
              for (int j = 0; j < 8; ++j) { a[j] += b2[j]; ss += a[j] * a[j]; }
              ss = red16(ss);
              const float r = 1.f / sqrtf(ss * (1.f / 128.f) + EPSF);
              const f32x4 w0 = *(const f32x4*)(g_head_d + c0), w1 = *(const f32x4*)(g_head_d + c0 + 4);
#pragma unroll
              for (int j = 0; j < 8; ++j) o[j] = a[j] * r * (j < 4 ? w0[j & 3] : w1[j & 3]) * siluf_(g[j]);
              pack8s(Y + (size_t)row * DM + 1024 + c0, o); }
        }
    }
}
typedef float f32x4v __attribute__((ext_vector_type(4)));
constexpr int HB_LD = 2052;
typedef float f32x2_t __attribute__((ext_vector_type(2)));
template <bool DRY> __device__ __forceinline__ void ph_norm2_route(const bf16* X1, const float* g2, const float* ADA, const float* w_grp, const float* b_grp, const float* w_rtr, const float* b_rtr,
                                               bf16* HL2, int* TOK_E, int* TOK_P, float* TOK_W, unsigned* cnt, LAS float* sf, int tid, int lane, int wave) {
    for (int grp16 = blockIdx.x; grp16 < ML / 16; grp16 += gridDim.x) {
#pragma unroll 1
        for (int rr = 0; rr < 2; ++rr) {
            const int r = 2 * wave + rr, row = grp16 * 16 + r;
            const u32x2* src = (const u32x2*)(X1 + (size_t)row * DM); const float* sh = ADA + (size_t)(row / SEQ) * 12288 + 6144; const float* sc = sh + 2048;
            f32x4 v[8]; float s = 0.f;
#pragma unroll
            for (int j = 0; j < 8; ++j) { const u32x2 w = src[lane + 64 * j]; v[j] = (f32x4){bf_lo(w.x), bf_hi(w.x), bf_lo(w.y), bf_hi(w.y)}; s += (v[j].x * v[j].x + v[j].y * v[j].y) + (v[j].z * v[j].z + v[j].w * v[j].w); }
            const float rstd = 1.f / sqrtf(wave_sum(s) * (1.f / DM) + EPSF);
#pragma unroll
            for (int j = 0; j < 8; ++j) { const int col = 4 * (lane + 64 * j);
                const f32x4 g = *(const f32x4*)(g2 + col), a = *(const f32x4*)(sc + col), b = *(const f32x4*)(sh + col);
                const f32x4 o = (v[j] * rstd) * g * (a + 1.f) + b;
                *(LAS f32x4*)(sf + r * HB_LD + col) = o; }
        }
        __syncthreads();
        f32x4v acc0 = {0.f, 0.f, 0.f, 0.f}, acc1 = acc0, acc2 = acc0;
        { const int arow = lane & 15, kg = lane >> 4, bc = lane & 15;
#pragma unroll 1
          for (int kb = 0; kb < 64; kb += 16) {
              float av[16], b0[16], b1[16], b2[16];
#pragma unroll
              for (int u = 0; u < 16; ++u) { const int k = 256 * wave + 4 * (kb + u) + kg;
                  av[u] = sf[arow * HB_LD + k]; const f32x2_t bw = *(const f32x2_t*)(w_rtr + k * 32 + 2 * bc); b0[u] = bw.x; b1[u] = bw.y; b2[u] = bc < 4 ? w_grp[k * 4 + bc] : 0.f; }
              __builtin_amdgcn_sched_barrier(0);
#pragma unroll
              for (int u = 0; u < 16; ++u) {
                  acc0 = __builtin_amdgcn_mfma_f32_16x16x4f32(av[u], b0[u], acc0, 0, 0, 0);
                  acc1 = __builtin_amdgcn_mfma_f32_16x16x4f32(av[u], b1[u], acc1, 0, 0, 0);
                  acc2 = __builtin_amdgcn_mfma_f32_16x16x4f32(av[u], b2[u], acc2, 0, 0, 0); } } }
        __syncthreads();
        { LAS float* red = sf; const int col = lane & 15, r4 = 4 * (lane >> 4);
#pragma unroll
          for (int q = 0; q < 4; ++q) { red[((wave * 3 + 0) * 16 + r4 + q) * 16 + col] = acc0[q]; red[((wave * 3 + 1) * 16 + r4 + q) * 16 + col] = acc1[q]; red[((wave * 3 + 2) * 16 + r4 + q) * 16 + col] = acc2[q]; } }
        __syncthreads();
        for (int i = tid; i < 768; i += NTHREADS) { float s = 0.f;
#pragma unroll
            for (int w = 0; w < 8; ++w) s += sf[w * 768 + i];
            sf[8 * 768 + i] = s; }
        __syncthreads();
        if (tid < 16) {
            const int r = tid, row = grp16 * 16 + r; const LAS float* lg = sf + 8 * 768;
            float gl[4];
#pragma unroll
            for (int i = 0; i < 4; ++i) gl[i] = lg[(2 * 16 + r) * 16 + i] + b_grp[i];
            int gbest = 0; float gmax = gl[0];
#pragma unroll
            for (int i = 1; i < 4; ++i) if (gl[i] > gmax) { gmax = gl[i]; gbest = i; }
            float gsum = 0.f;
#pragma unroll
            for (int i = 0; i < 4; ++i) gsum += expf(gl[i] - gmax);
            const float pgrp = 1.f / gsum;
            float l0 = -3.0e38f, l1 = -3.0e38f; int e0 = 0, e1 = 0;
#pragma unroll
            for (int j = 0; j < 8; ++j) { const int idx = gbest * 8 + j; const float l = lg[((idx & 1) * 16 + r) * 16 + (idx >> 1)] + b_rtr[idx];
                if (l > l0) { l1 = l0; e1 = e0; l0 = l; e0 = j; } else if (l > l1) { l1 = l; e1 = j; } }
            const float t = expf(l1 - l0);
            const float w0 = pgrp / (1.f + t), w1 = pgrp * t / (1.f + t);
            const int ea = gbest * 8 + e0, eb = gbest * 8 + e1;
            if (DRY) { asm volatile("" :: "v"(w0), "v"(w1), "v"(ea), "v"(eb)); } else {
            const int pa = (int)atomicAdd(cnt + 64 * ea, 1u), pb = (int)atomicAdd(cnt + 64 * eb, 1u);
            TOK_E[row * 2] = ea; TOK_E[row * 2 + 1] = eb; TOK_P[row * 2] = pa; TOK_P[row * 2 + 1] = pb; TOK_W[row * 2] = w0; TOK_W[row * 2 + 1] = w1; }
        }
        __syncthreads();
    }
}
__device__ __forceinline__ void build_moe_tables(const unsigned* cnt, LAS int* tb, int tid) {
    __syncthreads();
    if (tid < NE) tb[320 + tid] = (int)__hip_atomic_load(cnt + 64 * tid, __ATOMIC_RELAXED, __HIP_MEMORY_SCOPE_AGENT);
    __syncthreads();
    if (tid == 0) { int acc = 0;
        for (int e = 0; e < NE; ++e) { const int nb = (tb[320 + e] + 255) >> 8; tb[e] = acc;
            for (int p = 0; p < nb; ++p) tb[64 + acc + p] = e;
            acc += nb; }
        tb[32] = acc; }
    __syncthreads();
}
__device__ __forceinline__ void ph_gather(const bf16* X1, const float* g2, const float* ADA, const int* TOK_E, const int* TOK_P, int* TOK_D, bf16* XB, const LAS int* tb, int gw, int NGW, int lane) {
    for (int tok = gw; tok < ML; tok += NGW) {
        const u32x2* src = (const u32x2*)(X1 + (size_t)tok * DM); const float* sh = ADA + (size_t)(tok / SEQ) * 12288 + 6144; const float* sc = sh + 2048;
        f32x4 v[8]; float s = 0.f;
#pragma unroll
        for (int j = 0; j < 8; ++j) { const u32x2 w = src[lane + 64 * j]; v[j] = (f32x4){bf_lo(w.x), bf_hi(w.x), bf_lo(w.y), bf_hi(w.y)}; s += (v[j].x * v[j].x + v[j].y * v[j].y) + (v[j].z * v[j].z + v[j].w * v[j].w); }
        const float rstd = 1.f / sqrtf(wave_sum(s) * (1.f / DM) + EPSF);
        const int e0 = TOK_E[tok * 2], e1 = TOK_E[tok * 2 + 1], d0 = tb[e0] * 256 + TOK_P[tok * 2], d1 = tb[e1] * 256 + TOK_P[tok * 2 + 1];
        unsigned long long* o0 = (unsigned long long*)(XB + (size_t)d0 * DM) + lane; unsigned long long* o1 = (unsigned long long*)(XB + (size_t)d1 * DM) + lane;
#pragma unroll
        for (int j = 0; j < 8; ++j) { const int col = 4 * (lane + 64 * j);
            const f32x4 g = *(const f32x4*)(g2 + col), a = *(const f32x4*)(sc + col), b = *(const f32x4*)(sh + col);
            const f32x4 o = (v[j] * rstd) * g * (a + 1.f) + b;
            const unsigned long long w = (unsigned long long)pk2(o.x, o.y) | ((unsigned long long)pk2(o.z, o.w) << 32);
            o0[64 * j] = w; o1[64 * j] = w; }
        if (lane == 0) { TOK_D[tok * 2] = d0; TOK_D[tok * 2 + 1] = d1; }
    }
}
__device__ __forceinline__ void ph_final(const bf16* X1, float* dst, const bf16* YE, const int* TOK_D, const float* TOK_W, const float* ADA, const float* g_final, int gw, int NGW, int lane) {
    for (int tok = gw; tok < ML; tok += NGW) {
        const int d0 = TOK_D[tok * 2], d1 = TOK_D[tok * 2 + 1]; const float w0 = TOK_W[tok * 2], w1 = TOK_W[tok * 2 + 1];
        const float* gt = ADA + (size_t)(tok / SEQ) * 12288 + 10240;
        const u32x2* xr = (const u32x2*)(X1 + (size_t)tok * DM) + lane;
        const u32x2* y0 = (const u32x2*)(YE + (size_t)d0 * DM) + lane; const u32x2* y1 = (const u32x2*)(YE + (size_t)d1 * DM) + lane;
        f32x4 v[8]; float s = 0.f;
#pragma unroll
        for (int j = 0; j < 8; ++j) { const int col = 4 * (lane + 64 * j);
            const u32x2 xw = xr[64 * j]; const f32x4 xv = {bf_lo(xw.x), bf_hi(xw.x), bf_lo(xw.y), bf_hi(xw.y)}, g = *(const f32x4*)(gt + col); const u32x2 a = y0[64 * j], b = y1[64 * j];
            const f32x4 ya = {bf_lo(a.x), bf_hi(a.x), bf_lo(a.y), bf_hi(a.y)}, yb = {bf_lo(b.x), bf_hi(b.x), bf_lo(b.y), bf_hi(b.y)};
            v[j] = xv + g * (ya * w0 + yb * w1);
            s += (v[j].x * v[j].x + v[j].y * v[j].y) + (v[j].z * v[j].z + v[j].w * v[j].w); }
        const float rstd = 1.f / sqrtf(wave_sum(s) * (1.f / DM) + EPSF);
#pragma unroll
        for (int j = 0; j < 8; ++j) { const int col = 4 * (lane + 64 * j); ((f32x4*)(dst + (size_t)tok * DM))[lane + 64 * j] = (v[j] * rstd) * *(const f32x4*)(g_final + col); }
    }
}
constexpr int NPH = 13;
struct Args { const float* in[24]; float* out; unsigned char* ws; int ph_lo, ph_hi; };
__global__ void __launch_bounds__(NTHREADS, 2) fwd_kernel(Args args) {
    extern __shared__ __attribute__((aligned(16))) unsigned char lds_raw[];
    LAS unsigned char* lds = (LAS unsigned char*)lds_raw;
    LAS float* sf = (LAS float*)lds;
    LAS int* tb = (LAS int*)(lds + TBL_OFF + 256);
    const int tid = threadIdx.x, lane = tid & 63, wave = __builtin_amdgcn_readfirstlane(tid >> 6);
    const int G = gridDim.x, bx = blockIdx.x;
    const int vcu = (G % 8 == 0) ? (bx % 8) * (G / 8) + bx / 8 : bx;
    const int gw = vcu * NWAVES + wave, NGW = G * NWAVES;
    unsigned char* const ws = args.ws;
    unsigned* const ctl = (unsigned*)(ws + WS_CTL);
#define xin ((const float*)args.in[0])
#define cvec ((const float*)args.in[1])
#define ctx ((const float*)args.in[2])
#define c_ctx ((const float*)args.in[3])
#define w_ada ((const float*)args.in[4])
#define b_ada ((const float*)args.in[5])
#define g_norm1 ((const float*)args.in[6])
#define g_norm2 ((const float*)args.in[7])
#define w_in ((const float*)args.in[8])
#define b_gate ((const float*)args.in[9])
#define a_log ((const float*)args.in[10])
#define dt_bias ((const float*)args.in[11])
#define w_conv ((const float*)args.in[12])
#define g_head_m ((const float*)args.in[13])
#define g_head_d ((const float*)args.in[14])
#define w_out ((const float*)args.in[15])
#define w_grp ((const float*)args.in[16])
#define b_grp ((const float*)args.in[17])
#define w_rtr ((const float*)args.in[18])
#define b_rtr ((const float*)args.in[19])
#define w1 ((const float*)args.in[20])
#define w3 ((const float*)args.in[21])
#define w2 ((const float*)args.in[22])
#define g_final ((const float*)args.in[23])
#define out (args.out)
#define cnt (ctl + CW_CNT)
#define ADA ((float*)(ws + WS_ADA))
#define GF ((float*)(ws + WS_GF))
#define MLG ((float*)(ws + WS_MLG))
#define GDG ((float*)(ws + WS_GDG))
#define TOK_E ((int*)(ws + WS_TOK))
#define TOK_P ((int*)(ws + WS_TOK) + 2 * ML)
#define TOK_W ((float*)(ws + WS_TOK) + 4 * ML)
#define TOK_D ((int*)(ws + WS_TOK) + 6 * ML)
#define WinT ((bf16*)(ws + WS_WIN))
#define WoutT ((bf16*)(ws + WS_WOUT))
#define W13T ((bf16*)(ws + WS_W13))
#define W2T ((bf16*)(ws + WS_W2))
#define HL ((bf16*)(ws + WS_HL))
#define Y ((bf16*)(ws + WS_Y))
#define Z1 ((bf16*)(ws + WS_Z1))
#define Z2 ((bf16*)(ws + WS_Z2))
#define GQ ((bf16*)(ws + WS_GQ))
#define GK ((bf16*)(ws + WS_GK))
#define GV ((bf16*)(ws + WS_GV))
#define MO ((bf16*)(ws + WS_MO))
#define GO ((bf16*)(ws + WS_GO))
#define GW ((bf16*)(ws + WS_GW))
#define GU ((bf16*)(ws + WS_GU))
#define GA ((bf16*)(ws + WS_GA))
#define GSC ((float*)(ws + WS_GSC))
#define MS ((bf16*)(ws + WS_MS))
#define MSC ((float*)(ws + WS_MSC))
#define DEN ((float*)(ws + WS_DEN))
#define HL2 ((bf16*)(ws + WS_HL2))
#define XB ((bf16*)(ws + WS_XB))
#define HB ((bf16*)(ws + WS_H))
#define YE ((bf16*)(ws + WS_YE))
#define X1B ((bf16*)(ws + WS_X1B))

    const int lo = args.ph_lo, hi = args.ph_hi;
    volatile LAS unsigned* MISC = (volatile LAS unsigned*)(lds + TBL_OFF);
    if (tid < 64) MISC[tid] = 0u;
    __syncthreads();
    XcdBarrier bar; bar.bar = ctl + CW_BAR; bar.x = 0; bar.st = nullptr;
    if (hi - lo > 1) bar = xcd_barrier_post(ctl + CW_BAR, MISC + 8);
#define IN(k) (lo <= (k) && (k) < hi)
#define SEAM(k) do { if (IN(k) && IN((k) + 1)) { xcd_barrier(bar); \
        if (USE_CG_SYNC && (k) == 0) { cg::this_grid().sync(); if (tid == 0) { __builtin_amdgcn_fence(__ATOMIC_ACQUIRE, "agent"); asm volatile("s_waitcnt vmcnt(0)" ::: "memory"); } __syncthreads(); } } } while (0)

#define NOPK(k) do { if ((NOPMASK >> (k)) & 1) asm volatile("s_nop 0"); } while (0)
#define RUN(k, ...) do { NOPK(k); if (IN(k)) { __VA_ARGS__ if ((REPEAT_MASK >> (k)) & 1) { xcd_barrier(bar); __VA_ARGS__ } } } while (0)
    RUN(0, ph_ada(cvec, c_ctx, w_ada, b_ada, ADA, sf, tid, lane, wave); __syncthreads(); ph_transposes_io(w_in, w_out, ws, lds, gw, NGW, wave, lane););
    SEAM(0);
    RUN(1, ph_norm1(xin, ctx, g_norm1, ADA, HL, gw, NGW, lane););
    SEAM(1);
    RUN(2, { pg8::DenseSched S; S.init(HL, WinT, MT, NZ, DM, G, bx); pg8::EpiZ E{Z1, Z2, GF}; pg8::gemm_phase<pg8::EpiZ, pg8::DenseSched, true, true>(lds, DM, S, E); });
    SEAM(2);
    RUN(4, ph_cprep(Z1, Z2, GF, w_conv, b_gate, a_log, dt_bias, MS, MSC, GQ, GK, GW, GU, GA, GSC, lds, tid, lane, wave););
    SEAM(4);
    RUN(5, ph_scan(Z1, MS, MSC, GQ, GK, GW, GU, GA, GSC, MO, DEN, GO, w1, w3, w2, ws, lds, tid, lane, wave););
    SEAM(5);
    RUN(6, ph_combine(Z1, MO, DEN, GO, g_head_m, g_head_d, Y, gw, NGW, lane););
    SEAM(6);
    RUN(7, { pg8::DenseSched S; S.init(Y, WoutT, ML, DM, DM, G, bx); pg8::EpiX1 E{xin, X1B, ADA}; pg8::gemm_phase<pg8::EpiX1, pg8::DenseSched, true, true>(lds, DM, S, E); });
    SEAM(7);
    NOPK(8);
    if (IN(8)) { if ((REPEAT_MASK >> 8) & 1) { ph_norm2_route<true>(X1B, g_norm2, ADA, w_grp, b_grp, w_rtr, b_rtr, HL2, TOK_E, TOK_P, TOK_W, cnt, sf, tid, lane, wave); xcd_barrier(bar); }
                 ph_norm2_route<false>(X1B, g_norm2, ADA, w_grp, b_grp, w_rtr, b_rtr, HL2, TOK_E, TOK_P, TOK_W, cnt, sf, tid, lane, wave); }
    SEAM(8);
    RUN(9, build_moe_tables(cnt, tb, tid); ph_gather(X1B, g_norm2, ADA, TOK_E, TOK_P, TOK_D, XB, tb, gw, NGW, lane););
    SEAM(9);
    RUN(10, { build_moe_tables(cnt, tb, tid);
                 pg8::MoeSched S; S.A = (const char*)XB; S.Bt = (const char*)W13T; S.a_tstep = (size_t)256 * DM * 2; S.b_estep = (size_t)1536 * DM * 2; S.b_tstep = (size_t)256 * DM * 2;
                 S.nN = 6; S.nunits = tb[32] * 6; S.G = G; S.c = vcu; S.blk2e = tb + 64;
                 pg8::EpiSwiglu E{HB};
                 pg8::gemm_phase<pg8::EpiSwiglu, pg8::MoeSched, true, true>(lds, DM, S, E); });
    SEAM(10);
    RUN(11, { build_moe_tables(cnt, tb, tid);
                  pg8::MoeSched S; S.A = (const char*)HB; S.Bt = (const char*)W2T; S.a_tstep = (size_t)256 * DE * 2; S.b_estep = (size_t)DM * DE * 2; S.b_tstep = (size_t)256 * DE * 2;
                  S.nN = 8; S.nunits = tb[32] * 8; S.G = G; S.c = vcu; S.blk2e = tb + 64;
                  pg8::EpiBf E{YE, DM};
                  pg8::gemm_phase<pg8::EpiBf, pg8::MoeSched, true, true>(lds, DE, S, E); });
    SEAM(11);
    NOPK(12);
    if (IN(12)) { if ((REPEAT_MASK >> 12) & 1) { ph_final(X1B, (float*)(ws + WS_XB), YE, TOK_D, TOK_W, ADA, g_final, gw, NGW, lane); xcd_barrier(bar); }
                  ph_final(X1B, out, YE, TOK_D, TOK_W, ADA, g_final, gw, NGW, lane); }
#undef RUN
#undef IN
#undef SEAM
#undef xin
#undef cvec
#undef ctx
#undef c_ctx
#undef w_ada
#undef b_ada
#undef g_norm1
#undef g_norm2
#undef w_in
#undef b_gate
#undef a_log
#undef dt_bias
#undef w_conv
#undef g_head_m
#undef g_head_d
#undef w_out
#undef w_grp
#undef b_grp
#undef w_rtr
#undef b_rtr
#undef w1
#undef w3
#undef w2
#undef g_final
#undef out
#undef cnt
#undef ADA
#undef GF
#undef MLG
#undef GDG
#undef TOK_E
#undef TOK_P
#undef TOK_W
#undef TOK_D
#undef WinT
#undef WoutT
#undef W13T
#undef W2T
#undef HL
#undef Y
#undef Z1
#undef Z2
#undef GQ
#undef GK
#undef GV
#undef MO
#undef GO
#undef GW
#undef GU
#undef GA
#undef GSC
#undef MS
#undef MSC
#undef DEN
#undef HL2
#undef XB
#undef HB
#undef YE
#undef X1B
}

#ifndef MK_MULTI
#define MK_MULTI 0
#endif
extern "C" void kernel_launch(void* const* d_in, const int* in_sizes, int n_in, void* d_out, int out_size, void* d_ws, size_t ws_size, hipStream_t stream) {
    static int grid = 0;
    if (grid == 0) {
        if (n_in != 24 || in_sizes[0] != ML * DM || out_size != ML * DM || ws_size < WS_END) {
            fprintf(stderr, "kernel_launch: built for 24 inputs, x/out of %d floats, >= %zu bytes of workspace; got n_in %d, in0 %d, out %d, ws %zu; nothing launched\n", ML * DM, (size_t)WS_END, n_in, n_in > 0 ? in_sizes[0] : -1, out_size, ws_size);
            grid = -1; return; }
        int dev = 0, cus = 0, per_cu = 0;
        if (hipGetDevice(&dev) != hipSuccess || hipDeviceGetAttribute(&cus, hipDeviceAttributeMultiprocessorCount, dev) != hipSuccess) { fprintf(stderr, "kernel_launch: device query failed\n"); grid = -1; return; }
        if (hipFuncSetAttribute((const void*)fwd_kernel, hipFuncAttributeMaxDynamicSharedMemorySize, LDS_BYTES) != hipSuccess) { fprintf(stderr, "kernel_launch: hipFuncSetAttribute failed\n"); grid = -1; return; }
        if (hipOccupancyMaxActiveBlocksPerMultiprocessor(&per_cu, (const void*)fwd_kernel, NTHREADS, LDS_BYTES) != hipSuccess || per_cu < 1) { fprintf(stderr, "kernel_launch: occupancy query says %d blocks per CU\n", per_cu); (void)hipGetLastError(); grid = -1; return; }
        grid = cus;
        fprintf(stderr, "kernel_launch: %d CUs, occupancy %d per CU, grid %d\n", cus, per_cu, grid);
    }
    if (grid < 0) return;
    if (hipMemsetAsync((char*)d_ws + WS_CTL, 0, CTL_ZERO_BYTES, stream) != hipSuccess) { fprintf(stderr, "kernel_launch: memset failed\n"); return; }
    Args a{};
    for (int i = 0; i < 24; ++i) a.in[i] = (const float*)d_in[i];
    a.out = (float*)d_out; a.ws = (unsigned char*)d_ws;
#if MK_MULTI
    for (int ph = 0; ph < NPH; ++ph) { a.ph_lo = ph; a.ph_hi = ph + 1; hipLaunchKernelGGL(fwd_kernel, dim3(grid), dim3(NTHREADS), LDS_BYTES, stream, a); }
#else
    a.ph_lo = 0; a.ph_hi = NPH;
    void* params[] = {&a};
    const hipError_t e = hipLaunchCooperativeKernel((const void*)fwd_kernel, dim3(grid), dim3(NTHREADS), params, LDS_BYTES, stream);
    if (e != hipSuccess) fprintf(stderr, "kernel_launch: cooperative launch failed: %s (grid %d)\n", hipGetErrorString(e), grid);
#endif
}
```
